# Optimizing an MI355X kernel written in HIP

```python
import jax, jax.numpy as jnp
from jax import lax
import numpy as np

D_MODEL = 1024
BATCH = 4
SEQ = 8192
DEPTH = 2

BRANCH_WIDTH = D_MODEL // 2
RWKV_HEAD_DIM = 64
RWKV_HEADS = BRANCH_WIDTH // RWKV_HEAD_DIM
RWKV_WIDTH = RWKV_HEADS * RWKV_HEAD_DIM
DECAY_LORA = 64
ICLR_LORA = 64
GATE_LORA = 128
RWKV_LN_EPS = 64e-5
CONV_CH = BRANCH_WIDTH
CONV_TAPS = 3
FOX_HEAD_DIM = 64
FOX_HEADS = BRANCH_WIDTH // FOX_HEAD_DIM
FOX_WIDTH = FOX_HEADS * FOX_HEAD_DIM
Q_BLOCK = 128
N_BRANCHES = 3
RWKV_COLS = 3 * RWKV_WIDTH + DECAY_LORA + ICLR_LORA + GATE_LORA
CONV_COLS = 3 * CONV_CH
FOX_COLS = 3 * FOX_WIDTH + FOX_HEADS
GATE_COLS = N_BRANCHES * D_MODEL
IN_COLS = RWKV_COLS + CONV_COLS + FOX_COLS + GATE_COLS
D_FF = 2816
N_EXPERTS = 8
TOP_K = 2
D_FF_EXPERT = 3584
N_DENSE = (DEPTH + 1) // 2
N_MOE = DEPTH // 2
DEEPNORM_ALPHA = (2 * DEPTH) ** 0.25
DEEPNORM_BETA = (8 * DEPTH) ** -0.25
LN_EPS = 1e-5

kernel_name = 'hybrid_rwkv7_conv_fox_moe_deepnorm'


def _split_cols(t, sizes):
    return jnp.split(t, np.cumsum(sizes)[:-1].tolist(), axis=-1)


def _heads(t, n_heads):
    return t.reshape(t.shape[:-1] + (n_heads, t.shape[-1] // n_heads))


def layer_norm(x, g, b):
    xf = x.astype(jnp.float32)
    mu = jnp.mean(xf, axis=-1, keepdims=True)
    var = jnp.mean(jnp.square(xf - mu), axis=-1, keepdims=True)
    return ((xf - mu) * lax.rsqrt(var + LN_EPS) * g + b).astype(x.dtype)


def token_shift(t):
    return jnp.pad(t, ((0, 0), (1, 0), (0, 0)))[:, :-1]


def rwkv7_scan(r, decay, k, v, a_vec, b_vec):
    bsz, _, h, n = r.shape

    def step(state, inp):
        r_t, d_t, k_t, v_t, a_t, b_t = inp
        sa = jnp.einsum('bhvk,bhk->bhv', state, a_t)
        state = (state * d_t[:, :, None, :] + sa[..., None] * b_t[:, :, None, :]
                 + v_t[..., None] * k_t[:, :, None, :])
        return state, jnp.einsum('bhvk,bhk->bhv', state, r_t)

    xs = tuple(jnp.moveaxis(t, 1, 0) for t in (r, decay, k, v, a_vec, b_vec))
    s0 = jnp.zeros((bsz, h, n, n), jnp.float32)
    _, ys = lax.scan(step, s0, xs)
    return jnp.moveaxis(ys, 0, 1)


def rwkv7_time_mix(p, mu_shift, w0_decay, w2_decay, a0, w2_iclr, w2_gate, k_k, k_a, r_k, lnx_g, lnx_b):
    f32 = jnp.float32
    bsz, t_len, _ = p.shape
    p = p + mu_shift * (token_shift(p) - p)
    r, k, v, w_lo, a_lo, g_lo = _split_cols(p, [RWKV_WIDTH] * 3 + [DECAY_LORA, ICLR_LORA, GATE_LORA])
    w_raw = (w0_decay + jnp.tanh(w_lo) @ w2_decay).astype(f32)
    decay = jnp.exp(-jnp.exp(-jax.nn.softplus(-w_raw) - 0.5))
    a = jax.nn.sigmoid(a0 + a_lo @ w2_iclr).astype(f32)
    g = jax.nn.sigmoid(g_lo) @ w2_gate
    r, k, v = r.astype(f32), k.astype(f32), v.astype(f32)
    kk = _heads(k * k_k, RWKV_HEADS)
    kk = kk / jnp.maximum(jnp.linalg.norm(kk, axis=-1, keepdims=True), 1e-12)
    k = k * (1.0 + (a - 1.0) * k_a)
    rh, kh, vh, ah = (_heads(t, RWKV_HEADS) for t in (r, k, v, a))
    y = rwkv7_scan(rh, _heads(decay, RWKV_HEADS), kh, vh, -kk, kk * ah)
    mu = jnp.mean(y, axis=-1, keepdims=True)
    var = jnp.mean(jnp.square(y - mu), axis=-1, keepdims=True)
    y = ((y - mu) * lax.rsqrt(var + RWKV_LN_EPS)).reshape(bsz, t_len, RWKV_WIDTH) * lnx_g + lnx_b
    bonus = jnp.sum(rh * kh * r_k, axis=-1, keepdims=True) * vh
    y = y + bonus.reshape(bsz, t_len, RWKV_WIDTH)
    return y.astype(p.dtype) * g


def short_conv_mix(p, conv_w):
    t_len = p.shape[1]
    b_gate, c_gate, h = _split_cols(p, [CONV_CH] * 3)
    u = c_gate * h
    u_pad = jnp.pad(u, ((0, 0), (CONV_TAPS - 1, 0), (0, 0)))
    y = conv_w[0] * u_pad[:, 0:t_len]
    for i in range(1, CONV_TAPS):
        y = y + conv_w[i] * u_pad[:, i:i + t_len]
    return b_gate * y


def forgetting_attention(p, b_forget):
    f32 = jnp.float32
    bsz, t_len, _ = p.shape
    q, k, v, f = _split_cols(p, [FOX_WIDTH] * 3 + [FOX_HEADS])
    q, k, v = (_heads(t, FOX_HEADS) for t in (q, k, v))
    log_f = jax.nn.log_sigmoid((f + b_forget).astype(f32))
    cum = jnp.transpose(jnp.cumsum(log_f, axis=1), (0, 2, 1))
    scale = FOX_HEAD_DIM ** -0.5
    q_pos = jnp.arange(Q_BLOCK)
    outs = []
    for blk in range(t_len // Q_BLOCK):
        lo = blk * Q_BLOCK
        hi = lo + Q_BLOCK
        s = jnp.einsum('bqhd,bkhd->bhqk', q[:, lo:hi], k[:, :hi]).astype(f32) * scale
        s = s + cum[:, :, lo:hi, None] - cum[:, :, None, :hi]
        causal = jnp.arange(hi)[None, :] <= (lo + q_pos)[:, None]
        s = jnp.where(causal, s, -jnp.inf)
        prob = jax.nn.softmax(s, axis=-1).astype(v.dtype)
        outs.append(jnp.einsum('bhqk,bkhd->bqhd', prob, v[:, :hi]))
    return jnp.concatenate(outs, axis=1).reshape(bsz, t_len, FOX_WIDTH)


def hybrid_token_mixer(x, w_in, mu_shift, w0_decay, w2_decay, a0, w2_iclr, w2_gate, k_k, k_a, r_k,
                       lnx_g, lnx_b, conv_w, b_forget, b_gate, w_up_rwkv, w_up_conv, w_up_attn, w_out):
    bsz, t_len, _ = x.shape
    proj = x @ w_in
    p_rwkv, p_conv, p_fox, p_gate = _split_cols(proj, [RWKV_COLS, CONV_COLS, FOX_COLS, GATE_COLS])
    o_a = rwkv7_time_mix(p_rwkv, mu_shift, w0_decay, w2_decay, a0, w2_iclr, w2_gate, k_k, k_a, r_k, lnx_g, lnx_b)
    o_b = short_conv_mix(p_conv, conv_w)
    o_c = forgetting_attention(p_fox, b_forget)
    gates = jax.nn.sigmoid(p_gate.reshape(bsz, t_len, N_BRANCHES, D_MODEL) + b_gate)
    merged = (gates[:, :, 0] * (o_a @ w_up_rwkv) + gates[:, :, 1] * (o_b @ w_up_conv)
              + gates[:, :, 2] * (o_c @ w_up_attn))
    return merged @ w_out


def swiglu(x, w1, w3, w2):
    return (jax.nn.silu(x @ w1) * (x @ w3)) @ w2


def moe_swiglu(x, router_w, router_b, w1, w3, w2):
    f32 = jnp.float32
    logits = (x @ router_w).astype(f32) + router_b
    top_v, top_i = lax.top_k(logits, TOP_K)
    top_g = jax.nn.softmax(top_v, axis=-1)
    combine = jnp.sum(jax.nn.one_hot(top_i, N_EXPERTS, dtype=f32) * top_g[..., None], axis=-2)
    y = jnp.zeros_like(x)
    for e in range(N_EXPERTS):
        y = y + combine[..., e:e + 1].astype(x.dtype) * swiglu(x, w1[e], w3[e], w2[e])
    return y


def setup_inputs(seed: int = 0) -> dict:
    key = jax.random.key(seed)
    ks = iter(jax.random.split(key, 48))
    f32 = jnp.float32
    L = DEPTH
    D = D_MODEL

    def nrm(shape, scale):
        return jax.random.normal(next(ks), shape, f32) * scale

    return {
        'x': nrm((BATCH, SEQ, D), 1.0),
        'ln0_g': 1.0 + nrm((D,), 0.02),
        'ln0_b': nrm((D,), 0.02),
        'w_in': nrm((L, D, IN_COLS), D ** -0.5),
        'mu_shift': jax.random.uniform(next(ks), (L, RWKV_COLS), f32),
        'w0_decay': -1.5 + nrm((L, RWKV_WIDTH), 0.5),
        'w2_decay': nrm((L, DECAY_LORA, RWKV_WIDTH), 0.1),
        'a0': nrm((L, RWKV_WIDTH), 0.5),
        'w2_iclr': nrm((L, ICLR_LORA, RWKV_WIDTH), ICLR_LORA ** -0.5),
        'w2_gate': nrm((L, GATE_LORA, RWKV_WIDTH), GATE_LORA ** -0.5),
        'k_k': 0.85 + nrm((L, RWKV_WIDTH), 0.05),
        'k_a': 1.0 + nrm((L, RWKV_WIDTH), 0.05),
        'r_k': nrm((L, RWKV_HEADS, RWKV_HEAD_DIM), 0.1),
        'lnx_g': 1.0 + nrm((L, RWKV_WIDTH), 0.02),
        'lnx_b': nrm((L, RWKV_WIDTH), 0.02),
        'conv_w': nrm((L, CONV_TAPS, CONV_CH), CONV_TAPS ** -0.5),
        'b_forget': 3.0 + nrm((L, FOX_HEADS), 1.0),
        'b_gate': nrm((L, N_BRANCHES, D), 0.1),
        'w_up_rwkv': nrm((L, RWKV_WIDTH, D), RWKV_WIDTH ** -0.5),
        'w_up_conv': nrm((L, CONV_CH, D), CONV_CH ** -0.5),
        'w_up_attn': nrm((L, FOX_WIDTH, D), FOX_WIDTH ** -0.5),
        'w_out': nrm((L, D, D), D ** -0.5 * DEEPNORM_BETA),
        'ln1_g': 1.0 + nrm((L, D), 0.02),
        'ln1_b': nrm((L, D), 0.02),
        'ln2_g': 1.0 + nrm((L, D), 0.02),
        'ln2_b': nrm((L, D), 0.02),
        'ffn_w1': nrm((N_DENSE, D, D_FF), D ** -0.5),
        'ffn_w3': nrm((N_DENSE, D, D_FF), D ** -0.5),
        'ffn_w2': nrm((N_DENSE, D_FF, D), D_FF ** -0.5 * DEEPNORM_BETA),
        'router_w': nrm((N_MOE, D, N_EXPERTS), D ** -0.5),
        'router_b': nrm((N_MOE, N_EXPERTS), 0.01),
        'moe_w1': nrm((N_MOE, N_EXPERTS, D, D_FF_EXPERT), D ** -0.5),
        'moe_w3': nrm((N_MOE, N_EXPERTS, D, D_FF_EXPERT), D ** -0.5),
        'moe_w2': nrm((N_MOE, N_EXPERTS, D_FF_EXPERT, D), D_FF_EXPERT ** -0.5 * DEEPNORM_BETA),
    }


def reference(x, ln0_g, ln0_b, w_in, mu_shift, w0_decay, w2_decay, a0, w2_iclr, w2_gate, k_k, k_a, r_k,
              lnx_g, lnx_b, conv_w, b_forget, b_gate, w_up_rwkv, w_up_conv, w_up_attn, w_out,
              ln1_g, ln1_b, ln2_g, ln2_b, ffn_w1, ffn_w3, ffn_w2, router_w, router_b,
              moe_w1, moe_w3, moe_w2):
    x = layer_norm(x, ln0_g, ln0_b)
    for l in range(DEPTH):
        mix = hybrid_token_mixer(x, w_in[l], mu_shift[l], w0_decay[l], w2_decay[l], a0[l], w2_iclr[l],
                                 w2_gate[l], k_k[l], k_a[l], r_k[l], lnx_g[l], lnx_b[l], conv_w[l],
                                 b_forget[l], b_gate[l], w_up_rwkv[l], w_up_conv[l], w_up_attn[l], w_out[l])
        x = layer_norm(DEEPNORM_ALPHA * x + mix, ln1_g[l], ln1_b[l])
        i = l // 2
        if l % 2 == 0:
            ffn = swiglu(x, ffn_w1[i], ffn_w3[i], ffn_w2[i])
        else:
            ffn = moe_swiglu(x, router_w[i], router_b[i], moe_w1[i], moe_w3[i], moe_w2[i])
        x = layer_norm(DEEPNORM_ALPHA * x + ffn, ln2_g[l], ln2_b[l])
    return x
```

```cpp
#define PROBE_MOE_SCALE 1.f
#include <hip/hip_runtime.h>
#include <hip/hip_bf16.h>
#include <cstdio>
#include <cstdint>
#include <cmath>

namespace pg8 {
#define PG8_LAS __attribute__((address_space(3)))
typedef unsigned short bf16_t;
typedef short bf16x8 __attribute__((ext_vector_type(8)));
typedef float f32x4 __attribute__((ext_vector_type(4)));
typedef unsigned u32x4 __attribute__((ext_vector_type(4)));
typedef unsigned u32x2 __attribute__((ext_vector_type(2)));
constexpr int BM = 256, BK = 64, HALF = 128, HTB = HALF * BK * 2  , STAGE_BYTES = 8 * HTB, NXCD = 8, WGM = 8;

__host__ __device__ __forceinline__ int lds_byte(int r, int c) { const int st = (r >> 4) * 2 + (c >> 5), rr = r & 15, cc = c & 31, ob = rr * 64 + cc * 2; return st * 1024 + (ob ^ (((ob >> 9) & 1) << 5)); }
__host__ __device__ __forceinline__ void stage_rc(int b, int& R, int& C) { const int st = b / 1024, sb = b % 1024, swz = sb ^ (((sb >> 9) & 1) << 5); R = (st >> 1) * 16 + swz / 64; C = (st & 1) * 32 + (swz % 64) / 2; }
__host__ __device__ __forceinline__ int perm32(int rho) { const int n = rho >> 4, i = rho & 15; return 8 * (i >> 2) + 4 * n + (i & 3); }

struct Unit { int pm, pn, e; };
struct Gemm { const bf16_t* A; const bf16_t* Bt; int lda, ldb, K; size_t bstride; const int* rows; };

struct StaticOrder {
    int nM, nN, nwg, G, c;
    __host__ __device__ void init(int M, int N, int G_, int c_) { nM = M / BM; nN = N / BM; nwg = nM * nN; G = G_; c = c_; }
    __host__ __device__ void init_tiles(int nM_, int nN_, int G_, int c_) { nM = nM_; nN = nN_; nwg = nM * nN; G = G_; c = c_; }
    __host__ __device__ bool next(int i, Unit& u) const {
        const long L = (long)i * G + c; if (L >= nwg) return false;
        int wgid = (int)L; { const int q = nwg / NXCD, r = nwg % NXCD, xcd = wgid % NXCD, off = wgid / NXCD; wgid = (xcd < r ? xcd * (q + 1) : r * (q + 1) + (xcd - r) * q) + off; }
        const int nig = WGM * nN, gid = wgid / nig, fm = gid * WGM, gsz = (nM - fm) < WGM ? (nM - fm) : WGM;
        u.pm = fm + ((wgid % nig) % gsz); u.pn = (wgid % nig) / gsz; u.e = 0; return true;
    }
    __device__ __forceinline__ void a_ready(const Unit&) const {}
    __device__ __forceinline__ void done(const Unit&) const {}
};
struct GroupedOrder {
    StaticOrder so; const PG8_LAS int* pexp;
    __device__ __forceinline__ bool next(int i, Unit& u) const { if (!so.next(i, u)) return false; u.e = pexp[u.pm]; return true; }
    __device__ __forceinline__ void a_ready(const Unit&) const {}
    __device__ __forceinline__ void done(const Unit&) const {}
};

__device__ __forceinline__ unsigned cvt_pk_bf16(float lo, float hi) { unsigned r; asm volatile("v_cvt_pk_bf16_f32 %0, %1, %2" : "=v"(r) : "v"(lo), "v"(hi)); return r; }
__device__ __forceinline__ float bf_lo(unsigned w) { return __builtin_bit_cast(float, w << 16); }
__device__ __forceinline__ float bf_hi(unsigned w) { return __builtin_bit_cast(float, w & 0xffff0000u); }
__device__ __forceinline__ float fsigmoid(float x) { return __builtin_amdgcn_rcpf(1.0f + __expf(-x)); }
__device__ __forceinline__ u32x4 pack8(const f32x4 v0, const f32x4 v1) { u32x4 w; w.x = cvt_pk_bf16(v0[0], v0[1]); w.y = cvt_pk_bf16(v0[2], v0[3]); w.z = cvt_pk_bf16(v1[0], v1[1]); w.w = cvt_pk_bf16(v1[2], v1[3]); return w; }
__device__ __forceinline__ void unpack8(const u32x4 w, f32x4& v0, f32x4& v1) { v0 = (f32x4){bf_lo(w.x), bf_hi(w.x), bf_lo(w.y), bf_hi(w.y)}; v1 = (f32x4){bf_lo(w.z), bf_hi(w.z), bf_lo(w.w), bf_hi(w.w)}; }

#define PG8_EPI_LOOP_BEGIN \
    _Pragma("unroll") for (int ai = 0; ai < 2; ++ai) _Pragma("unroll") for (int m = 0; m < 4; ++m) { const int row = row0 + ai * HALF + m * 16; \
    _Pragma("unroll") for (int bj = 0; bj < 2; ++bj) { const int lc = lcol + bj * HALF; f32x4 v0 = acc[ai][bj][m][0], v1 = acc[ai][bj][m][1];
#define PG8_EPI_LOOP_END } }

struct EpiInA {
    static constexpr bool PERM = true, AFTER_DRAIN = false;
    bf16_t *R, *C, *Fq; float* FL; size_t fstride;
    __device__ __forceinline__ void operator()(const f32x4 (&acc)[2][2][4][2], const Unit& u, int wr, int wc, int fr, int fq) const {
        const int pn = u.pn, row0 = u.pm * BM + wr * 64 + fr, lcol = wc * 32 + 8 * fq;
        bf16_t* base; int ldc, colt;
        if (pn < 7) {
            PG8_EPI_LOOP_BEGIN
                *(u32x4*)(R + (size_t)row * 1792 + pn * 256 + lc) = pack8(v0, v1);
            PG8_EPI_LOOP_END
            return;
        }
        else if (pn < 13) { base = C; ldc = 1536; colt = (pn - 7) * 256; }
        else if (pn < 19) { const int q = pn - 13; base = C + ((size_t)(Fq - C) + (size_t)(q >> 1) * fstride); ldc = 512; colt = (q & 1) * 256; }
        else {
            if (wc == 0 && fq == 0) {
#pragma unroll
                for (int ai = 0; ai < 2; ++ai)
#pragma unroll
                    for (int m = 0; m < 4; ++m) { float* p = FL + (size_t)(row0 + ai * HALF + m * 16) * 8; *(f32x4*)p = acc[ai][0][m][0]; *(f32x4*)(p + 4) = acc[ai][0][m][1]; }
            }
            return;
        }
        PG8_EPI_LOOP_BEGIN
            *(u32x4*)(base + (size_t)row * ldc + colt + lc) = pack8(v0, v1);
        PG8_EPI_LOOP_END
    }
};
struct EpiLora {
    static constexpr bool PERM = true, AFTER_DRAIN = false;
    float* LW; bf16_t *LAo, *LG; const float *w0, *a0;
    __device__ __forceinline__ void operator()(const f32x4 (&acc)[2][2][4][2], const Unit& u, int wr, int wc, int fr, int fq) const {
        const int pn = u.pn, row0 = u.pm * BM + wr * 64 + fr, lcol = wc * 32 + 8 * fq, colt = (pn & 1) * 256;
        if (pn < 2) {
            PG8_EPI_LOOP_BEGIN
                const int c = colt + lc; const f32x4 b0 = *(const f32x4*)(w0 + c), b1 = *(const f32x4*)(w0 + c + 4); f32x4 o0, o1;
#pragma unroll
                for (int j = 0; j < 4; ++j) { o0[j] = -0.6065306597126334f * fsigmoid(v0[j] + b0[j]); o1[j] = -0.6065306597126334f * fsigmoid(v1[j] + b1[j]); }
                float* p = LW + (size_t)row * 512 + c; *(f32x4*)p = o0; *(f32x4*)(p + 4) = o1;
            PG8_EPI_LOOP_END
        } else if (pn < 4) {
            PG8_EPI_LOOP_BEGIN
                const int c = colt + lc; const f32x4 b0 = *(const f32x4*)(a0 + c), b1 = *(const f32x4*)(a0 + c + 4);
#pragma unroll
                for (int j = 0; j < 4; ++j) { v0[j] = fsigmoid(v0[j] + b0[j]); v1[j] = fsigmoid(v1[j] + b1[j]); }
                *(u32x4*)(LAo + (size_t)row * 512 + c) = pack8(v0, v1);
            PG8_EPI_LOOP_END
        } else {
            PG8_EPI_LOOP_BEGIN
                *(u32x4*)(LG + (size_t)row * 512 + colt + lc) = pack8(v0, v1);
            PG8_EPI_LOOP_END
        }
    }
};
struct EpiGate {
    static constexpr bool PERM = true, AFTER_DRAIN = false;
    bf16_t *G01, *G2; const float* bg; size_t gstride;
    __device__ __forceinline__ void operator()(const f32x4 (&acc)[2][2][4][2], const Unit& u, int wr, int wc, int fr, int fq) const {
        const int pn = u.pn, gi = pn >> 2, row0 = u.pm * BM + wr * 64 + fr, lcol = wc * 32 + 8 * fq, colt = (pn & 3) * 256;
        bf16_t* base = G01 + (size_t)gi * gstride; if (gi == 2) base = G2; const float* bb = bg + gi * 1024;
        PG8_EPI_LOOP_BEGIN
            const int c = colt + lc; const f32x4 b0 = *(const f32x4*)(bb + c), b1 = *(const f32x4*)(bb + c + 4);
#pragma unroll
            for (int j = 0; j < 4; ++j) { v0[j] = fsigmoid(v0[j] + b0[j]); v1[j] = fsigmoid(v1[j] + b1[j]); }
            *(u32x4*)(base + (size_t)row * 1024 + c) = pack8(v0, v1);
        PG8_EPI_LOOP_END
    }
};
struct EpiUp {
    static constexpr bool PERM = true, AFTER_DRAIN = false;
    const bf16_t* G; bf16_t* MG; int accum; int accum_id;
    __device__ __forceinline__ void operator()(const f32x4 (&acc)[2][2][4][2], const Unit& u, int wr, int wc, int fr, int fq) const {
        const int row0 = u.pm * BM + wr * 64 + fr, lcol = wc * 32 + 8 * fq, colt = u.pn * 256;
        PG8_EPI_LOOP_BEGIN
            const size_t off = (size_t)row * 1024 + colt + lc; f32x4 g0, g1; unpack8(*(const u32x4*)(G + off), g0, g1);
            v0 = v0 * g0; v1 = v1 * g1;
#ifdef PROBE_ZERO_BR
            if ((PROBE_ZERO_BR >> accum_id) & 1) { v0 = v0 * 0.f; v1 = v1 * 0.f; }
#endif
            if (accum) { f32x4 p0, p1; unpack8(*(const u32x4*)(MG + off), p0, p1); v0 = v0 + p0; v1 = v1 + p1; }
            *(u32x4*)(MG + off) = pack8(v0, v1);
        PG8_EPI_LOOP_END
    }
};
struct EpiResid {
    static constexpr bool PERM = true, AFTER_DRAIN = false;
    const bf16_t* X; float* Y; float alpha; int zero = 0;
    __device__ __forceinline__ void operator()(const f32x4 (&acc)[2][2][4][2], const Unit& u, int wr, int wc, int fr, int fq) const {
        const int row0 = u.pm * BM + wr * 64 + fr, lcol = wc * 32 + 8 * fq, colt = u.pn * 256;
        PG8_EPI_LOOP_BEGIN
            const size_t off = (size_t)row * 1024 + colt + lc; f32x4 x0, x1; unpack8(*(const u32x4*)(X + off), x0, x1);
            if (zero) { v0 = v0 * 0.f; v1 = v1 * 0.f; }
            v0 = v0 + alpha * x0; v1 = v1 + alpha * x1;
            *(f32x4*)(Y + off) = v0; *(f32x4*)(Y + off + 4) = v1;
        PG8_EPI_LOOP_END
    }
};
struct EpiSwiglu {
    static constexpr bool PERM = true, AFTER_DRAIN = false;
    bf16_t* H; int ldh;
    __device__ __forceinline__ void operator()(const f32x4 (&acc)[2][2][4][2], const Unit& u, int wr, int wc, int fr, int fq) const {
        const int row0 = u.pm * BM + wr * 64 + fr, lcol = wc * 32 + 8 * fq, colt = u.pn * 128;
#pragma unroll
        for (int ai = 0; ai < 2; ++ai)
#pragma unroll
            for (int m = 0; m < 4; ++m) { const int row = row0 + ai * HALF + m * 16;
                f32x4 a0 = acc[ai][0][m][0], a1 = acc[ai][0][m][1]; const f32x4 b0 = acc[ai][1][m][0], b1 = acc[ai][1][m][1];
#pragma unroll
                for (int j = 0; j < 4; ++j) { a0[j] = a0[j] * fsigmoid(a0[j]) * b0[j]; a1[j] = a1[j] * fsigmoid(a1[j]) * b1[j]; }
                *(u32x4*)(H + (size_t)row * ldh + colt + lcol) = pack8(a0, a1); }
    }
};
struct EpiStore {
    static constexpr bool PERM = true, AFTER_DRAIN = false;
    bf16_t* O; int ldc;
    __device__ __forceinline__ void operator()(const f32x4 (&acc)[2][2][4][2], const Unit& u, int wr, int wc, int fr, int fq) const {
        const int row0 = u.pm * BM + wr * 64 + fr, lcol = wc * 32 + 8 * fq, colt = u.pn * 256;
        PG8_EPI_LOOP_BEGIN
            *(u32x4*)(O + (size_t)row * ldc + colt + lc) = pack8(v0, v1);
        PG8_EPI_LOOP_END
    }
};

template <class Epi, class Sched, bool ALIGN_EPI = false, bool GATHER = false>
__device__ __forceinline__ void gemm_phase(PG8_LAS unsigned char* lds, const Gemm g, const Sched& S, const Epi& E) {
    int tid_ = threadIdx.x; asm volatile("" : "+v"(tid_));
    const int tid = tid_, wid = __builtin_amdgcn_readfirstlane(tid >> 6), lane = tid & 63, wr = wid >> 2, wc = wid & 3, fr = lane & 15, fq = lane >> 4;
    const int K = g.K, nt = K / BK;
    unsigned voffA[2], voffB[2]; int rowA[2]; unsigned colA2[2];
#pragma unroll
    for (int i = 0; i < 2; ++i) { int R, C; stage_rc(tid * 16 + i * 8192, R, C); const int Rb = Epi::PERM ? ((R & ~31) + perm32(R & 31)) : R;
        rowA[i] = R; colA2[i] = (unsigned)C * 2u; voffA[i] = (unsigned)(R * g.lda + C) * 2u; voffB[i] = (unsigned)(Rb * g.ldb + C) * 2u; }
    const size_t kstep = (size_t)(BK * 2);
    const unsigned hstepA = (unsigned)HALF * (unsigned)g.lda * 2u;
    const size_t hstepB = (size_t)HALF * g.ldb * 2;
    const size_t tstepA = 2 * (size_t)hstepA, tstepB = 2 * hstepB;
    const unsigned ldsw = (unsigned)wid * 1024u;
    const int aoff = lds_byte(wr * 64 + fr, fq * 8), boff = lds_byte(wc * 32 + fr, fq * 8);
#define PG8_SA(b, h) (((b) * 2 + (h)) * HTB)
#define PG8_SB(b, h) ((4 + (b) * 2 + (h)) * HTB)
#define PG8_STAGE(bufoff, gbase, voff) do { _Pragma("unroll") for (int _i = 0; _i < 2; ++_i) \
        __builtin_amdgcn_global_load_lds((const unsigned*)((const char*)(gbase) + (voff)[_i]), (PG8_LAS unsigned*)(lds + (bufoff) + ldsw + _i * 8192), 16, 0, 0); } while (0)
#define PG8_STAGE_A(bufoff, kbase, h, GO) do { if constexpr (GATHER) PG8_STAGE(bufoff, kbase, GO[h]); else PG8_STAGE(bufoff, (kbase) + (size_t)(h) * hstepA, voffA); } while (0)
#define PG8_LDA(dst, b, h) do { _Pragma("unroll") for (int m = 0; m < 4; ++m) _Pragma("unroll") for (int k = 0; k < 2; ++k) dst[m][k] = *(const PG8_LAS bf16x8*)(lds + PG8_SA(b, h) + aoff + m * 2048 + k * 1024); } while (0)
#define PG8_LDB(dst, b, h) do { _Pragma("unroll") for (int n = 0; n < 2; ++n) _Pragma("unroll") for (int k = 0; k < 2; ++k) dst[n][k] = *(const PG8_LAS bf16x8*)(lds + PG8_SB(b, h) + boff + n * 2048 + k * 1024); } while (0)
#define PG8_MMA(ai, bj, At, Bt) do { __builtin_amdgcn_s_setprio(1); _Pragma("unroll") for (int m = 0; m < 4; ++m) _Pragma("unroll") for (int n = 0; n < 2; ++n) _Pragma("unroll") for (int k = 0; k < 2; ++k) \
        acc[ai][bj][m][n] = __builtin_amdgcn_mfma_f32_16x16x32_bf16(Bt[n][k], At[m][k], acc[ai][bj][m][n], 0, 0, 0); __builtin_amdgcn_s_setprio(0); } while (0)
#define PG8_WAIT_V(n) asm volatile("s_waitcnt vmcnt(" #n ")" ::: "memory")
#define PG8_WAIT_L(n) asm volatile("s_waitcnt lgkmcnt(" #n ")" ::: "memory")
#define PG8_BAR __builtin_amdgcn_s_barrier()
#define PG8_SCHED __builtin_amdgcn_sched_barrier(0)
#define PG8_SETGO(go, u) do { _Pragma("unroll") for (int _h = 0; _h < 2; ++_h) _Pragma("unroll") for (int _i = 0; _i < 2; ++_i) { \
        if constexpr (GATHER) { const int _tok = g.rows[(u).pm * BM + _h * HALF + rowA[_i]]; go[_h][_i] = (unsigned)_tok * (unsigned)(g.lda * 2) + colA2[_i]; asm volatile("" : "+v"(go[_h][_i])); } \
        else go[_h][_i] = 0u; } } while (0)
    Unit cur, nxt; int ui = 0;
    if (!S.next(0, cur)) return;
    f32x4 acc[2][2][4][2];
#pragma unroll
    for (int a = 0; a < 2; ++a)
#pragma unroll
        for (int b = 0; b < 2; ++b)
#pragma unroll
            for (int m = 0; m < 4; ++m)
#pragma unroll
                for (int n = 0; n < 2; ++n) acc[a][b][m][n] = (f32x4){0.f, 0.f, 0.f, 0.f};
    bf16x8 At[4][2], B0[2][2], B1[2][2];
    unsigned goC[2][2], goN[2][2];
    PG8_SETGO(goC, cur);
    const char* cA = GATHER ? (const char*)g.A : (const char*)g.A + (size_t)cur.pm * tstepA;
    const char* cB = (const char*)g.Bt + (size_t)cur.e * g.bstride + (size_t)cur.pn * tstepB;
    S.a_ready(cur);
    PG8_STAGE(PG8_SB(0, 0), cB, voffB); PG8_STAGE(PG8_SB(0, 1), cB + hstepB, voffB); PG8_STAGE_A(PG8_SA(0, 0), cA, 0, goC); PG8_STAGE_A(PG8_SA(0, 1), cA, 1, goC);
    if (wr == 1) PG8_BAR;
    PG8_WAIT_V(2); PG8_BAR;
    PG8_STAGE(PG8_SB(1, 0), cB + kstep, voffB); PG8_STAGE_A(PG8_SA(1, 0), cA + kstep, 0, goC); PG8_STAGE(PG8_SB(1, 1), cB + hstepB + kstep, voffB);
    PG8_WAIT_V(6); PG8_BAR;
    for (;;) {
        const bool has_next = S.next(ui + 1, nxt);
        const char* nA = cA; const char* nB = cB;
        if (has_next) { PG8_SETGO(goN, nxt); nA = GATHER ? (const char*)g.A : (const char*)g.A + (size_t)nxt.pm * tstepA; nB = (const char*)g.Bt + (size_t)nxt.e * g.bstride + (size_t)nxt.pn * tstepB; }
        else {
#pragma unroll
            for (int h = 0; h < 2; ++h)
#pragma unroll
                for (int i = 0; i < 2; ++i) goN[h][i] = goC[h][i]; }
        for (int t = 0; t < nt; t += 2) {
            const bool last = (t == nt - 2);
            const char* a1 = cA + (size_t)(t + 1) * kstep;
            const char* a2 = last ? nA : cA + (size_t)(t + 2) * kstep; const char* b2 = last ? nB : cB + (size_t)(t + 2) * kstep;
            const char* a3 = a2 + kstep; const char* b3 = b2 + kstep;
            unsigned g2[2][2];
#pragma unroll
            for (int h = 0; h < 2; ++h)
#pragma unroll
                for (int i = 0; i < 2; ++i) g2[h][i] = (GATHER && last) ? goN[h][i] : goC[h][i];
            if (last && has_next) S.a_ready(nxt);
            PG8_LDB(B0, 0, 0); PG8_LDB(B1, 0, 1); PG8_SCHED; PG8_LDA(At, 0, 0); PG8_STAGE_A(PG8_SA(1, 1), a1, 1, goC);
            PG8_WAIT_V(8); PG8_WAIT_L(0); PG8_BAR; PG8_MMA(0, 0, At, B0); PG8_MMA(0, 1, At, B1); PG8_BAR; PG8_SCHED;
            PG8_LDA(At, 0, 1); PG8_STAGE(PG8_SB(0, 0), b2, voffB); PG8_STAGE(PG8_SB(0, 1), b2 + hstepB, voffB); PG8_STAGE_A(PG8_SA(0, 0), a2, 0, g2);
            PG8_WAIT_V(8); PG8_WAIT_L(0); PG8_BAR; PG8_MMA(1, 0, At, B0); PG8_MMA(1, 1, At, B1); PG8_BAR; PG8_SCHED;
            PG8_LDB(B0, 1, 0); PG8_LDB(B1, 1, 1); PG8_SCHED; PG8_LDA(At, 1, 0); PG8_STAGE_A(PG8_SA(0, 1), a2, 1, g2);
            PG8_WAIT_V(8); PG8_WAIT_L(0); PG8_BAR; PG8_MMA(0, 0, At, B0); PG8_MMA(0, 1, At, B1); PG8_BAR; PG8_SCHED;
            PG8_LDA(At, 1, 1); PG8_STAGE(PG8_SB(1, 0), b3, voffB); PG8_STAGE(PG8_SB(1, 1), b3 + hstepB, voffB); PG8_STAGE_A(PG8_SA(1, 0), a3, 0, g2);
            PG8_WAIT_V(8); PG8_WAIT_L(0); PG8_BAR; PG8_MMA(1, 0, At, B0); PG8_MMA(1, 1, At, B1); PG8_BAR; PG8_SCHED;
        }
        if constexpr (ALIGN_EPI) { if (wr == 0) PG8_BAR; }
        E(acc, cur, wr, wc, fr, fq); S.done(cur);
        if (!has_next) break;
#pragma unroll
        for (int a = 0; a < 2; ++a)
#pragma unroll
            for (int b = 0; b < 2; ++b)
#pragma unroll
                for (int m = 0; m < 4; ++m)
#pragma unroll
                    for (int n = 0; n < 2; ++n) acc[a][b][m][n] = (f32x4){0.f, 0.f, 0.f, 0.f};
        cur = nxt; cA = nA; cB = nB; ++ui;
#pragma unroll
        for (int h = 0; h < 2; ++h)
#pragma unroll
            for (int i = 0; i < 2; ++i) goC[h][i] = goN[h][i];
        if constexpr (ALIGN_EPI) { if (wr == 1) PG8_BAR; }
    }
    PG8_WAIT_V(0);
    if constexpr (!ALIGN_EPI) { if (wr == 0) PG8_BAR; }
    PG8_BAR;
#undef PG8_SA
#undef PG8_SB
#undef PG8_STAGE
#undef PG8_STAGE_A
#undef PG8_LDA
#undef PG8_LDB
#undef PG8_MMA
#undef PG8_WAIT_V
#undef PG8_WAIT_L
#undef PG8_BAR
#undef PG8_SCHED
#undef PG8_SETGO
}
}
#include <hip/hip_bf16.h>
#include <cmath>
namespace attn_body {
using bf16=__hip_bfloat16;
using bf16x8=__attribute__((ext_vector_type(8)))short;
using s16x4=__attribute__((ext_vector_type(4)))short;
using f32x16=__attribute__((ext_vector_type(16)))float;
using u32x4=__attribute__((ext_vector_type(4)))unsigned;
constexpr int BATCH=4,NHEAD=8,SEQ=8192,D=64,DM=NHEAD*D;
constexpr int NW=8,QBLK=32,QB=QBLK*NW,KVBLK=64,NQB=SEQ/QB;
constexpr int ATTN_PITCH=DM, ATTN_UNIT_ROWS=QB;
__device__ __forceinline__ int crow(int r,int hi){return (r&3)+8*(r>>2)+4*hi;}
#define SBAR() __builtin_amdgcn_sched_barrier(0)
__device__ __forceinline__ void cmask(f32x16&p0,f32x16&p1,int jb,int qrel,int hi){
  const float NEG=-INFINITY; int kb=64*jb+4*hi;
  #pragma unroll
  for(int r=0;r<16;++r){int kv=kb+(r&3)+8*(r>>2); if(kv>qrel)p0[r]=NEG; if(kv+32>qrel)p1[r]=NEG;}
}

constexpr int NSLOT=3, SLOTB=8192;
constexpr int LDS_K=0, LDS_V=NSLOT*SLOTB, LDS_WS=2*NSLOT*SLOTB, LDS_OST=LDS_WS+NW*64*4, LDS_CB=LDS_OST+NW*4096, LDS_BYTES=LDS_CB+SEQ*4;
constexpr float C2=0.125f*1.4426950408889634f;
__device__ __forceinline__ void glds16(const void*gsrc,unsigned lds_dst){unsigned keep;
  asm volatile("s_mov_b32 %0, m0\n\ts_mov_b32 m0, %2\n\ts_nop 0\n\tglobal_load_lds_dwordx4 %1, off\n\ts_mov_b32 m0, %0":"=&s"(keep):"v"(gsrc),"s"(lds_dst):"memory");}
__device__ __forceinline__ float max3f(float a,float b,float c){float r;asm("v_max3_f32 %0, %1, %2, %3":"=v"(r):"v"(a),"v"(b),"v"(c));return r;}
__device__ __forceinline__ float max2f(float a,float b){float r;asm("v_max_f32_e32 %0, %1, %2":"=v"(r):"v"(a),"v"(b));return r;}
__device__ __forceinline__ float fadd_s(float a,float b){float r;asm("v_add_f32_e32 %0, %1, %2":"=v"(r):"v"(a),"v"(b));return r;}
__device__ __forceinline__ float fsub_s(float a,float b){float r;asm("v_sub_f32_e32 %0, %1, %2":"=v"(r):"v"(a),"v"(b));return r;}
typedef float f32x2_t __attribute__((ext_vector_type(2))); typedef __bf16 bf16x2_t __attribute__((ext_vector_type(2)));
__device__ __forceinline__ unsigned cvtpk_s(float lo,float hi){f32x2_t v={lo,hi};bf16x2_t b=__builtin_convertvector(v,bf16x2_t);return __builtin_bit_cast(unsigned,b);}
#define WAIT_BAR(N) asm volatile("s_waitcnt vmcnt(" #N ") lgkmcnt(0)\n\ts_barrier":::"memory")

__device__ __forceinline__ void qkt(f32x16&p0,f32x16&p1,const char*Kslot,const bf16x8*qr,int r32,int hi){
  const char*kb=Kslot+hi*1024+r32*16;
  #pragma unroll
  for(int d0=0;d0<4;++d0){
    const bf16x8 b0=*reinterpret_cast<const bf16x8*>(kb+d0*2048);
    const bf16x8 b1=*reinterpret_cast<const bf16x8*>(kb+d0*2048+512);
    {p0=__builtin_amdgcn_mfma_f32_32x32x16_bf16(b0,qr[d0],p0,0,0,0);p1=__builtin_amdgcn_mfma_f32_32x32x16_bf16(b1,qr[d0],p1,0,0,0);}}
}
typedef __attribute__((address_space(3))) const char* lds_cptr;
typedef short v4i16_t __attribute__((ext_vector_type(4)));
typedef float f32x4_t __attribute__((ext_vector_type(4)));
__device__ __forceinline__ void kload8(bf16x8*kf,lds_cptr kp){
  kf[0]=*(const __attribute__((address_space(3))) bf16x8*)(kp);      kf[1]=*(const __attribute__((address_space(3))) bf16x8*)(kp+512);
  kf[2]=*(const __attribute__((address_space(3))) bf16x8*)(kp+2048); kf[3]=*(const __attribute__((address_space(3))) bf16x8*)(kp+2560);
  kf[4]=*(const __attribute__((address_space(3))) bf16x8*)(kp+4096); kf[5]=*(const __attribute__((address_space(3))) bf16x8*)(kp+4608);
  kf[6]=*(const __attribute__((address_space(3))) bf16x8*)(kp+6144); kf[7]=*(const __attribute__((address_space(3))) bf16x8*)(kp+6656);
}
__device__ __forceinline__ void kload2(bf16x8*kf,lds_cptr kp,int j){ kf[2*j]=*(const __attribute__((address_space(3))) bf16x8*)(kp+j*2048); kf[2*j+1]=*(const __attribute__((address_space(3))) bf16x8*)(kp+j*2048+512); }
__device__ __forceinline__ s16x4 vtr(lds_cptr p){ return __builtin_bit_cast(s16x4,__builtin_amdgcn_ds_read_tr16_b64_v4i16((__attribute__((address_space(3))) v4i16_t*)p)); }
__device__ __forceinline__ float rowmax(const f32x16&p0,const f32x16&p1){
  float a=max3f(p0[0],p0[1],p1[0]),b=max3f(p0[2],p0[3],p1[1]);a=max3f(a,p1[2],p1[3]);
  #pragma unroll
  for(int r=4;r<16;r+=4){a=max3f(a,p0[r],p0[r+1]);b=max3f(b,p0[r+2],p0[r+3]);a=max3f(a,p1[r],p1[r+1]);b=max3f(b,p1[r+2],p1[r+3]);}
  const float m=max2f(a,b);
  auto rr=__builtin_amdgcn_permlane32_swap(__float_as_uint(m),__float_as_uint(m),false,false);
  return max2f(__uint_as_float(rr[0]),__uint_as_float(rr[1]));
}
__device__ __forceinline__ void pv(f32x16*o,int vb,bf16x8 pa0,bf16x8 pa1,bf16x8 pa2,bf16x8 pa3){
  #pragma unroll
  for(int d0=0;d0<2;++d0){s16x4 lo[4],hi[4];
    #pragma unroll
    for(int ks=0;ks<4;++ks){
      asm volatile("ds_read_b64_tr_b16 %0,%1 offset:%c2":"=&v"(lo[ks]):"v"(vb),"i"(d0*4096+ks*1024):"memory");
      asm volatile("ds_read_b64_tr_b16 %0,%1 offset:%c2":"=&v"(hi[ks]):"v"(vb),"i"(d0*4096+ks*1024+512):"memory");}
    asm volatile("s_waitcnt lgkmcnt(0)":::"memory");SBAR();
    #define PK(k) (bf16x8){lo[k][0],lo[k][1],lo[k][2],lo[k][3],hi[k][0],hi[k][1],hi[k][2],hi[k][3]}
    o[d0]=__builtin_amdgcn_mfma_f32_32x32x16_bf16(pa0,PK(0),o[d0],0,0,0);
    o[d0]=__builtin_amdgcn_mfma_f32_32x32x16_bf16(pa1,PK(1),o[d0],0,0,0);
    o[d0]=__builtin_amdgcn_mfma_f32_32x32x16_bf16(pa2,PK(2),o[d0],0,0,0);
    o[d0]=__builtin_amdgcn_mfma_f32_32x32x16_bf16(pa3,PK(3),o[d0],0,0,0);
    #undef PK
  }
}

#ifndef ATTN_STORE16
#define ATTN_STORE16(p,v) (*(u32x4*)(p)=(v))
#endif
template<int THRL> __device__ __forceinline__ void attn_unit(int b,int h,int qb,const bf16*Q,const bf16*__restrict__ K,const bf16*__restrict__ V,bf16*O,const float*cbg,char*shm){
  int tid_=threadIdx.x; asm volatile("":"+v"(tid_)); const int tid=tid_,lane=tid&63,r32=lane&31,hi=lane>>5; const int wid=__builtin_amdgcn_readfirstlane(tid>>6);
  const long rowbase=(long)b*SEQ; const int q0=qb*QB;
  const bf16*Qw=Q+(rowbase+q0+wid*QBLK)*DM+h*D;
  const bf16*Kh=K+rowbase*DM+h*D,*Vh=V+rowbase*DM+h*D;
  const unsigned lds0=(unsigned)(uintptr_t)shm;
  float*wsf=(float*)(shm+LDS_WS)+wid*64;
  const bf16*ksrc=Kh+(long)lane*DM+wid*8;
  const bf16*vsrc=Vh+(long)(16*(wid&3)+(lane>>2))*DM+(wid>>2)*32+(lane&3)*8;
  const unsigned kdst=lds0+LDS_K+wid*1024, vdst=lds0+LDS_V+wid*1024;
  #define DMA_K(t,slot) glds16(ksrc+(long)(t)*KVBLK*DM,(unsigned)__builtin_amdgcn_readfirstlane(kdst+(slot)))
  #define DMA_V(t,slot) glds16(vsrc+(long)(t)*KVBLK*DM,(unsigned)__builtin_amdgcn_readfirstlane(vdst+(slot)))
  const int vb0=(int)(lds0+LDS_V)+((lane>>4)&1)*32+(lane&3)*8+(4*hi+((lane&15)>>2))*64;
  const char*Kbase=shm+LDS_K; bf16x8 kf[8];
  const lds_cptr shm3=(lds_cptr)shm; const lds_cptr kp0=shm3+LDS_K+hi*1024+r32*16; const lds_cptr vp0=shm3+LDS_V+((lane>>4)&1)*32+(lane&3)*8+(4*hi+((lane&15)>>2))*64;
  const int NT=(q0+QB)/KVBLK;
  { const int nfl=q0+QB; for(int i_=tid*4;i_<nfl;i_+=NW*64*4){ const f32x4_t v_=*(const f32x4_t*)(cbg+i_); *(__attribute__((address_space(3))) f32x4_t*)(shm3+LDS_CB+i_*4)=v_; } }
  #define CINIT(C0,C1,t) do{ const __attribute__((address_space(3))) f32x4_t* cb_=(const __attribute__((address_space(3))) f32x4_t*)(shm3+LDS_CB)+((t)*16+hi); \
    _Pragma("unroll") for(int i_=0;i_<4;++i_){ const f32x4_t b0_=cb_[2*i_], b1_=cb_[8+2*i_]; \
      _Pragma("unroll") for(int j_=0;j_<4;++j_){ C0[4*i_+j_]=b0_[j_]-mhat; C1[4*i_+j_]=b1_[j_]-mhat; } } }while(0)
  DMA_K(0,0);DMA_V(0,0);DMA_K(1,SLOTB);
  bf16x8 qr[4];
  #pragma unroll
  for(int d0=0;d0<4;++d0)qr[d0]=*reinterpret_cast<const bf16x8*>(&Qw[(long)r32*DM+d0*16+hi*8]);
  float mhat=0.f,l_reg=0.f;f32x16 o[2];o[0]=f32x16{};o[1]=f32x16{};
  const int qrel=wid*QBLK+r32;
  #define CMASK(P0,P1,t) do{int jb_=(t)-(NT-4); if(jb_>=0)cmask(P0,P1,jb_,qrel,hi);}while(0)
  bool resc=false;
  #define START(P0,P1) do{ const float rm=rowmax(P0,P1); resc=false; \
    { const float dl=rm; mhat=fadd_s(mhat,dl); \
      _Pragma("unroll") for(int r=0;r<16;++r){P0[r]=fsub_s(P0[r],dl);P1[r]=fsub_s(P1[r],dl);} \
      } \
    _Pragma("unroll") for(int r=0;r<16;++r)P0[r]=__builtin_amdgcn_exp2f(P0[r]); }while(0)
  #define RESC() do{ if(resc){ asm volatile("s_waitcnt lgkmcnt(0)":::"memory"); \
      _Pragma("unroll") for(int d_=0;d_<2;++d_) _Pragma("unroll") for(int r=0;r<16;++r)o[d_][r]*=wsf[crow(r,hi)]; } }while(0)
  f32x16 pA0,pA1,pB0,pB1;
  int sl_prev=0,sl_cur=0,sl_next=SLOTB;
  #define ROT() do{sl_prev=sl_cur;sl_cur=sl_next;sl_next=(sl_next==(NSLOT-1)*SLOTB)?0:sl_next+SLOTB;}while(0)
  DMA_K(2,2*SLOTB);
  WAIT_BAR(3);
  CINIT(pA0,pA1,0); qkt(pA0,pA1,Kbase,qr,r32,hi);asm volatile("s_nop 15\n\ts_nop 7":"+v"(pA0),"+v"(pA1));CMASK(pA0,pA1,0);
  START(pA0,pA1);
  _Pragma("unroll") for(int r=0;r<16;++r)pA1[r]=__builtin_amdgcn_exp2f(pA1[r]);
  WAIT_BAR(0);
  DMA_K(3,0);DMA_V(1,SLOTB);
  ROT();
  kload8(kf,kp0+sl_cur);
  WAIT_BAR(2);
  s16x4 vlo[8],vhi[8]; u32x4 pw0,pw1,pw2,pw3;
  #define PKW(P,B) cvtpk_s(P[B],P[B+1])
  #define PAF(k) __builtin_bit_cast(bf16x8,pw##k)
  #define VFR(i) (bf16x8){vlo[i][0],vlo[i][1],vlo[i][2],vlo[i][3],vhi[i][0],vhi[i][1],vhi[i][2],vhi[i][3]}
  #define PIN(x) asm volatile("":"+v"(x))
  #define MX3(a,b,c) __builtin_fmaxf(__builtin_fmaxf((a),(b)),(c))
  #define GAPA(MF,A0,A1,A2,A3,W0,W1,PW) do{ MF; sacc+=A0; sacc+=A1; sacc+=A2; sacc+=A3; PIN(sacc); W0; W1; PIN(PW); SBAR(); }while(0)
  #define EX(v) __builtin_amdgcn_exp2f(v)
  #define GAPB(MF,X,B) do{ MF; X[B]=EX(X[B]); X[B+1]=EX(X[B+1]); X[B+2]=EX(X[B+2]); X[B+3]=EX(X[B+3]); PIN(X); SBAR(); }while(0)
  #define VRD(i) do{ vlo[i]=vtr(vp_+(((i)>>2)*4096+((i)&3)*1024)); vhi[i]=vtr(vp_+(((i)>>2)*4096+((i)&3)*1024+512)); }while(0)
  #define KRD(G,j) do{ if(G){ kload2(kf,kp0+sl_next,j); SBAR(); } }while(0)
  #define STEP(C0,C1,P0,P1,t,GK,GV,GL) do{ SBAR(); CINIT(C0,C1,t); SBAR(); \
    const lds_cptr vp_=vp0+sl_prev; \
    VRD(0); SBAR(); float sacc=(P0[0]+P0[1]); \
    GAPA(C0=__builtin_amdgcn_mfma_f32_32x32x16_bf16(kf[0],qr[0],C0,0,0,0), P0[2],P0[3],P0[4],P0[5],     pw0[0]=PKW(P0,0), pw0[1]=PKW(P0,2), pw0); \
    VRD(4); SBAR(); GAPA(C1=__builtin_amdgcn_mfma_f32_32x32x16_bf16(kf[1],qr[0],C1,0,0,0), P0[6],P0[7],P0[8],P0[9],     pw0[2]=PKW(P0,4), pw0[3]=PKW(P0,6), pw0); \
    VRD(1); SBAR(); GAPA(C0=__builtin_amdgcn_mfma_f32_32x32x16_bf16(kf[2],qr[1],C0,0,0,0),   P0[10],P0[11],P0[12],P0[13], pw1[0]=PKW(P0,8), pw1[1]=PKW(P0,10), pw1); \
    VRD(5); SBAR(); GAPA(C1=__builtin_amdgcn_mfma_f32_32x32x16_bf16(kf[3],qr[1],C1,0,0,0),   P0[14],P0[15],P1[0],P1[1],   pw1[2]=PKW(P0,12),pw1[3]=PKW(P0,14), pw1); \
    VRD(2); SBAR(); GAPA(C0=__builtin_amdgcn_mfma_f32_32x32x16_bf16(kf[4],qr[2],C0,0,0,0),   P1[2],P1[3],P1[4],P1[5],     pw2[0]=PKW(P1,0), pw2[1]=PKW(P1,2), pw2); \
    VRD(6); SBAR(); GAPA(C1=__builtin_amdgcn_mfma_f32_32x32x16_bf16(kf[5],qr[2],C1,0,0,0),   P1[6],P1[7],P1[8],P1[9],     pw2[2]=PKW(P1,4), pw2[3]=PKW(P1,6), pw2); \
    VRD(3); SBAR(); GAPA(C0=__builtin_amdgcn_mfma_f32_32x32x16_bf16(kf[6],qr[3],C0,0,0,0),   P1[10],P1[11],P1[12],P1[13], pw3[0]=PKW(P1,8), pw3[1]=PKW(P1,10), pw3); \
    VRD(7); SBAR(); GAPA(C1=__builtin_amdgcn_mfma_f32_32x32x16_bf16(kf[7],qr[3],C1,0,0,0),   P1[14],P1[15],0.f,0.f,       pw3[2]=PKW(P1,12),pw3[3]=PKW(P1,14), pw3); \
    l_reg+=sacc; \
    if(GK){DMA_K((t)+3,sl_cur);} if(GV){DMA_V((t)+1,sl_next);} \
    CMASK(C0,C1,t); \
    { float a=MX3(C0[0],C0[1],C1[0]),b=MX3(C0[2],C0[3],C1[1]); a=MX3(a,C1[2],C1[3]); \
      _Pragma("unroll") for(int r=4;r<16;r+=4){a=MX3(a,C0[r],C0[r+1]);b=MX3(b,C0[r+2],C0[r+3]);a=MX3(a,C1[r],C1[r+1]);b=MX3(b,C1[r+2],C1[r+3]);} \
      float rm=__builtin_fmaxf(a,b); { auto rr=__builtin_amdgcn_permlane32_swap(__float_as_uint(rm),__float_as_uint(rm),false,false); rm=__builtin_fmaxf(__uint_as_float(rr[0]),__uint_as_float(rr[1])); } \
      resc=false; \
      if(__builtin_expect(__any(rm>(float)THRL),0)){ const float dl=__builtin_fmaxf(rm,0.f); mhat+=dl; \
        _Pragma("unroll") for(int r=0;r<16;++r){C0[r]-=dl;C1[r]-=dl;} \
        const float f=__builtin_amdgcn_exp2f(-dl); l_reg*=f; if(hi==0)wsf[r32]=f; resc=true; } } \
    SBAR(); \
    GAPB(o[0]=__builtin_amdgcn_mfma_f32_32x32x16_bf16(PAF(0),VFR(0),o[0],0,0,0), C0,0); \
    GAPB(o[1]=__builtin_amdgcn_mfma_f32_32x32x16_bf16(PAF(0),VFR(4),o[1],0,0,0), C0,4); \
    KRD(GL,0); GAPB(o[0]=__builtin_amdgcn_mfma_f32_32x32x16_bf16(PAF(1),VFR(1),o[0],0,0,0), C0,8); \
    KRD(GL,1); GAPB(o[1]=__builtin_amdgcn_mfma_f32_32x32x16_bf16(PAF(1),VFR(5),o[1],0,0,0), C0,12); \
    KRD(GL,2); GAPB(o[0]=__builtin_amdgcn_mfma_f32_32x32x16_bf16(PAF(2),VFR(2),o[0],0,0,0), C1,0); \
    KRD(GL,3); GAPB(o[1]=__builtin_amdgcn_mfma_f32_32x32x16_bf16(PAF(2),VFR(6),o[1],0,0,0), C1,4); \
    GAPB(o[0]=__builtin_amdgcn_mfma_f32_32x32x16_bf16(PAF(3),VFR(3),o[0],0,0,0), C1,8); \
    GAPB(o[1]=__builtin_amdgcn_mfma_f32_32x32x16_bf16(PAF(3),VFR(7),o[1],0,0,0), C1,12); \
    }while(0)
  int t=1;
  #undef CMASK
  #define CMASK(P0,P1,t) do{}while(0)
  for(;t+5<NT;t+=2){
    STEP(pB0,pB1,pA0,pA1,t,true,true,true);     WAIT_BAR(2); RESC(); ROT();
    STEP(pA0,pA1,pB0,pB1,t+1,true,true,true);   WAIT_BAR(2); RESC(); ROT();
  }
  #undef CMASK
  #define CMASK(P0,P1,t) do{int jb_=(t)-(NT-4); if(jb_>=0)cmask(P0,P1,jb_,qrel,hi);}while(0)
  #define ENDW(tt) do{ if((tt)+3<NT){WAIT_BAR(2);} else if((tt)+2<NT){WAIT_BAR(1);} else {WAIT_BAR(0);} }while(0)
  for(;t+1<NT;t+=2){
    STEP(pB0,pB1,pA0,pA1,t,(t+3<NT),(t+1<NT),(t+1<NT));       ENDW(t);   RESC(); ROT();
    STEP(pA0,pA1,pB0,pB1,t+1,(t+4<NT),(t+2<NT),(t+2<NT));     ENDW(t+1); RESC(); ROT();
  }
  STEP(pB0,pB1,pA0,pA1,NT-1,false,false,false); RESC();
  { float sacc=pB0[0]+pB0[1]; _Pragma("unroll") for(int r=2;r<16;++r)sacc+=pB0[r]; _Pragma("unroll") for(int r=0;r<16;++r)sacc+=pB1[r]; l_reg+=sacc;
    pw0=(u32x4){PKW(pB0,0),PKW(pB0,2),PKW(pB0,4),PKW(pB0,6)};pw1=(u32x4){PKW(pB0,8),PKW(pB0,10),PKW(pB0,12),PKW(pB0,14)};pw2=(u32x4){PKW(pB1,0),PKW(pB1,2),PKW(pB1,4),PKW(pB1,6)};pw3=(u32x4){PKW(pB1,8),PKW(pB1,10),PKW(pB1,12),PKW(pB1,14)};
    SBAR(); pv(o,vb0+sl_cur,PAF(0),PAF(1),PAF(2),PAF(3)); }
  #undef PKW
  #undef PAF
  #undef VFR
  #undef PIN
  #undef MX3
  #undef GAPA
  #undef GAPB
  #undef EX
  #undef VRD
  #undef KRD
  #undef STEP
  #undef ENDW
  {auto rr=__builtin_amdgcn_permlane32_swap(__float_as_uint(l_reg),__float_as_uint(l_reg),false,false);l_reg=__uint_as_float(rr[0])+__uint_as_float(rr[1]);}
  if(hi==0)wsf[32+r32]=l_reg;asm volatile("s_waitcnt lgkmcnt(0)":::"memory");
  float rli[16];
  #pragma unroll
  for(int r=0;r<16;++r)rli[r]=__builtin_amdgcn_rcpf(wsf[32+crow(r,hi)]);
  bf16*Ow=O+(rowbase+q0+wid*QBLK)*DM+h*D;
  { bf16*stg=(bf16*)(shm+LDS_OST)+wid*2048;
    #pragma unroll
    for(int r=0;r<16;++r){const int orow=crow(r,hi);
      #pragma unroll
      for(int d0=0;d0<2;++d0)stg[orow*64+d0*32+r32]=__float2bfloat16(o[d0][r]*rli[r]);}
    asm volatile("s_waitcnt lgkmcnt(0)":::"memory");
    #pragma unroll
    for(int i=0;i<4;++i){const int row=i*8+(lane>>3),ch=lane&7; const u32x4 v=*(const u32x4*)(stg+row*64+ch*8); ATTN_STORE16(Ow+(long)row*DM+ch*8,v);} }
  asm volatile("s_waitcnt lgkmcnt(0)\n\ts_barrier":::"memory");
  #undef DMA_K
  #undef CINIT
  #undef DMA_V
  #undef CMASK
  #undef START
  #undef RESC
  #undef ROT
}
constexpr int ATTN_LDS_BYTES=LDS_BYTES;
struct AttnTensors { const bf16* Q; const bf16* K; const bf16* V; bf16* O; const float* CB; };
struct AttnUnit { int bh; int qb; };
struct StaticOrder {
  int vcu;
  __device__ __forceinline__ explicit StaticOrder(int grid,int block):vcu((block%8)*(grid/8)+block/8){}
  __device__ __forceinline__ bool next(int i,AttnUnit&u)const{ if(i>=4)return false; const int s=vcu&7; u.bh=vcu>>3; u.qb=(i==0)?s:(i==1)?15-s:(i==2)?16+s:31-s; return true; }
  __device__ __forceinline__ void a_ready(const AttnUnit&)const{}
  __device__ __forceinline__ void done(const AttnUnit&)const{}
};
template<class Sched,int THRL=8> __device__ __forceinline__ void attn_phase(char*lds,const AttnTensors&T,const Sched&S){
  AttnUnit u;
  for(int i=0;S.next(i,u);++i){ S.a_ready(u); attn_unit<THRL>(u.bh/NHEAD,u.bh%NHEAD,u.qb,T.Q,T.K,T.V,T.O,T.CB+(size_t)u.bh*SEQ,lds); S.done(u); }
}
#undef SBAR
#undef WAIT_BAR
}
#define GAS __attribute__((address_space(1)))
#define LAS __attribute__((address_space(3)))
typedef unsigned short bf16;
typedef unsigned v4u __attribute__((ext_vector_type(4)));
typedef float f32x4 __attribute__((ext_vector_type(4)));
typedef short bf16x8 __attribute__((ext_vector_type(8)));
typedef GAS unsigned gu32;
typedef GAS unsigned long long gu64;
#define RLX_AGENT __ATOMIC_RELAXED, __HIP_MEMORY_SCOPE_AGENT
#define LDS_WAIT() asm volatile("s_waitcnt lgkmcnt(0)" ::: "memory")
#define VM_WAIT() asm volatile("s_waitcnt vmcnt(0)" ::: "memory")
__device__ __forceinline__ unsigned long long rt() { return __builtin_amdgcn_s_memrealtime(); }
__device__ __forceinline__ unsigned f2bf(float f) { unsigned u = __builtin_bit_cast(unsigned, f); return (u + 0x7fffu + ((u >> 16) & 1u)) >> 16; }
__device__ __forceinline__ unsigned pk2(float lo, float hi) { return f2bf(lo) | (f2bf(hi) << 16); }

#define XB_TMO      128
#define XB_XCNT(j)  (256  + 64 * (j))
#define XB_XSUB(j)  (1280 + 64 * (j))
#define XB_XGEN(j)  (2304 + 64 * (j))
#define XB_TOP      3328
#define XB_TOPGEN   3392
#define XCD_BAR_WORDS 3456
#define XB_SPIN_CAP (1u << 18)

__device__ __forceinline__ unsigned xb_ld(unsigned* p)              { return __hip_atomic_load(p, __ATOMIC_RELAXED, __HIP_MEMORY_SCOPE_AGENT); }
__device__ __forceinline__ unsigned xb_add(unsigned* p, unsigned v) { return __hip_atomic_fetch_add(p, v, __ATOMIC_RELAXED, __HIP_MEMORY_SCOPE_AGENT); }
__device__ __forceinline__ unsigned xb_xcc_id() { return (unsigned)__builtin_amdgcn_s_getreg((3 << 11) | 20) & 0xFu; }
#define XB_SPIN(cond, bar) do { unsigned _sp = 0; while (cond) { __builtin_amdgcn_s_sleep(1); \
    if ((++_sp & 255u) == 0u) { if (xb_ld(&(bar)[XB_TMO])) break; if (_sp > XB_SPIN_CAP) { atomicAdd(&(bar)[XB_TMO], 1u); break; } } } } while (0)

struct XcdBarrier {
    unsigned* bar; unsigned x;
    volatile LAS unsigned* st;
};

__device__ __forceinline__ XcdBarrier xcd_barrier_post(unsigned* bar, volatile LAS unsigned* st) {
    XcdBarrier b; b.bar = bar; b.x = xb_xcc_id(); b.st = st;
    if (threadIdx.x == 0) (void)xb_add(&bar[XB_XCNT(b.x)], 1u);
    return b;
}
__device__ __forceinline__ void xcd_barrier_complete(unsigned* bar, unsigned x, unsigned& nloc, unsigned& nx) {
    const unsigned G = gridDim.x * gridDim.y * gridDim.z;
    unsigned sum, cnt, mine, sp = 0u;
    for (;;) {
        sum = 0u; cnt = 0u; mine = 0u;
#pragma unroll
        for (unsigned j = 0; j < 16; ++j) { const unsigned c = xb_ld(&bar[XB_XCNT(j)]); sum += c; cnt += (c > 0u) ? 1u : 0u; mine = (j == x) ? c : mine; }
        if (sum == G) break;
        __builtin_amdgcn_s_sleep(1);
        if ((++sp & 255u) == 0u) { if (xb_ld(&bar[XB_TMO])) break; if (sp > XB_SPIN_CAP) { atomicAdd(&bar[XB_TMO], 1u); break; } }
    }
    nloc = mine > 0u ? mine : 1u; nx = cnt > 0u ? cnt : 1u;
}

__device__ __forceinline__ void xcd_barrier(const XcdBarrier& b) {
    asm volatile("s_waitcnt vmcnt(0)" ::: "memory");
    __syncthreads();
    if (threadIdx.x == 0) {
        unsigned* bar = b.bar;
        __builtin_amdgcn_s_waitcnt(0);
        unsigned nloc = b.st[0], nx = b.st[1];
        if (nloc == 0u) { xcd_barrier_complete(bar, b.x, nloc, nx); b.st[0] = nloc; b.st[1] = nx; }
        const unsigned old = xb_add(&bar[XB_XSUB(b.x)], 1u);
        const unsigned gen = old / nloc;
        if (old + 1u == (gen + 1u) * nloc) {
            __builtin_amdgcn_fence(__ATOMIC_RELEASE, "agent");
            asm volatile("s_waitcnt vmcnt(0)" ::: "memory");
            const unsigned og = xb_add(&bar[XB_TOP], 1u);
            const unsigned tg = og / nx;
            if (og + 1u == (tg + 1u) * nx) xb_add(&bar[XB_TOPGEN], 1u);
            else XB_SPIN(xb_ld(&bar[XB_TOPGEN]) == tg, bar);
            __builtin_amdgcn_fence(__ATOMIC_ACQUIRE, "agent");
            xb_add(&bar[XB_XGEN(b.x)], 1u);
            asm volatile("s_waitcnt vmcnt(0)" ::: "memory");
        } else {
            XB_SPIN(xb_ld(&bar[XB_XGEN(b.x)]) == gen, bar);
            __builtin_amdgcn_fence(__ATOMIC_ACQUIRE, "agent");
            asm volatile("s_waitcnt vmcnt(0)" ::: "memory");
        }
    }
    __syncthreads();
}

constexpr int NWAVES = 8, NG = 256, NGW = NG * NWAVES;
constexpr int BATCH = 4, T = 8192, D = 1024, M = BATCH * T, NLAYER = 2;
constexpr int RW = 512, RH = 8;
constexpr int R_COLS = 1792, C_COLS = 1536, IN_COLS = 7944, INA_N = 5120, INP_N = 8192;
constexpr int DFF = 2816, DFFE = 3584, NEXP = 8;
constexpr int MOE_HALF = M / 2, MOE_ROWS = MOE_HALF * 2 + NEXP * 256;
constexpr float LN_EPS = 1e-5f, RWKV_LN_EPS = 64e-5f;
constexpr float DN_ALPHA = 1.4142135623730951f;
constexpr float LOG2E = 1.4426950408889634f;

constexpr size_t MiB = 1u << 20, KiB = 1u << 10;
constexpr size_t WS_CTL = 0, CTL_ZERO_BYTES = 1 * MiB;
constexpr size_t WS_FL = 1 * MiB, WS_CB = 2 * MiB;
constexpr size_t WS_TOKE = 3 * MiB, WS_TOKG = WS_TOKE + 128 * KiB, WS_PPOS = WS_TOKG + 256 * KiB, WS_RTOK = WS_PPOS + 256 * KiB;
constexpr size_t WS_WL = 5 * MiB;
constexpr size_t WS_X = 8 * MiB;
constexpr size_t WS_WIN = 72 * MiB, WS_WUP = 104 * MiB, WS_WOUT = 110 * MiB, WS_W13 = 114 * MiB, WS_W2 = 125 * MiB;
constexpr size_t WS_L = 132 * MiB;
constexpr size_t WS_C = WS_L, WS_FQ = 228 * MiB, WS_FK = 260 * MiB, WS_FV = 292 * MiB, WS_LA = 324 * MiB, WS_LW = 340 * MiB, WS_LAO = 404 * MiB, WS_LG = 436 * MiB,
                 WS_OB = 468 * MiB, WS_OA = 500 * MiB, WS_BV = 532 * MiB;
constexpr size_t WS_G2 = WS_L, WS_MG = WS_FK, WS_H = WS_L;
constexpr size_t WS_WM13 = 72 * MiB, WS_WM2 = 184 * MiB, WS_HM = 240 * MiB, WS_YP = 478 * MiB, WS_END = 580 * MiB;
static_assert(WS_RTOK + 2 * MOE_ROWS * 4 <= 4 * MiB && WS_WL + 2 * 1536 * 256 * 2 <= WS_X, "small tables");
static_assert(WS_W2 + (size_t)D * DFF * 2 <= WS_L && WS_BV + (size_t)M * RW * 2 <= WS_END && WS_H + (size_t)M * DFF * 2 <= WS_END, "ws map");
static_assert(WS_WM13 + (size_t)NEXP * 2 * DFFE * D * 2 == WS_WM2 && WS_WM2 + (size_t)NEXP * D * DFFE * 2 == WS_HM && WS_HM + (size_t)MOE_ROWS * DFFE * 2 == WS_YP && WS_YP + (size_t)MOE_ROWS * D * 2 <= WS_END, "moe map");
constexpr int CW_TMO = 0, CW_CODE = 1, CW_BAR = 4096, CW_QATT = 8192, CW_CNT = 12288, CW_FILL = 14336;

constexpr int RING_OFF = 0, RING_BYTES = 131072;
constexpr int LDSCTL_OFF = RING_BYTES, MISC_OFF = LDSCTL_OFF + 320, PEXP_OFF = LDSCTL_OFF + 1024, MOFF_OFF = LDSCTL_OFF + 2048;
constexpr int LDS_BYTES = 147456;

struct Args { const float* in[34]; float* out; unsigned char* ws; };
struct Frame {
    LAS unsigned char* lds; volatile LAS unsigned* MISC; gu32* ctl;
    int tid, lane, wave, vcu, G;
};
__device__ __forceinline__ float wave_sum(float v) {
#pragma unroll
    for (int o = 1; o < 64; o <<= 1) v += __shfl_xor(v, o);
    return v;
}
template <int CTRL> __device__ __forceinline__ float dpp_mov(float v) { return __builtin_bit_cast(float, __builtin_amdgcn_update_dpp(0, __builtin_bit_cast(int, v), CTRL, 0xf, 0xf, false)); }
__device__ __forceinline__ float red8(float v) { v += dpp_mov<0xB1>(v); v += dpp_mov<0x4E>(v); v += dpp_mov<0x141>(v); return v; }
__device__ __forceinline__ float red16(float v) { v = red8(v); v += dpp_mov<0x140>(v); return v; }
__device__ __forceinline__ float swap32_add(float v) { float a = v, b = v; asm volatile("s_nop 1\n\tv_permlane32_swap_b32 %0, %1" : "+v"(a), "+v"(b)); return a + b; }
__device__ __forceinline__ float bfu(unsigned short u) { return __builtin_bit_cast(float, (unsigned)u << 16); }
__device__ __forceinline__ float bflo(unsigned w) { return __builtin_bit_cast(float, w << 16); }
__device__ __forceinline__ float bfhi(unsigned w) { return __builtin_bit_cast(float, w & 0xffff0000u); }
__device__ __forceinline__ float sigm(float x) { return __builtin_amdgcn_rcpf(1.0f + __expf(-x)); }

__device__ __forceinline__ void tr_item(const float* W, int ldw, int sk0, int n0, int nvalid, bf16* dst, int ldk, int dk0, float scale, LAS float* scr, int lane) {
    const int n_ = lane & 31;
#pragma unroll 8
    for (int i = 0; i < 32; ++i) { const int kk = 2 * i + (lane >> 5); float v = 0.f; if (n_ < nvalid) v = W[(size_t)(sk0 + kk) * ldw + n0 + n_] * scale; scr[kk * 33 + n_] = v; }
    LDS_WAIT(); asm volatile("" ::: "memory");
    const int c = lane & 7;
#pragma unroll
    for (int j = 0; j < 4; ++j) { const int n = (lane >> 3) + 8 * j; const LAS float* s = scr + (8 * c) * 33 + n;
        v4u o; o.x = pk2(s[0 * 33], s[1 * 33]); o.y = pk2(s[2 * 33], s[3 * 33]); o.z = pk2(s[4 * 33], s[5 * 33]); o.w = pk2(s[6 * 33], s[7 * 33]);
        *(GAS v4u*)(dst + (size_t)n * ldk + dk0 + 8 * c) = o; }
    LDS_WAIT(); asm volatile("" ::: "memory");
}

__device__ __forceinline__ void ln_norm(f32x4 (&v)[4], const float* g, const float* b, int lane) {
    float s = 0.f;
#pragma unroll
    for (int j = 0; j < 4; ++j) s += (v[j].x + v[j].y) + (v[j].z + v[j].w);
    const float mean = wave_sum(s) * (1.f / D); float s2 = 0.f;
#pragma unroll
    for (int j = 0; j < 4; ++j) { v[j] = v[j] - mean; s2 += (v[j].x * v[j].x + v[j].y * v[j].y) + (v[j].z * v[j].z + v[j].w * v[j].w); }
    const float rstd = 1.f / sqrtf(wave_sum(s2) * (1.f / D) + LN_EPS);
#pragma unroll
    for (int j = 0; j < 4; ++j) { const f32x4 gg = *(const f32x4*)(g + 4 * lane + 256 * j), bb = *(const f32x4*)(b + 4 * lane + 256 * j); v[j] = v[j] * rstd * gg + bb; }
}
__device__ __forceinline__ void row_store_bf16(bf16* orow, const f32x4 (&v)[4], int lane) {
    GAS unsigned long long* o8 = (GAS unsigned long long*)orow + lane;
#pragma unroll
    for (int j = 0; j < 4; ++j) o8[64 * j] = (unsigned long long)pk2(v[j].x, v[j].y) | ((unsigned long long)pk2(v[j].z, v[j].w) << 32);
}
__device__ __forceinline__ void row_load_bf16(const bf16* row, f32x4 (&v)[4], int lane) {
    const GAS unsigned long long* p = (const GAS unsigned long long*)row + lane;
#pragma unroll
    for (int j = 0; j < 4; ++j) { const unsigned long long w = p[64 * j]; const unsigned lo = (unsigned)w, hi = (unsigned)(w >> 32); v[j] = (f32x4){bflo(lo), bfhi(lo), bflo(hi), bfhi(hi)}; }
}

struct DynAttnOrder {
    gu32* ctr; volatile LAS unsigned* slot; int grp;
    __device__ __forceinline__ bool next(int, attn_body::AttnUnit& u) const {
        if (threadIdx.x == 0) slot[0] = __hip_atomic_fetch_add(ctr, 1u, RLX_AGENT);
        __syncthreads();
        const unsigned v = slot[0];
        __syncthreads();
        if (v >= 128u) return false;
        u.qb = 31 - (int)(v >> 2); u.bh = grp * 4 + (int)(v & 3u); return true;
    }
    __device__ __forceinline__ void a_ready(const attn_body::AttnUnit&) const {}
    __device__ __forceinline__ void done(const attn_body::AttnUnit&) const {}
};

constexpr int SC_TC = 32, SC_BUF = 45056;
typedef float f32x2 __attribute__((ext_vector_type(2)));
struct ScanRegs { float r[5], k[5], v[5], a[4], lw[4]; };
__device__ __forceinline__ void rwkv_scan_unit(const Frame& F, int su, const bf16* Rraw, const bf16* LAo, const float* LW, bf16* OA, bf16* BV,
                                               const float* mu_l, const float* kk_l, const float* ka_l, const float* rk_l) {
    const int bh = su >> 2, qq = su & 3, b = bh >> 3, h = bh & 7;
    const int tid = F.tid, lane = F.lane, w = F.wave;
    const float mu_r = mu_l[h * 64 + lane], mu_k = mu_l[512 + h * 64 + lane], mu_v = mu_l[1024 + h * 64 + lane];
    const float kkc = kk_l[h * 64 + lane], kac = ka_l[h * 64 + lane], rkc = rk_l[h * 64 + lane];
    const int hi = lane >> 5, riw = (lane >> 4) & 1, kidx = (lane & 15) + 16 * hi, row16 = 2 * w + riw;
    const size_t m0 = (size_t)b * T;
    const int hc = h * 64 + lane;
    f32x2 s = (f32x2){0.f, 0.f};
    ScanRegs g;
#define SC_LOAD(c) do { const int tb_ = (c) * SC_TC + 4 * w; const size_t mb_ = m0 + tb_; \
        _Pragma("unroll") for (int j = 0; j < 5; ++j) { const bool ok_ = !(j == 0 && tb_ == 0); const bf16* rp_ = Rraw + (mb_ + j - 1) * R_COLS + hc; \
            g.r[j] = ok_ ? bfu(rp_[0]) : 0.f; g.k[j] = ok_ ? bfu(rp_[512]) : 0.f; g.v[j] = ok_ ? bfu(rp_[1024]) : 0.f; } \
        _Pragma("unroll") for (int j = 0; j < 4; ++j) { g.a[j] = bfu(LAo[(mb_ + j) * RW + hc]); g.lw[j] = LW[(mb_ + j) * RW + hc]; } } while (0)
#define SC_PREP(c, bufp) do { LAS float* B_ = (LAS float*)(bufp); const size_t mb_ = m0 + (c) * SC_TC + 4 * w; \
        _Pragma("unroll") for (int j = 0; j < 4; ++j) { const int tt = 4 * w + j; \
            const float r_ = g.r[j + 1] + mu_r * (g.r[j] - g.r[j + 1]), k_ = g.k[j + 1] + mu_k * (g.k[j] - g.k[j + 1]), v_ = g.v[j + 1] + mu_v * (g.v[j] - g.v[j + 1]); \
            const float a_ = g.a[j], d_ = __expf(g.lw[j]); \
            const float kk0 = k_ * kkc; const float n2 = wave_sum(kk0 * kk0); const float kkn = kk0 / fmaxf(sqrtf(n2), 1e-12f); \
            const float kmod = k_ * (1.f + (a_ - 1.f) * kac); const float bonus = wave_sum(r_ * kmod * rkc); \
            B_[tt * 64 + lane] = d_; B_[2048 + tt * 64 + lane] = -kkn; B_[4096 + tt * 64 + lane] = kkn * a_; B_[6144 + tt * 64 + lane] = kmod; B_[8192 + tt * 64 + lane] = r_; \
            if ((lane >> 4) == qq) { B_[10240 + tt * 16 + (lane & 15)] = v_; BV[(mb_ + j) * RW + hc] = (bf16)f2bf(bonus * v_); } } } while (0)
    LAS unsigned char* buf0 = F.lds + RING_OFF;
    SC_LOAD(0); SC_PREP(0, buf0);
    __syncthreads();
    for (int c = 0; c < T / SC_TC; ++c) {
        LAS unsigned char* bufc = buf0 + (c & 1) * SC_BUF; LAS unsigned char* bufn = buf0 + ((c + 1) & 1) * SC_BUF;
        if (c + 1 < T / SC_TC) SC_LOAD(c + 1);
        const LAS f32x2* Sd2 = (const LAS f32x2*)bufc; const LAS f32x2* Sa2 = Sd2 + 1024; const LAS f32x2* Sb2 = Sd2 + 2048; const LAS f32x2* Sk2 = Sd2 + 3072; const LAS f32x2* Sr2 = Sd2 + 4096;
        const LAS float* Sv = (const LAS float*)bufc + 10240; LAS float* Sy = (LAS float*)bufc + 10240 + 512;
#pragma unroll 4
        for (int tt = 0; tt < SC_TC; ++tt) {
            const f32x2 dv = Sd2[tt * 32 + kidx], av = Sa2[tt * 32 + kidx], bv = Sb2[tt * 32 + kidx], kv = Sk2[tt * 32 + kidx], rv = Sr2[tt * 32 + kidx]; const float vv = Sv[tt * 16 + row16];
            float p = s.x * av.x + s.y * av.y; p = red16(p); p = swap32_add(p);
            s.x = s.x * dv.x + (p * bv.x + vv * kv.x); s.y = s.y * dv.y + (p * bv.y + vv * kv.y);
            float y = s.x * rv.x + s.y * rv.y; y = red16(y); y = swap32_add(y);
            if ((lane & 47) == 0) Sy[tt * 16 + row16] = y;
        }
        __syncthreads();
        { const int tt = tid >> 4, rr = tid & 15; OA[(m0 + (size_t)c * SC_TC + tt) * RW + h * 64 + 16 * qq + rr] = (bf16)f2bf(Sy[tt * 16 + rr]); }
        if (c + 1 < T / SC_TC) SC_PREP(c + 1, bufn);
        __syncthreads();
    }
#undef SC_LOAD
#undef SC_PREP
}

__global__ void __launch_bounds__(NWAVES * 64, 2) mk_fwd(Args args) {
    extern __shared__ __attribute__((aligned(16))) unsigned char lds[];
    {
        const int t0_ = threadIdx.x;
        for (int u = t0_; u < (LDS_BYTES - LDSCTL_OFF) / 4; u += NWAVES * 64) ((LAS unsigned*)((LAS unsigned char*)lds + LDSCTL_OFF))[u] = 0u;
        __syncthreads();
    }
    XcdBarrier bar = xcd_barrier_post((unsigned*)((gu32*)(args.ws + WS_CTL) + CW_BAR), (volatile LAS unsigned*)((LAS unsigned char*)lds + MISC_OFF) + 8);
#define GRID_BAR() do { XcdBarrier b2_ = bar; asm volatile("" : "+s"(b2_.bar), "+s"(b2_.x)); xcd_barrier(b2_); } while (0)
#define PH_BEGIN unsigned char* ws = args.ws; float* outp = args.out; int tid_o_ = threadIdx.x, bx = blockIdx.x; asm volatile("" : "+s"(ws), "+s"(outp), "+v"(tid_o_), "+s"(bx)); \
    gu32* ctl = (gu32*)(ws + WS_CTL); (void)ctl; Frame F; F.lds = (LAS unsigned char*)lds; F.MISC = (volatile LAS unsigned*)(F.lds + MISC_OFF); F.ctl = ctl; \
    F.tid = tid_o_; F.lane = F.tid & 63; F.wave = __builtin_amdgcn_readfirstlane(F.tid >> 6); F.G = NG; F.vcu = (bx % 8) * (NG / 8) + bx / 8; \
    const int lane = F.lane, gw = F.vcu * NWAVES + F.wave; (void)lane; (void)gw
#define FL ((float*)(ws + WS_FL))
#define CB ((float*)(ws + WS_CB))
#define TOKE ((unsigned*)(ws + WS_TOKE))
#define TOKG ((float*)(ws + WS_TOKG))
#define PPOS ((unsigned*)(ws + WS_PPOS))
#define RTOK ((int*)(ws + WS_RTOK))
#define WL ((bf16*)(ws + WS_WL))
#define X ((bf16*)(ws + WS_X))
#define WIN ((bf16*)(ws + WS_WIN))
#define WUP ((bf16*)(ws + WS_WUP))
#define WOUT ((bf16*)(ws + WS_WOUT))
#define W13 ((bf16*)(ws + WS_W13))
#define W2 ((bf16*)(ws + WS_W2))
#define Cb ((bf16*)(ws + WS_C))
#define FQ ((bf16*)(ws + WS_FQ))
#define FK ((bf16*)(ws + WS_FK))
#define FV ((bf16*)(ws + WS_FV))
#define LA ((bf16*)(ws + WS_LA))
#define LW ((float*)(ws + WS_LW))
#define LAO ((bf16*)(ws + WS_LAO))
#define LG ((bf16*)(ws + WS_LG))
#define OB ((bf16*)(ws + WS_OB))
#define OA ((bf16*)(ws + WS_OA))
#define BV ((bf16*)(ws + WS_BV))
#define G2 ((bf16*)(ws + WS_G2))
#define MG ((bf16*)(ws + WS_MG))
#define H ((bf16*)(ws + WS_H))
#define WM13 ((bf16*)(ws + WS_WM13))
#define WM2 ((bf16*)(ws + WS_WM2))
#define HM ((bf16*)(ws + WS_HM))
#define YP ((bf16*)(ws + WS_YP))
#define Rr ((bf16*)outp)
#define G0 ((bf16*)outp)
#define G1 ((bf16*)outp + (size_t)M * D)
#define Y (outp)

    {
        PH_BEGIN;
        LAS float* scr = (LAS float*)(F.lds + RING_OFF + F.wave * 16384);
        constexpr int I_IN = (INP_N / 32) * 16, I_UP = 32 * 8, I_OUT = 32 * 16, I_13 = (2 * DFF / 32) * 16, I_2 = 32 * (DFF / 64), I_L = 48 * 4;
        constexpr int NITEMS = 2 * I_IN + 6 * I_UP + 2 * I_OUT + I_13 + I_2 + 2 * I_L;
        for (int it = gw; it < NITEMS; it += NGW) {
            int r = it;
            if (r < 2 * I_IN) { const int l = r / I_IN; r -= l * I_IN; const int rg = r >> 4, kb = r & 15, d0 = 32 * rg; int n0 = d0, nv = 32;
                if (d0 >= INA_N) n0 = d0 - 248; else if (d0 > 4864) nv = 0; else if (d0 == 4864) nv = 8;
                const float sc = (d0 >= 3328 && d0 < 3840) ? attn_body::C2 : 1.f;
                tr_item(args.in[3] + (size_t)l * D * IN_COLS, IN_COLS, 64 * kb, n0, nv, WIN + ((size_t)l * INP_N + d0) * D, D, 64 * kb, sc, scr, lane); continue; }
            r -= 2 * I_IN;
            if (r < 6 * I_UP) { const int q = r / I_UP; r -= q * I_UP; const int l = q / 3, br = q % 3; const int rg = r >> 3, kb = r & 7;
                const float* W = args.in[18 + br] + (size_t)l * RW * D;
                tr_item(W, D, 64 * kb, 32 * rg, 32, WUP + ((size_t)(l * 3 + br) * D + 32 * rg) * RW, RW, 64 * kb, 1.f, scr, lane); continue; }
            r -= 6 * I_UP;
            if (r < 2 * I_OUT) { const int l = r / I_OUT; r -= l * I_OUT; const int rg = r >> 4, kb = r & 15;
                tr_item(args.in[21] + (size_t)l * D * D, D, 64 * kb, 32 * rg, 32, WOUT + ((size_t)l * D + 32 * rg) * D, D, 64 * kb, 1.f, scr, lane); continue; }
            r -= 2 * I_OUT;
            if (r < I_13) { const int rg = r >> 4, kb = r & 15, d0 = 32 * rg, tile = d0 >> 8, within = d0 & 255;
                const float* W = (within < 128) ? args.in[26] : args.in[27];
                tr_item(W, DFF, 64 * kb, tile * 128 + (within & 127), 32, W13 + (size_t)d0 * D, D, 64 * kb, 1.f, scr, lane); continue; }
            r -= I_13;
            if (r < I_2) { const int rg = r / (DFF / 64), kb = r % (DFF / 64);
                tr_item(args.in[28], D, 64 * kb, 32 * rg, 32, W2 + (size_t)(32 * rg) * DFF, DFF, 64 * kb, 1.f, scr, lane); continue; }
            r -= I_2;
            { const int l = r / I_L; r -= l * I_L; const int rg = r >> 2, kb = r & 3; const float* W = nullptr; int ldw = RW, sk0 = 0, n0 = 0, nv = 0;
                if (rg < 16) { if (kb == 0) { W = args.in[6] + (size_t)l * 64 * RW; n0 = 32 * rg; nv = 32; } }
                else if (rg < 32) { if (kb == 1) { W = args.in[8] + (size_t)l * 64 * RW; n0 = 32 * (rg - 16); nv = 32; } }
                else { if (kb >= 2) { W = args.in[9] + (size_t)l * 128 * RW; sk0 = 64 * (kb - 2); n0 = 32 * (rg - 32); nv = 32; } }
                tr_item(W, ldw, sk0, n0, nv, WL + ((size_t)l * 1536 + 32 * rg) * 256, 256, 64 * kb, 1.f, scr, lane); }
        }
        for (int m = gw; m < M; m += NGW) { f32x4 v[4]; const GAS f32x4* xr = (const GAS f32x4*)(args.in[0] + (size_t)m * D) + lane;
#pragma unroll
            for (int j = 0; j < 4; ++j) v[j] = xr[64 * j];
            ln_norm(v, args.in[1], args.in[2], lane); row_store_bf16(X + (size_t)m * D, v, lane); }
    }
    GRID_BAR();

{ constexpr int l = 0;

        {
            PH_BEGIN;
            pg8::Gemm g{X, WIN + (size_t)l * INP_N * D, D, D, D, 0, nullptr}; pg8::StaticOrder S; S.init(M, INA_N, NG, bx);
            pg8::EpiInA E{Rr, Cb, FQ, FL, (size_t)(WS_FK - WS_FQ) / 2};
            pg8::gemm_phase<pg8::EpiInA, pg8::StaticOrder, true, false>(F.lds + RING_OFF, g, S, E);
        }
        GRID_BAR();
        {
            PH_BEGIN;
            if (F.vcu < 32) {
                const int bh = F.vcu, b = bh >> 3, h = bh & 7; const float bf_ = args.in[16][l * 8 + h];
                LAS float* tot = (LAS float*)(F.lds + RING_OFF);
                float loc[16]; float run = 0.f; const int t0 = F.tid * 16;
#pragma unroll
                for (int i = 0; i < 16; ++i) { const float f = FL[((size_t)b * T + t0 + i) * 8 + h] + bf_; const float ls = fminf(f, 0.f) - log1pf(__expf(-fabsf(f))); run += ls; loc[i] = run; }
                tot[F.tid] = run; __syncthreads();
                float pre = 0.f; for (int i = 0; i < F.tid; ++i) pre += tot[i];
#pragma unroll
                for (int i = 0; i < 16; ++i) CB[(size_t)bh * T + t0 + i] = -(pre + loc[i]) * LOG2E;
                __syncthreads();
            }
            const float* mu = args.in[4] + (size_t)l * R_COLS + 1536; const float* cw = args.in[15] + (size_t)l * 3 * RW;
            const f32x4 mu4 = *(const f32x4*)(mu + 4 * lane);
            f32x4 w0a = *(const f32x4*)(cw + 8 * lane), w0b = *(const f32x4*)(cw + 8 * lane + 4), w1a = *(const f32x4*)(cw + RW + 8 * lane), w1b = *(const f32x4*)(cw + RW + 8 * lane + 4),
                  w2a = *(const f32x4*)(cw + 2 * RW + 8 * lane), w2b = *(const f32x4*)(cw + 2 * RW + 8 * lane + 4);
            for (int m = gw; m < M; m += NGW) {
                const int t = m & (T - 1);
                {
                    const bf16* rp = Rr + (size_t)m * R_COLS + 1536 + 4 * lane; const pg8::u32x2 cu = *(const pg8::u32x2*)rp; pg8::u32x2 pv = (pg8::u32x2){0u, 0u}; if (t > 0) pv = *(const pg8::u32x2*)(rp - R_COLS);
                    f32x4 c4 = (f32x4){bflo(cu.x), bfhi(cu.x), bflo(cu.y), bfhi(cu.y)}, p4 = (f32x4){bflo(pv.x), bfhi(pv.x), bflo(pv.y), bfhi(pv.y)};
                    f32x4 o = c4 + mu4 * (p4 - c4);
                    if (lane < 16) {
#pragma unroll
                        for (int j = 0; j < 4; ++j) o[j] = 2.f * sigm(2.f * o[j]) - 1.f;
                    } else if (lane >= 32) {
#pragma unroll
                        for (int j = 0; j < 4; ++j) o[j] = sigm(o[j]);
                    }
                    pg8::u32x2 ou; ou.x = pk2(o[0], o[1]); ou.y = pk2(o[2], o[3]); *(pg8::u32x2*)(LA + (size_t)m * 256 + 4 * lane) = ou;
                }
                {
                    const bf16* cp = Cb + (size_t)m * C_COLS + 8 * lane; f32x4 u0a, u0b, u1a, u1b, u2a, u2b, ba, bb, ca, cb_, ha, hb;
                    pg8::unpack8(*(const pg8::u32x4*)cp, ba, bb);
                    pg8::unpack8(*(const pg8::u32x4*)(cp + 512), ca, cb_); pg8::unpack8(*(const pg8::u32x4*)(cp + 1024), ha, hb); u0a = ca * ha; u0b = cb_ * hb;
                    if (t >= 1) { pg8::unpack8(*(const pg8::u32x4*)(cp - C_COLS + 512), ca, cb_); pg8::unpack8(*(const pg8::u32x4*)(cp - C_COLS + 1024), ha, hb); u1a = ca * ha; u1b = cb_ * hb; } else { u1a = (f32x4){0.f, 0.f, 0.f, 0.f}; u1b = u1a; }
                    if (t >= 2) { pg8::unpack8(*(const pg8::u32x4*)(cp - 2 * C_COLS + 512), ca, cb_); pg8::unpack8(*(const pg8::u32x4*)(cp - 2 * C_COLS + 1024), ha, hb); u2a = ca * ha; u2b = cb_ * hb; } else { u2a = (f32x4){0.f, 0.f, 0.f, 0.f}; u2b = u2a; }
                    const f32x4 ya = ba * (w0a * u2a + w1a * u1a + w2a * u0a), yb = bb * (w0b * u2b + w1b * u1b + w2b * u0b);
                    *(pg8::u32x4*)(OB + (size_t)m * RW + 8 * lane) = pg8::pack8(ya, yb);
                }
            }
        }
        GRID_BAR();
        {
            PH_BEGIN;
            pg8::Gemm g{LA, WL + (size_t)l * 1536 * 256, 256, 256, 256, 0, nullptr}; pg8::StaticOrder S; S.init(M, 1536, NG, bx);
            pg8::EpiLora E{LW, LAO, LG, args.in[5] + (size_t)l * RW, args.in[7] + (size_t)l * RW};
            pg8::gemm_phase<pg8::EpiLora, pg8::StaticOrder, true, false>(F.lds + RING_OFF, g, S, E);
        }
        GRID_BAR();
        {
            PH_BEGIN;
            const int grp = bx & 7, jj = bx >> 3;
            if (jj < 16) rwkv_scan_unit(F, grp * 16 + jj, Rr, LAO, LW, OA, BV, args.in[4] + (size_t)l * R_COLS, args.in[10] + (size_t)l * RW, args.in[11] + (size_t)l * RW, args.in[12] + (size_t)l * RW);
            const attn_body::AttnTensors AT{(const attn_body::bf16*)FQ, (const attn_body::bf16*)FK, (const attn_body::bf16*)FV, (attn_body::bf16*)FQ, CB};
            const DynAttnOrder S{ctl + CW_QATT + 1024 * l + 64 * grp, F.MISC + 0, grp};
            attn_body::attn_phase<DynAttnOrder, 12>((char*)lds + RING_OFF, AT, S);
        }
        GRID_BAR();
        {
            PH_BEGIN;
            const float* lg = args.in[13] + (size_t)l * RW + 8 * lane; const float* lb = args.in[14] + (size_t)l * RW + 8 * lane;
            const f32x4 lga = *(const f32x4*)lg, lgb = *(const f32x4*)(lg + 4), lba = *(const f32x4*)lb, lbb = *(const f32x4*)(lb + 4);
            for (int m = gw; m < M; m += NGW) {
                const size_t off = (size_t)m * RW + 8 * lane; f32x4 ya, yb, ba, bb, ga, gb;
                pg8::unpack8(*(const pg8::u32x4*)(OA + off), ya, yb); pg8::unpack8(*(const pg8::u32x4*)(BV + off), ba, bb); pg8::unpack8(*(const pg8::u32x4*)(LG + off), ga, gb);
                float s = (ya[0] + ya[1]) + (ya[2] + ya[3]) + (yb[0] + yb[1]) + (yb[2] + yb[3]); s = red8(s); const float mean = s * (1.f / 64.f);
                ya = ya - mean; yb = yb - mean;
                float q = (ya[0] * ya[0] + ya[1] * ya[1]) + (ya[2] * ya[2] + ya[3] * ya[3]) + (yb[0] * yb[0] + yb[1] * yb[1]) + (yb[2] * yb[2] + yb[3] * yb[3]); q = red8(q);
                const float rstd = 1.f / sqrtf(q * (1.f / 64.f) + RWKV_LN_EPS);
                ya = (ya * rstd * lga + lba + ba) * ga; yb = (yb * rstd * lgb + lbb + bb) * gb;
                *(pg8::u32x4*)(OA + off) = pg8::pack8(ya, yb);
            }
            pg8::Gemm g{X, WIN + ((size_t)l * INP_N + INA_N) * D, D, D, D, 0, nullptr}; pg8::StaticOrder S; S.init(M, 3 * D, NG, bx);
            pg8::EpiGate E{G0, G2, args.in[17] + (size_t)l * 3 * D, (size_t)M * D};
            pg8::gemm_phase<pg8::EpiGate, pg8::StaticOrder, true, false>(F.lds + RING_OFF, g, S, E);
        }
        GRID_BAR();
        for (int br = 0; br < 3; ++br) {
            PH_BEGIN;
            const size_t aoff_ = (br == 0) ? WS_OA : ((br == 1) ? WS_OB : WS_FQ); const bf16* Ai = (const bf16*)(ws + aoff_); const bf16* Gi = G0 + (size_t)br * M * D; if (br == 2) Gi = G2;
            pg8::Gemm g{Ai, WUP + (size_t)(l * 3 + br) * D * RW, RW, RW, RW, 0, nullptr}; pg8::StaticOrder S; S.init(M, D, NG, bx);
            pg8::EpiUp E{Gi, MG, br, br};
            pg8::gemm_phase<pg8::EpiUp, pg8::StaticOrder, true, false>(F.lds + RING_OFF, g, S, E);
        }
        GRID_BAR();
        {
            PH_BEGIN;
            pg8::Gemm g{MG, WOUT + (size_t)l * D * D, D, D, D, 0, nullptr}; pg8::StaticOrder S; S.init(M, D, NG, bx);
            pg8::EpiResid E{X, Y, DN_ALPHA};
            pg8::gemm_phase<pg8::EpiResid, pg8::StaticOrder, true, false>(F.lds + RING_OFF, g, S, E);
        }
        GRID_BAR();
        {
            PH_BEGIN;
            const float* g1 = args.in[22] + (size_t)l * D; const float* b1 = args.in[23] + (size_t)l * D;
            const bool moe = (l & 1) != 0;
            LAS float* rwl = (LAS float*)(F.lds + RING_OFF);
            if (moe) { for (int i = F.tid; i < D * NEXP / 4; i += NWAVES * 64) ((LAS f32x4*)rwl)[i] = ((const f32x4*)(args.in[29] + (size_t)(l >> 1) * D * NEXP))[i]; __syncthreads(); }
            for (int m = gw; m < M; m += NGW) { f32x4 v[4]; const GAS f32x4* yr = (const GAS f32x4*)(Y + (size_t)m * D) + lane;
#pragma unroll
                for (int j = 0; j < 4; ++j) v[j] = yr[64 * j];
                ln_norm(v, g1, b1, lane); row_store_bf16(X + (size_t)m * D, v, lane);
                if (moe) {
                    float lgt[8];
#pragma unroll
                    for (int e = 0; e < 8; ++e) lgt[e] = 0.f;
#pragma unroll
                    for (int j = 0; j < 4; ++j)
#pragma unroll
                        for (int i = 0; i < 4; ++i) { const LAS f32x4* wp = (const LAS f32x4*)(rwl + (size_t)(4 * lane + 256 * j + i) * 8); const f32x4 wa = wp[0], wb = wp[1]; const float xv = v[j][i];
                            lgt[0] += xv * wa[0]; lgt[1] += xv * wa[1]; lgt[2] += xv * wa[2]; lgt[3] += xv * wa[3]; lgt[4] += xv * wb[0]; lgt[5] += xv * wb[1]; lgt[6] += xv * wb[2]; lgt[7] += xv * wb[3]; }
#pragma unroll
                    for (int e = 0; e < 8; ++e) lgt[e] = wave_sum(lgt[e]) + args.in[30][(l >> 1) * NEXP + e];
                    if (lane == 0) {
                        int e1 = 0; float v1 = lgt[0];
#pragma unroll
                        for (int e = 1; e < 8; ++e) if (lgt[e] > v1) { v1 = lgt[e]; e1 = e; }
                        int e2 = -1; float v2 = -INFINITY;
#pragma unroll
                        for (int e = 0; e < 8; ++e) if (e != e1 && lgt[e] > v2) { v2 = lgt[e]; e2 = e; }
                        const float gA = 1.f / (1.f + __expf(v2 - v1));
                        TOKE[m] = (unsigned)e1 | ((unsigned)e2 << 8); TOKG[2 * m] = gA; TOKG[2 * m + 1] = 1.f - gA;
                        const int hf = m / MOE_HALF;
                        __hip_atomic_fetch_add(ctl + CW_CNT + 64 * (hf * 8 + e1), 1u, RLX_AGENT); __hip_atomic_fetch_add(ctl + CW_CNT + 64 * (hf * 8 + e2), 1u, RLX_AGENT);
                    }
                }
            }
            if (moe) {
                __syncthreads();
                LAS float* scr = (LAS float*)(F.lds + RING_OFF + 32768 + F.wave * 8448);
                const int li = l >> 1; constexpr int I_13 = (2 * DFFE / 32) * 16, I_2 = 32 * (DFFE / 64);
                for (int it = gw; it < NEXP * (I_13 + I_2); it += NGW) {
                    const int e = it / (I_13 + I_2); int r = it - e * (I_13 + I_2);
                    if (r < I_13) { const int rg = r >> 4, kb = r & 15, d0 = 32 * rg, tile = d0 >> 8, within = d0 & 255;
                        const float* W = ((within < 128) ? args.in[31] : args.in[32]) + ((size_t)li * NEXP + e) * D * DFFE;
                        tr_item(W, DFFE, 64 * kb, tile * 128 + (within & 127), 32, WM13 + ((size_t)e * 2 * DFFE + d0) * D, D, 64 * kb, 1.f, scr, lane); }
                    else { r -= I_13; const int rg = r / (DFFE / 64), kb = r % (DFFE / 64);
                        tr_item(args.in[33] + ((size_t)li * NEXP + e) * DFFE * D, D, 64 * kb, 32 * rg, 32, WM2 + ((size_t)e * D + 32 * rg) * DFFE, DFFE, 64 * kb, 1.f, scr, lane); }
                }
            }
        }
        GRID_BAR();
        if constexpr ((l & 1) == 0) {
            {
                PH_BEGIN;
                pg8::Gemm g{X, W13, D, D, D, 0, nullptr}; pg8::StaticOrder S; S.init(M, 2 * DFF, NG, bx);
                pg8::EpiSwiglu E{H, DFF};
                pg8::gemm_phase<pg8::EpiSwiglu, pg8::StaticOrder, true, false>(F.lds + RING_OFF, g, S, E);
            }
            GRID_BAR();
            {
                PH_BEGIN;
                pg8::Gemm g{H, W2, DFF, DFF, DFF, 0, nullptr}; pg8::StaticOrder S; S.init(M, D, NG, bx);
                pg8::EpiResid E{X, Y, DN_ALPHA};
#if defined(PROBE_ZERO_FFN) && (PROBE_ZERO_FFN & 1)
                E.zero = 1;
#endif
                pg8::gemm_phase<pg8::EpiResid, pg8::StaticOrder, true, false>(F.lds + RING_OFF, g, S, E);
            }
            GRID_BAR();
            {
                PH_BEGIN;
                const float* g2 = args.in[24] + (size_t)l * D; const float* b2 = args.in[25] + (size_t)l * D;
                for (int m = gw; m < M; m += NGW) { f32x4 v[4]; const GAS f32x4* yr = (const GAS f32x4*)(Y + (size_t)m * D) + lane;
#pragma unroll
                    for (int j = 0; j < 4; ++j) v[j] = yr[64 * j];
                    ln_norm(v, g2, b2, lane);
                    if (l == NLAYER - 1) { GAS f32x4* o = (GAS f32x4*)(outp + (size_t)m * D) + lane;
#pragma unroll
                        for (int j = 0; j < 4; ++j) o[64 * j] = v[j]; }
                    else row_store_bf16(X + (size_t)m * D, v, lane); }
            }
            GRID_BAR();
        } else {
            LAS int* moff = (LAS int*)((LAS unsigned char*)lds + MOFF_OFF);
            LAS int* pexp = (LAS int*)((LAS unsigned char*)lds + PEXP_OFF);
            { PH_BEGIN;
            if (F.tid < 2) { int o = 0; for (int e = 0; e < NEXP; ++e) { moff[F.tid * 9 + e] = o; const int c = (int)__hip_atomic_load(ctl + CW_CNT + 64 * (F.tid * 8 + e), RLX_AGENT); o += (c + 255) & ~255; } moff[F.tid * 9 + 8] = o; }
            __syncthreads();
            {
                const int m = F.vcu * (NWAVES * 64) + F.tid;
                if (m < M) { const int hf = m / MOE_HALF; const unsigned te = TOKE[m];
#pragma unroll
                    for (int s = 0; s < 2; ++s) { const int e = (int)((te >> (8 * s)) & 255u); const unsigned rk = __hip_atomic_fetch_add(ctl + CW_FILL + 64 * (hf * 8 + e), 1u, RLX_AGENT);
                        const int pos = moff[hf * 9 + e] + (int)rk; PPOS[2 * m + s] = (unsigned)pos; RTOK[hf * MOE_ROWS + pos] = m; } }
                if (F.vcu >= 64 && F.vcu < 66) { const int hf = F.vcu - 64;
                    for (int e = 0; e < NEXP; ++e) { const int c = (int)__hip_atomic_load(ctl + CW_CNT + 64 * (hf * 8 + e), RLX_AGENT); const int p0 = moff[hf * 9 + e] + c, p1 = moff[hf * 9 + e + 1];
                        for (int p = p0 + F.tid; p < p1; p += NWAVES * 64) RTOK[hf * MOE_ROWS + p] = hf * MOE_HALF; } }
            } }
            GRID_BAR();
{ constexpr int hf = 0;

                const int npan = moff[hf * 9 + 8] >> 8;
                __syncthreads();
                int tp_ = threadIdx.x; asm volatile("" : "+v"(tp_));
                for (int p = tp_; p < npan; p += NWAVES * 64) { int e = 0;
#pragma unroll
                    for (int q = 1; q < NEXP; ++q) if (p * 256 >= moff[hf * 9 + q]) e = q;
                    pexp[p] = e; }
                __syncthreads();
                {
                    PH_BEGIN;
                    pg8::Gemm g{X, WM13, D, D, D, (size_t)2 * DFFE * D * 2, RTOK + hf * MOE_ROWS}; pg8::GroupedOrder S; S.so.init_tiles(npan, 2 * DFFE / 256, NG, bx); S.pexp = pexp;
                    pg8::EpiSwiglu E{HM, DFFE};
                    pg8::gemm_phase<pg8::EpiSwiglu, pg8::GroupedOrder, true, true>(F.lds + RING_OFF, g, S, E);
                }
                GRID_BAR();
                {
                    PH_BEGIN;
                    pg8::Gemm g{HM, WM2, DFFE, DFFE, DFFE, (size_t)D * DFFE * 2, nullptr}; pg8::GroupedOrder S; S.so.init_tiles(npan, D / 256, NG, bx); S.pexp = pexp;
                    pg8::EpiStore E{YP, D};
                    pg8::gemm_phase<pg8::EpiStore, pg8::GroupedOrder, true, false>(F.lds + RING_OFF, g, S, E);
                }
                GRID_BAR();
                {
                    PH_BEGIN;
                    const float* g2 = args.in[24] + (size_t)l * D; const float* b2 = args.in[25] + (size_t)l * D;
                    for (int mm = gw; mm < MOE_HALF; mm += NGW) { const int m = hf * MOE_HALF + mm;
                        f32x4 v[4], a[4], c[4]; row_load_bf16(X + (size_t)m * D, v, lane);
                        const unsigned p1 = PPOS[2 * m], p2 = PPOS[2 * m + 1]; const float ga = TOKG[2 * m], gb = TOKG[2 * m + 1];
                        row_load_bf16(YP + (size_t)p1 * D, a, lane); row_load_bf16(YP + (size_t)p2 * D, c, lane);
#pragma unroll
                        for (int j = 0; j < 4; ++j) v[j] = DN_ALPHA * v[j] + PROBE_MOE_SCALE * (ga * a[j] + gb * c[j]);
                        ln_norm(v, g2, b2, lane);
                        if (l == NLAYER - 1) { GAS f32x4* o = (GAS f32x4*)(outp + (size_t)m * D) + lane;
#pragma unroll
                            for (int j = 0; j < 4; ++j) o[64 * j] = v[j]; }
                        else row_store_bf16(X + (size_t)m * D, v, lane); }
                }

}
{ constexpr int hf = 1;

                const int npan = moff[hf * 9 + 8] >> 8;
                __syncthreads();
                int tp_ = threadIdx.x; asm volatile("" : "+v"(tp_));
                for (int p = tp_; p < npan; p += NWAVES * 64) { int e = 0;
#pragma unroll
                    for (int q = 1; q < NEXP; ++q) if (p * 256 >= moff[hf * 9 + q]) e = q;
                    pexp[p] = e; }
                __syncthreads();
                {
                    PH_BEGIN;
                    pg8::Gemm g{X, WM13, D, D, D, (size_t)2 * DFFE * D * 2, RTOK + hf * MOE_ROWS}; pg8::GroupedOrder S; S.so.init_tiles(npan, 2 * DFFE / 256, NG, bx); S.pexp = pexp;
                    pg8::EpiSwiglu E{HM, DFFE};
                    pg8::gemm_phase<pg8::EpiSwiglu, pg8::GroupedOrder, true, true>(F.lds + RING_OFF, g, S, E);
                }
                GRID_BAR();
                {
                    PH_BEGIN;
                    pg8::Gemm g{HM, WM2, DFFE, DFFE, DFFE, (size_t)D * DFFE * 2, nullptr}; pg8::GroupedOrder S; S.so.init_tiles(npan, D / 256, NG, bx); S.pexp = pexp;
                    pg8::EpiStore E{YP, D};
                    pg8::gemm_phase<pg8::EpiStore, pg8::GroupedOrder, true, false>(F.lds + RING_OFF, g, S, E);
                }
                GRID_BAR();
                {
                    PH_BEGIN;
                    const float* g2 = args.in[24] + (size_t)l * D; const float* b2 = args.in[25] + (size_t)l * D;
                    for (int mm = gw; mm < MOE_HALF; mm += NGW) { const int m = hf * MOE_HALF + mm;
                        f32x4 v[4], a[4], c[4]; row_load_bf16(X + (size_t)m * D, v, lane);
                        const unsigned p1 = PPOS[2 * m], p2 = PPOS[2 * m + 1]; const float ga = TOKG[2 * m], gb = TOKG[2 * m + 1];
                        row_load_bf16(YP + (size_t)p1 * D, a, lane); row_load_bf16(YP + (size_t)p2 * D, c, lane);
#pragma unroll
                        for (int j = 0; j < 4; ++j) v[j] = DN_ALPHA * v[j] + PROBE_MOE_SCALE * (ga * a[j] + gb * c[j]);
                        ln_norm(v, g2, b2, lane);
                        if (l == NLAYER - 1) { GAS f32x4* o = (GAS f32x4*)(outp + (size_t)m * D) + lane;
#pragma unroll
                            for (int j = 0; j < 4; ++j) o[64 * j] = v[j]; }
                        else row_store_bf16(X + (size_t)m * D, v, lane); }
                }

}

            if (l != NLAYER - 1) GRID_BAR();
        }

}
{ constexpr int l = 1;

        {
            PH_BEGIN;
            pg8::Gemm g{X, WIN + (size_t)l * INP_N * D, D, D, D, 0, nullptr}; pg8::StaticOrder S; S.init(M, INA_N, NG, bx);
            pg8::EpiInA E{Rr, Cb, FQ, FL, (size_t)(WS_FK - WS_FQ) / 2};
            pg8::gemm_phase<pg8::EpiInA, pg8::StaticOrder, true, false>(F.lds + RING_OFF, g, S, E);
        }
        GRID_BAR();
        {
            PH_BEGIN;
            if (F.vcu < 32) {
                const int bh = F.vcu, b = bh >> 3, h = bh & 7; const float bf_ = args.in[16][l * 8 + h];
                LAS float* tot = (LAS float*)(F.lds + RING_OFF);
                float loc[16]; float run = 0.f; const int t0 = F.tid * 16;
#pragma unroll
                for (int i = 0; i < 16; ++i) { const float f = FL[((size_t)b * T + t0 + i) * 8 + h] + bf_; const float ls = fminf(f, 0.f) - log1pf(__expf(-fabsf(f))); run += ls; loc[i] = run; }
                tot[F.tid] = run; __syncthreads();
                float pre = 0.f; for (int i = 0; i < F.tid; ++i) pre += tot[i];
#pragma unroll
                for (int i = 0; i < 16; ++i) CB[(size_t)bh * T + t0 + i] = -(pre + loc[i]) * LOG2E;
                __syncthreads();
            }
            const float* mu = args.in[4] + (size_t)l * R_COLS + 1536; const float* cw = args.in[15] + (size_t)l * 3 * RW;
            const f32x4 mu4 = *(const f32x4*)(mu + 4 * lane);
            f32x4 w0a = *(const f32x4*)(cw + 8 * lane), w0b = *(const f32x4*)(cw + 8 * lane + 4), w1a = *(const f32x4*)(cw + RW + 8 * lane), w1b = *(const f32x4*)(cw + RW + 8 * lane + 4),
                  w2a = *(const f32x4*)(cw + 2 * RW + 8 * lane), w2b = *(const f32x4*)(cw + 2 * RW + 8 * lane + 4);
            for (int m = gw; m < M; m += NGW) {
                const int t = m & (T - 1);
                {
                    const bf16* rp = Rr + (size_t)m * R_COLS + 1536 + 4 * lane; const pg8::u32x2 cu = *(const pg8::u32x2*)rp; pg8::u32x2 pv = (pg8::u32x2){0u, 0u}; if (t > 0) pv = *(const pg8::u32x2*)(rp - R_COLS);
                    f32x4 c4 = (f32x4){bflo(cu.x), bfhi(cu.x), bflo(cu.y), bfhi(cu.y)}, p4 = (f32x4){bflo(pv.x), bfhi(pv.x), bflo(pv.y), bfhi(pv.y)};
                    f32x4 o = c4 + mu4 * (p4 - c4);
                    if (lane < 16) {
#pragma unroll
                        for (int j = 0; j < 4; ++j) o[j] = 2.f * sigm(2.f * o[j]) - 1.f;
                    } else if (lane >= 32) {
#pragma unroll
                        for (int j = 0; j < 4; ++j) o[j] = sigm(o[j]);
                    }
                    pg8::u32x2 ou; ou.x = pk2(o[0], o[1]); ou.y = pk2(o[2], o[3]); *(pg8::u32x2*)(LA + (size_t)m * 256 + 4 * lane) = ou;
                }
                {
                    const bf16* cp = Cb + (size_t)m * C_COLS + 8 * lane; f32x4 u0a, u0b, u1a, u1b, u2a, u2b, ba, bb, ca, cb_, ha, hb;
                    pg8::unpack8(*(const pg8::u32x4*)cp, ba, bb);
                    pg8::unpack8(*(const pg8::u32x4*)(cp + 512), ca, cb_); pg8::unpack8(*(const pg8::u32x4*)(cp + 1024), ha, hb); u0a = ca * ha; u0b = cb_ * hb;
                    if (t >= 1) { pg8::unpack8(*(const pg8::u32x4*)(cp - C_COLS + 512), ca, cb_); pg8::unpack8(*(const pg8::u32x4*)(cp - C_COLS + 1024), ha, hb); u1a = ca * ha; u1b = cb_ * hb; } else { u1a = (f32x4){0.f, 0.f, 0.f, 0.f}; u1b = u1a; }
                    if (t >= 2) { pg8::unpack8(*(const pg8::u32x4*)(cp - 2 * C_COLS + 512), ca, cb_); pg8::unpack8(*(const pg8::u32x4*)(cp - 2 * C_COLS + 1024), ha, hb); u2a = ca * ha; u2b = cb_ * hb; } else { u2a = (f32x4){0.f, 0.f, 0.f, 0.f}; u2b = u2a; }
                    const f32x4 ya = ba * (w0a * u2a + w1a * u1a + w2a * u0a), yb = bb * (w0b * u2b + w1b * u1b + w2b * u0b);
                    *(pg8::u32x4*)(OB + (size_t)m * RW + 8 * lane) = pg8::pack8(ya, yb);
                }
            }
        }
        GRID_BAR();
        {
            PH_BEGIN;
            pg8::Gemm g{LA, WL + (size_t)l * 1536 * 256, 256, 256, 256, 0, nullptr}; pg8::StaticOrder S; S.init(M, 1536, NG, bx);
            pg8::EpiLora E{LW, LAO, LG, args.in[5] + (size_t)l * RW, args.in[7] + (size_t)l * RW};
            pg8::gemm_phase<pg8::EpiLora, pg8::StaticOrder, true, false>(F.lds + RING_OFF, g, S, E);
        }
        GRID_BAR();
        {
            PH_BEGIN;
            const int grp = bx & 7, jj = bx >> 3;
            if (jj < 16) rwkv_scan_unit(F, grp * 16 + jj, Rr, LAO, LW, OA, BV, args.in[4] + (size_t)l * R_COLS, args.in[10] + (size_t)l * RW, args.in[11] + (size_t)l * RW, args.in[12] + (size_t)l * RW);
            const attn_body::AttnTensors AT{(const attn_body::bf16*)FQ, (const attn_body::bf16*)FK, (const attn_body::bf16*)FV, (attn_body::bf16*)FQ, CB};
            const DynAttnOrder S{ctl + CW_QATT + 1024 * l + 64 * grp, F.MISC + 0, grp};
            attn_body::attn_phase<DynAttnOrder, 12>((char*)lds + RING_OFF, AT, S);
        }
        GRID_BAR();
        {
            PH_BEGIN;
            const float* lg = args.in[13] + (size_t)l * RW + 8 * lane; const float* lb = args.in[14] + (size_t)l * RW + 8 * lane;
            const f32x4 lga = *(const f32x4*)lg, lgb = *(const f32x4*)(lg + 4), lba = *(const f32x4*)lb, lbb = *(const f32x4*)(lb + 4);
            for (int m = gw; m < M; m += NGW) {
                const size_t off = (size_t)m * RW + 8 * lane; f32x4 ya, yb, ba, bb, ga, gb;
                pg8::unpack8(*(const pg8::u32x4*)(OA + off), ya, yb); pg8::unpack8(*(const pg8::u32x4*)(BV + off), ba, bb); pg8::unpack8(*(const pg8::u32x4*)(LG + off), ga, gb);
                float s = (ya[0] + ya[1]) + (ya[2] + ya[3]) + (yb[0] + yb[1]) + (yb[2] + yb[3]); s = red8(s); const float mean = s * (1.f / 64.f);
                ya = ya - mean; yb = yb - mean;
                float q = (ya[0] * ya[0] + ya[1] * ya[1]) + (ya[2] * ya[2] + ya[3] * ya[3]) + (yb[0] * yb[0] + yb[1] * yb[1]) + (yb[2] * yb[2] + yb[3] * yb[3]); q = red8(q);
                const float rstd = 1.f / sqrtf(q * (1.f / 64.f) + RWKV_LN_EPS);
                ya = (ya * rstd * lga + lba + ba) * ga; yb = (yb * rstd * lgb + lbb + bb) * gb;
                *(pg8::u32x4*)(OA + off) = pg8::pack8(ya, yb);
            }
            pg8::Gemm g{X, WIN + ((size_t)l * INP_N + INA_N) * D, D, D, D, 0, nullptr}; pg8::StaticOrder S; S.init(M, 3 * D, NG, bx);
            pg8::EpiGate E{G0, G2, args.in[17] + (size_t)l * 3 * D, (size_t)M * D};
            pg8::gemm_phase<pg8::EpiGate, pg8::StaticOrder, true, false>(F.lds + RING_OFF, g, S, E);
        }
        GRID_BAR();
        for (int br = 0; br < 3; ++br) {
            PH_BEGIN;
            const size_t aoff_ = (br == 0) ? WS_OA : ((br == 1) ? WS_OB : WS_FQ); const bf16* Ai = (const bf16*)(ws + aoff_); const bf16* Gi = G0 + (size_t)br * M * D; if (br == 2) Gi = G2;
            pg8::Gemm g{Ai, WUP + (size_t)(l * 3 + br) * D * RW, RW, RW, RW, 0, nullptr}; pg8::StaticOrder S; S.init(M, D, NG, bx);
            pg8::EpiUp E{Gi, MG, br, br};
            pg8::gemm_phase<pg8::EpiUp, pg8::StaticOrder, true, false>(F.lds + RING_OFF, g, S, E);
        }
        GRID_BAR();
        {
            PH_BEGIN;
            pg8::Gemm g{MG, WOUT + (size_t)l * D * D, D, D, D, 0, nullptr}; pg8::StaticOrder S; S.init(M, D, NG, bx);
            pg8::EpiResid E{X, Y, DN_ALPHA};
            pg8::gemm_phase<pg8::EpiResid, pg8::StaticOrder, true, false>(F.lds + RING_OFF, g, S, E);
        }
        GRID_BAR();
        {
            PH_BEGIN;
            const float* g1 = args.in[22] + (size_t)l * D; const float* b1 = args.in[23] + (size_t)l * D;
            const bool moe = (l & 1) != 0;
            LAS float* rwl = (LAS float*)(F.lds + RING_OFF);
            if (moe) { for (int i = F.tid; i < D * NEXP / 4; i += NWAVES * 64) ((LAS f32x4*)rwl)[i] = ((const f32x4*)(args.in[29] + (size_t)(l >> 1) * D * NEXP))[i]; __syncthreads(); }
            for (int m = gw; m < M; m += NGW) { f32x4 v[4]; const GAS f32x4* yr = (const GAS f32x4*)(Y + (size_t)m * D) + lane;
#pragma unroll
                for (int j = 0; j < 4; ++j) v[j] = yr[64 * j];
                ln_norm(v, g1, b1, lane); row_store_bf16(X + (size_t)m * D, v, lane);
                if (moe) {
                    float lgt[8];
#pragma unroll
                    for (int e = 0; e < 8; ++e) lgt[e] = 0.f;
#pragma unroll
                    for (int j = 0; j < 4; ++j)
#pragma unroll
                        for (int i = 0; i < 4; ++i) { const LAS f32x4* wp = (const LAS f32x4*)(rwl + (size_t)(4 * lane + 256 * j + i) * 8); const f32x4 wa = wp[0], wb = wp[1]; const float xv = v[j][i];
                            lgt[0] += xv * wa[0]; lgt[1] += xv * wa[1]; lgt[2] += xv * wa[2]; lgt[3] += xv * wa[3]; lgt[4] += xv * wb[0]; lgt[5] += xv * wb[1]; lgt[6] += xv * wb[2]; lgt[7] += xv * wb[3]; }
#pragma unroll
                    for (int e = 0; e < 8; ++e) lgt[e] = wave_sum(lgt[e]) + args.in[30][(l >> 1) * NEXP + e];
                    if (lane == 0) {
                        int e1 = 0; float v1 = lgt[0];
#pragma unroll
                        for (int e = 1; e < 8; ++e) if (lgt[e] > v1) { v1 = lgt[e]; e1 = e; }
                        int e2 = -1; float v2 = -INFINITY;
#pragma unroll
                        for (int e = 0; e < 8; ++e) if (e != e1 && lgt[e] > v2) { v2 = lgt[e]; e2 = e; }
                        const float gA = 1.f / (1.f + __expf(v2 - v1));
                        TOKE[m] = (unsigned)e1 | ((unsigned)e2 << 8); TOKG[2 * m] = gA; TOKG[2 * m + 1] = 1.f - gA;
                        const int hf = m / MOE_HALF;
                        __hip_atomic_fetch_add(ctl + CW_CNT + 64 * (hf * 8 + e1), 1u, RLX_AGENT); __hip_atomic_fetch_add(ctl + CW_CNT + 64 * (hf * 8 + e2), 1u, RLX_AGENT);
                    }
                }
            }
            if (moe) {
                __syncthreads();
                LAS float* scr = (LAS float*)(F.lds + RING_OFF + 32768 + F.wave * 8448);
                const int li = l >> 1; constexpr int I_13 = (2 * DFFE / 32) * 16, I_2 = 32 * (DFFE / 64);
                for (int it = gw; it < NEXP * (I_13 + I_2); it += NGW) {
                    const int e = it / (I_13 + I_2); int r = it - e * (I_13 + I_2);
                    if (r < I_13) { const int rg = r >> 4, kb = r & 15, d0 = 32 * rg, tile = d0 >> 8, within = d0 & 255;
                        const float* W = ((within < 128) ? args.in[31] : args.in[32]) + ((size_t)li * NEXP + e) * D * DFFE;
                        tr_item(W, DFFE, 64 * kb, tile * 128 + (within & 127), 32, WM13 + ((size_t)e * 2 * DFFE + d0) * D, D, 64 * kb, 1.f, scr, lane); }
                    else { r -= I_13; const int rg = r / (DFFE / 64), kb = r % (DFFE / 64);
                        tr_item(args.in[33] + ((size_t)li * NEXP + e) * DFFE * D, D, 64 * kb, 32 * rg, 32, WM2 + ((size_t)e * D + 32 * rg) * DFFE, DFFE, 64 * kb, 1.f, scr, lane); }
                }
            }
        }
        GRID_BAR();
        if constexpr ((l & 1) == 0) {
            {
                PH_BEGIN;
                pg8::Gemm g{X, W13, D, D, D, 0, nullptr}; pg8::StaticOrder S; S.init(M, 2 * DFF, NG, bx);
                pg8::EpiSwiglu E{H, DFF};
                pg8::gemm_phase<pg8::EpiSwiglu, pg8::StaticOrder, true, false>(F.lds + RING_OFF, g, S, E);
            }
            GRID_BAR();
            {
                PH_BEGIN;
                pg8::Gemm g{H, W2, DFF, DFF, DFF, 0, nullptr}; pg8::StaticOrder S; S.init(M, D, NG, bx);
                pg8::EpiResid E{X, Y, DN_ALPHA};
#if defined(PROBE_ZERO_FFN) && (PROBE_ZERO_FFN & 1)
                E.zero = 1;
#endif
                pg8::gemm_phase<pg8::EpiResid, pg8::StaticOrder, true, false>(F.lds + RING_OFF, g, S, E);
            }
            GRID_BAR();
            {
                PH_BEGIN;
                const float* g2 = args.in[24] + (size_t)l * D; const float* b2 = args.in[25] + (size_t)l * D;
                for (int m = gw; m < M; m += NGW) { f32x4 v[4]; const GAS f32x4* yr = (const GAS f32x4*)(Y + (size_t)m * D) + lane;
#pragma unroll
                    for (int j = 0; j < 4; ++j) v[j] = yr[64 * j];
                    ln_norm(v, g2, b2, lane);
                    if (l == NLAYER - 1) { GAS f32x4* o = (GAS f32x4*)(outp + (size_t)m * D) + lane;
#pragma unroll
                        for (int j = 0; j < 4; ++j) o[64 * j] = v[j]; }
                    else row_store_bf16(X + (size_t)m * D, v, lane); }
            }
            GRID_BAR();
        } else {
            LAS int* moff = (LAS int*)((LAS unsigned char*)lds + MOFF_OFF);
            LAS int* pexp = (LAS int*)((LAS unsigned char*)lds + PEXP_OFF);
            { PH_BEGIN;
            if (F.tid < 2) { int o = 0; for (int e = 0; e < NEXP; ++e) { moff[F.tid * 9 + e] = o; const int c = (int)__hip_atomic_load(ctl + CW_CNT + 64 * (F.tid * 8 + e), RLX_AGENT); o += (c + 255) & ~255; } moff[F.tid * 9 + 8] = o; }
            __syncthreads();
            {
                const int m = F.vcu * (NWAVES * 64) + F.tid;
                if (m < M) { const int hf = m / MOE_HALF; const unsigned te = TOKE[m];
#pragma unroll
                    for (int s = 0; s < 2; ++s) { const int e = (int)((te >> (8 * s)) & 255u); const unsigned rk = __hip_atomic_fetch_add(ctl + CW_FILL + 64 * (hf * 8 + e), 1u, RLX_AGENT);
                        const int pos = moff[hf * 9 + e] + (int)rk; PPOS[2 * m + s] = (unsigned)pos; RTOK[hf * MOE_ROWS + pos] = m; } }
                if (F.vcu >= 64 && F.vcu < 66) { const int hf = F.vcu - 64;
                    for (int e = 0; e < NEXP; ++e) { const int c = (int)__hip_atomic_load(ctl + CW_CNT + 64 * (hf * 8 + e), RLX_AGENT); const int p0 = moff[hf * 9 + e] + c, p1 = moff[hf * 9 + e + 1];
                        for (int p = p0 + F.tid; p < p1; p += NWAVES * 64) RTOK[hf * MOE_ROWS + p] = hf * MOE_HALF; } }
            } }
            GRID_BAR();
{ constexpr int hf = 0;

                const int npan = moff[hf * 9 + 8] >> 8;
                __syncthreads();
                int tp_ = threadIdx.x; asm volatile("" : "+v"(tp_));
                for (int p = tp_; p < npan; p += NWAVES * 64) { int e = 0;
#pragma unroll
                    for (int q = 1; q < NEXP; ++q) if (p * 256 >= moff[hf * 9 + q]) e = q;
                    pexp[p] = e; }
                __syncthreads();
                {
                    PH_BEGIN;
                    pg8::Gemm g{X, WM13, D, D, D, (size_t)2 * DFFE * D * 2, RTOK + hf * MOE_ROWS}; pg8::GroupedOrder S; S.so.init_tiles(npan, 2 * DFFE / 256, NG, bx); S.pexp = pexp;
                    pg8::EpiSwiglu E{HM, DFFE};
                    pg8::gemm_phase<pg8::EpiSwiglu, pg8::GroupedOrder, true, true>(F.lds + RING_OFF, g, S, E);
                }
                GRID_BAR();
                {
                    PH_BEGIN;
                    pg8::Gemm g{HM, WM2, DFFE, DFFE, DFFE, (size_t)D * DFFE * 2, nullptr}; pg8::GroupedOrder S; S.so.init_tiles(npan, D / 256, NG, bx); S.pexp = pexp;
                    pg8::EpiStore E{YP, D};
                    pg8::gemm_phase<pg8::EpiStore, pg8::GroupedOrder, true, false>(F.lds + RING_OFF, g, S, E);
                }
                GRID_BAR();
                {
                    PH_BEGIN;
                    const float* g2 = args.in[24] + (size_t)l * D; const float* b2 = args.in[25] + (size_t)l * D;
                    for (int mm = gw; mm < MOE_HALF; mm += NGW) { const int m = hf * MOE_HALF + mm;
                        f32x4 v[4], a[4], c[4]; row_load_bf16(X + (size_t)m * D, v, lane);
                        const unsigned p1 = PPOS[2 * m], p2 = PPOS[2 * m + 1]; const float ga = TOKG[2 * m], gb = TOKG[2 * m + 1];
                        row_load_bf16(YP + (size_t)p1 * D, a, lane); row_load_bf16(YP + (size_t)p2 * D, c, lane);
#pragma unroll
                        for (int j = 0; j < 4; ++j) v[j] = DN_ALPHA * v[j] + PROBE_MOE_SCALE * (ga * a[j] + gb * c[j]);
                        ln_norm(v, g2, b2, lane);
                        if (l == NLAYER - 1) { GAS f32x4* o = (GAS f32x4*)(outp + (size_t)m * D) + lane;
#pragma unroll
                            for (int j = 0; j < 4; ++j) o[64 * j] = v[j]; }
                        else row_store_bf16(X + (size_t)m * D, v, lane); }
                }

}
{ constexpr int hf = 1;

                const int npan = moff[hf * 9 + 8] >> 8;
                __syncthreads();
                int tp_ = threadIdx.x; asm volatile("" : "+v"(tp_));
                for (int p = tp_; p < npan; p += NWAVES * 64) { int e = 0;
#pragma unroll
                    for (int q = 1; q < NEXP; ++q) if (p * 256 >= moff[hf * 9 + q]) e = q;
                    pexp[p] = e; }
                __syncthreads();
                {
                    PH_BEGIN;
                    pg8::Gemm g{X, WM13, D, D, D, (size_t)2 * DFFE * D * 2, RTOK + hf * MOE_ROWS}; pg8::GroupedOrder S; S.so.init_tiles(npan, 2 * DFFE / 256, NG, bx); S.pexp = pexp;
                    pg8::EpiSwiglu E{HM, DFFE};
                    pg8::gemm_phase<pg8::EpiSwiglu, pg8::GroupedOrder, true, true>(F.lds + RING_OFF, g, S, E);
                }
                GRID_BAR();
                {
                    PH_BEGIN;
                    pg8::Gemm g{HM, WM2, DFFE, DFFE, DFFE, (size_t)D * DFFE * 2, nullptr}; pg8::GroupedOrder S; S.so.init_tiles(npan, D / 256, NG, bx); S.pexp = pexp;
                    pg8::EpiStore E{YP, D};
                    pg8::gemm_phase<pg8::EpiStore, pg8::GroupedOrder, true, false>(F.lds + RING_OFF, g, S, E);
                }
                GRID_BAR();
                {
                    PH_BEGIN;
                    const float* g2 = args.in[24] + (size_t)l * D; const float* b2 = args.in[25] + (size_t)l * D;
                    for (int mm = gw; mm < MOE_HALF; mm += NGW) { const int m = hf * MOE_HALF + mm;
                        f32x4 v[4], a[4], c[4]; row_load_bf16(X + (size_t)m * D, v, lane);
                        const unsigned p1 = PPOS[2 * m], p2 = PPOS[2 * m + 1]; const float ga = TOKG[2 * m], gb = TOKG[2 * m + 1];
                        row_load_bf16(YP + (size_t)p1 * D, a, lane); row_load_bf16(YP + (size_t)p2 * D, c, lane);
#pragma unroll
                        for (int j = 0; j < 4; ++j) v[j] = DN_ALPHA * v[j] + PROBE_MOE_SCALE * (ga * a[j] + gb * c[j]);
                        ln_norm(v, g2, b2, lane);
                        if (l == NLAYER - 1) { GAS f32x4* o = (GAS f32x4*)(outp + (size_t)m * D) + lane;
#pragma unroll
                            for (int j = 0; j < 4; ++j) o[64 * j] = v[j]; }
                        else row_store_bf16(X + (size_t)m * D, v, lane); }
                }

}

            if (l != NLAYER - 1) GRID_BAR();
        }

}

}

extern "C" void kernel_launch(void* const* d_in, const int* in_sizes, int n_in, void* d_out, int out_size, void* d_ws, size_t ws_size, hipStream_t stream) {
    static int grid = 0;
    if (grid == 0) {
        if (n_in != 34 || in_sizes[0] != M * D || out_size != M * D || ws_size < WS_END) { fprintf(stderr, "kernel_launch: unexpected shapes / workspace (n_in %d, in0 %d, out %d, ws %zu); nothing launched\n", n_in, n_in > 0 ? in_sizes[0] : -1, out_size, ws_size); grid = -1; return; }
        int dev = 0, cus = 0;
        if (hipGetDevice(&dev) != hipSuccess || hipDeviceGetAttribute(&cus, hipDeviceAttributeMultiprocessorCount, dev) != hipSuccess) { grid = -1; return; }
        if (hipFuncSetAttribute((const void*)mk_fwd, hipFuncAttributeMaxDynamicSharedMemorySize, LDS_BYTES) != hipSuccess) { fprintf(stderr, "kernel_launch: hipFuncSetAttribute failed\n"); grid = -1; return; }
        int per_cu = 0;
        if (hipOccupancyMaxActiveBlocksPerMultiprocessor(&per_cu, (const void*)mk_fwd, NWAVES * 64, LDS_BYTES) != hipSuccess || per_cu < 1) fprintf(stderr, "kernel_launch: occupancy query reports %d workgroups per CU\n", per_cu);
        (void)hipGetLastError();
        if (cus != 256) { fprintf(stderr, "kernel_launch: built for a 256-CU device, found %d; nothing launched\n", cus); grid = -1; return; }
        grid = 256;
    }
    if (grid < 0) return;
    if (hipMemsetAsync((char*)d_ws + WS_CTL, 0, CTL_ZERO_BYTES, stream) != hipSuccess) return;
    Args a{};
    for (int i = 0; i < 34; ++i) a.in[i] = (const float*)d_in[i];
    a.out = (float*)d_out; a.ws = (unsigned char*)d_ws;
    hipLaunchKernelGGL(mk_fwd, dim3(grid), dim3(NWAVES * 64), LDS_BYTES, stream, a);
}
```

```cpp
#define PROBE_DUP 0
#define PROBE_MOE_SCALE 1.f
#include <hip/hip_runtime.h>
#include <hip/hip_bf16.h>
#include <cstdio>
#include <cstdint>
#include <cmath>

namespace pg8 {
#define PG8_LAS __attribute__((address_space(3)))
typedef unsigned short bf16_t;
typedef short bf16x8 __attribute__((ext_vector_type(8)));
typedef float f32x4 __attribute__((ext_vector_type(4)));
typedef unsigned u32x4 __attribute__((ext_vector_type(4)));
typedef unsigned u32x2 __attribute__((ext_vector_type(2)));
constexpr int BM = 256, BK = 64, HALF = 128, HTB = HALF * BK * 2  , STAGE_BYTES = 8 * HTB, NXCD = 8, WGM = 8;

__host__ __device__ __forceinline__ int lds_byte(int r, int c) { const int st = (r >> 4) * 2 + (c >> 5), rr = r & 15, cc = c & 31, ob = rr * 64 + cc * 2; return st * 1024 + (ob ^ (((ob >> 9) & 1) << 5)); }
__host__ __device__ __forceinline__ void stage_rc(int b, int& R, int& C) { const int st = b / 1024, sb = b % 1024, swz = sb ^ (((sb >> 9) & 1) << 5); R = (st >> 1) * 16 + swz / 64; C = (st & 1) * 32 + (swz % 64) / 2; }
__host__ __device__ __forceinline__ int perm32(int rho) { const int n = rho >> 4, i = rho & 15; return 8 * (i >> 2) + 4 * n + (i & 3); }

struct Unit { int pm, pn, e, ko; };
struct Gemm { const bf16_t* A; const bf16_t* Bt; size_t bstride; const int* rows; long aseg1 = 0, aseg2 = 0; };

struct StaticOrder {
    int nM, nN, nwg, G, c;
    __host__ __device__ void init(int M, int N, int G_, int c_) { nM = M / BM; nN = N / BM; nwg = nM * nN; G = G_; c = c_; }
    __host__ __device__ void init_tiles(int nM_, int nN_, int G_, int c_) { nM = nM_; nN = nN_; nwg = nM * nN; G = G_; c = c_; }
    __host__ __device__ bool next(int i, Unit& u) const {
        const long L = (long)i * G + c; if (L >= nwg) return false;
        int wgid = (int)L; { const int q = nwg / NXCD, r = nwg % NXCD, xcd = wgid % NXCD, off = wgid / NXCD; wgid = (xcd < r ? xcd * (q + 1) : r * (q + 1) + (xcd - r) * q) + off; }
        const int nig = WGM * nN, gid = wgid / nig, fm = gid * WGM, gsz = (nM - fm) < WGM ? (nM - fm) : WGM;
        u.pm = fm + ((wgid % nig) % gsz); u.pn = (wgid % nig) / gsz; u.e = 0; u.ko = 0; return true;
    }
    __device__ __forceinline__ void a_ready(const Unit&) const {}
    __device__ __forceinline__ void done(const Unit&) const {}
};
struct GroupedOrder {
    StaticOrder so; const PG8_LAS int* pexp;
    __device__ __forceinline__ bool next(int i, Unit& u) const { if (!so.next(i, u)) return false; u.e = __builtin_amdgcn_readfirstlane(pexp[u.pm]); return true; }
    __device__ __forceinline__ void a_ready(const Unit&) const {}
    __device__ __forceinline__ void done(const Unit&) const {}
};

struct SliceOrder {
    int pm0, np, nN, c, kbytes; const PG8_LAS int* pexp;
    __device__ __forceinline__ bool next(int i, Unit& u) const { if (i != 0 || c >= np * nN * 4) return false; const int sl = c & 3, t = c >> 2; u.pn = t % nN; u.pm = pm0 + t / nN;
        u.e = __builtin_amdgcn_readfirstlane(pexp[u.pm]); u.ko = sl * kbytes; return true; }
    __device__ __forceinline__ void a_ready(const Unit&) const {}
    __device__ __forceinline__ void done(const Unit&) const {}
};

typedef float f32x2 __attribute__((ext_vector_type(2))); typedef __bf16 bf16x2v __attribute__((ext_vector_type(2)));
__device__ __forceinline__ unsigned cvt_pk_bf16(float lo, float hi) { const f32x2 v = {lo, hi}; return __builtin_bit_cast(unsigned, __builtin_convertvector(v, bf16x2v)); }
__device__ __forceinline__ float bf_lo(unsigned w) { return __builtin_bit_cast(float, w << 16); }
__device__ __forceinline__ float bf_hi(unsigned w) { return __builtin_bit_cast(float, w & 0xffff0000u); }
__device__ __forceinline__ float fsigmoid(float x) { return __builtin_amdgcn_rcpf(1.0f + __expf(-x)); }
__device__ __forceinline__ u32x4 pack8(const f32x4 v0, const f32x4 v1) { u32x4 w; w.x = cvt_pk_bf16(v0[0], v0[1]); w.y = cvt_pk_bf16(v0[2], v0[3]); w.z = cvt_pk_bf16(v1[0], v1[1]); w.w = cvt_pk_bf16(v1[2], v1[3]); return w; }
__device__ __forceinline__ void unpack8(const u32x4 w, f32x4& v0, f32x4& v1) { v0 = (f32x4){bf_lo(w.x), bf_hi(w.x), bf_lo(w.y), bf_hi(w.y)}; v1 = (f32x4){bf_lo(w.z), bf_hi(w.z), bf_lo(w.w), bf_hi(w.w)}; }

#define PG8_EPI_LOOP_BEGIN \
    _Pragma("unroll") for (int ai = 0; ai < 2; ++ai) _Pragma("unroll") for (int m = 0; m < 4; ++m) { const int row = row0 + ai * HALF + m * 16; \
    _Pragma("unroll") for (int bj = 0; bj < 2; ++bj) { const int lc = lcol + bj * HALF; f32x4 v0 = acc[ai][bj][m][0], v1 = acc[ai][bj][m][1];
#define PG8_EPI_LOOP_END } }

struct EpiInA {
    static constexpr bool PERM = true, AFTER_DRAIN = false;
    bf16_t *R, *C, *Fq; float* FL; size_t fstride;
    __device__ __forceinline__ void operator()(const f32x4 (&acc)[2][2][4][2], const Unit& u, int wr, int wc, int fr, int fq) const {
        const int pn = u.pn, row0 = u.pm * BM + wr * 64 + fr, lcol = wc * 32 + 8 * fq;
        bf16_t* base; int ldc, colt;
        if (pn < 7) {
            PG8_EPI_LOOP_BEGIN
                *(u32x4*)(R + (size_t)row * 1792 + pn * 256 + lc) = pack8(v0, v1);
            PG8_EPI_LOOP_END
            return;
        }
        else if (pn < 13) { base = C; ldc = 1536; colt = (pn - 7) * 256; }
        else if (pn < 19) { const int q = pn - 13; base = C + ((size_t)(Fq - C) + (size_t)(q >> 1) * fstride); ldc = 512; colt = (q & 1) * 256; }
        else {
            if (wc == 0 && fq == 0) {
#pragma unroll
                for (int ai = 0; ai < 2; ++ai)
#pragma unroll
                    for (int m = 0; m < 4; ++m) { float* p = FL + (size_t)(row0 + ai * HALF + m * 16) * 8; *(f32x4*)p = acc[ai][0][m][0]; *(f32x4*)(p + 4) = acc[ai][0][m][1]; }
            }
            return;
        }
        PG8_EPI_LOOP_BEGIN
            *(u32x4*)(base + (size_t)row * ldc + colt + lc) = pack8(v0, v1);
        PG8_EPI_LOOP_END
    }
};
struct EpiLora {
    static constexpr bool PERM = true, AFTER_DRAIN = false;
    float* LW; bf16_t *LAo, *LG; const float *w0, *a0;
    __device__ __forceinline__ void operator()(const f32x4 (&acc)[2][2][4][2], const Unit& u, int wr, int wc, int fr, int fq) const {
        const int pn = u.pn, row0 = u.pm * BM + wr * 64 + fr, lcol = wc * 32 + 8 * fq, colt = (pn & 1) * 256;
        if (pn < 4) {
            const float* bp = ((pn < 2) ? w0 : a0) + colt + lcol; f32x4 bb[2][2];
#pragma unroll
            for (int bj = 0; bj < 2; ++bj) { bb[bj][0] = *(const f32x4*)(bp + bj * HALF); bb[bj][1] = *(const f32x4*)(bp + bj * HALF + 4); }
            if (pn < 2) {
                PG8_EPI_LOOP_BEGIN
                    const int c = colt + lc; f32x4 o0, o1;
#pragma unroll
                    for (int j = 0; j < 4; ++j) { o0[j] = -0.6065306597126334f * fsigmoid(v0[j] + bb[bj][0][j]); o1[j] = -0.6065306597126334f * fsigmoid(v1[j] + bb[bj][1][j]); }
                    float* p = LW + (size_t)row * 512 + c; *(f32x4*)p = o0; *(f32x4*)(p + 4) = o1;
                PG8_EPI_LOOP_END
            } else {
                PG8_EPI_LOOP_BEGIN
                    const int c = colt + lc;
#pragma unroll
                    for (int j = 0; j < 4; ++j) { v0[j] = fsigmoid(v0[j] + bb[bj][0][j]); v1[j] = fsigmoid(v1[j] + bb[bj][1][j]); }
                    *(u32x4*)(LAo + (size_t)row * 512 + c) = pack8(v0, v1);
                PG8_EPI_LOOP_END
            }
        } else {
            PG8_EPI_LOOP_BEGIN
                *(u32x4*)(LG + (size_t)row * 512 + colt + lc) = pack8(v0, v1);
            PG8_EPI_LOOP_END
        }
    }
};
struct EpiGate {
    static constexpr bool PERM = true, AFTER_DRAIN = false;
    unsigned char *G01, *G2; const float* bg; size_t gstride;
    __device__ __forceinline__ static unsigned q8x4(const f32x4 v) { unsigned w = 0u;
#pragma unroll
        for (int j = 0; j < 4; ++j) w = __builtin_amdgcn_cvt_pk_u8_f32(fmaxf(v[j] * 255.f, 1.f), (unsigned)j, w);
        return w; }
    __device__ __forceinline__ void operator()(const f32x4 (&acc)[2][2][4][2], const Unit& u, int wr, int wc, int fr, int fq) const {
        const int pn = u.pn, gi = pn >> 2, lcol = wc * 32 + 8 * fq, colt = (pn & 3) * 256, tid = (wr * 4 + wc) * 64 + fq * 16 + fr;
        unsigned char* base = G01 + (size_t)gi * gstride; if (gi == 2) base = G2; const float* bp = bg + gi * 1024 + colt + lcol;
        base += (size_t)(u.pm * 4 + (pn & 3)) * 65536 + (size_t)tid * 8;
        f32x4 bb[2][2];
#pragma unroll
        for (int bj = 0; bj < 2; ++bj) { bb[bj][0] = *(const f32x4*)(bp + bj * HALF); bb[bj][1] = *(const f32x4*)(bp + bj * HALF + 4); }
#pragma unroll
        for (int ai = 0; ai < 2; ++ai)
#pragma unroll
            for (int m = 0; m < 4; ++m)
#pragma unroll
                for (int bj = 0; bj < 2; ++bj) { f32x4 v0 = acc[ai][bj][m][0], v1 = acc[ai][bj][m][1];
#pragma unroll
                    for (int j = 0; j < 4; ++j) { v0[j] = fsigmoid(v0[j] + bb[bj][0][j]); v1[j] = fsigmoid(v1[j] + bb[bj][1][j]); }
                    u32x2 w; w.x = q8x4(v0); w.y = q8x4(v1); *(u32x2*)(base + ((ai * 4 + m) * 2 + bj) * 4096) = w; }
    }
};
struct EpiUp {
    static constexpr bool PERM = true, AFTER_DRAIN = false;
    const bf16_t* G; bf16_t* MG; int accum; int accum_id;
    __device__ __forceinline__ void operator()(const f32x4 (&acc)[2][2][4][2], const Unit& u, int wr, int wc, int fr, int fq) const {
        const int row0 = u.pm * BM + wr * 64 + fr, lcol = wc * 32 + 8 * fq, colt = u.pn * 256;
        PG8_EPI_LOOP_BEGIN
            const size_t off = (size_t)row * 1024 + colt + lc; f32x4 g0, g1; unpack8(*(const u32x4*)(G + off), g0, g1);
            v0 = v0 * g0; v1 = v1 * g1;
#ifdef PROBE_ZERO_BR
            if ((PROBE_ZERO_BR >> accum_id) & 1) { v0 = v0 * 0.f; v1 = v1 * 0.f; }
#endif
            if (accum) { f32x4 p0, p1; unpack8(*(const u32x4*)(MG + off), p0, p1); v0 = v0 + p0; v1 = v1 + p1; }
            *(u32x4*)(MG + off) = pack8(v0, v1);
        PG8_EPI_LOOP_END
    }
};
struct EpiUp3 {
    static constexpr bool PERM = true, AFTER_DRAIN = false;
    const unsigned char *G01, *G2; size_t gstride; bf16_t* MG;
    __device__ __forceinline__ const unsigned char* gtile(int gi, const Unit& u, int tid) const {
        const unsigned char* b = G01 + (size_t)gi * gstride; if (gi == 2) b = G2; return b + (size_t)(u.pm * 4 + u.pn) * 65536 + (size_t)tid * 8; }
    __device__ __forceinline__ static void unq8(const u32x2 w, f32x4& a0, f32x4& a1) {
        a0 = (f32x4){(float)((w.x >> 0) & 0xffu), (float)((w.x >> 8) & 0xffu), (float)((w.x >> 16) & 0xffu), (float)((w.x >> 24) & 0xffu)};
        a1 = (f32x4){(float)((w.y >> 0) & 0xffu), (float)((w.y >> 8) & 0xffu), (float)((w.y >> 16) & 0xffu), (float)((w.y >> 24) & 0xffu)}; }
    __device__ __forceinline__ void rescale(f32x4 (&acc)[2][2][4][2], const Unit& u, int wr, int wc, int fr, int fq, int s) const {
        const int tid = (wr * 4 + wc) * 64 + fq * 16 + fr; const unsigned char* pa = gtile(s - 1, u, tid); const unsigned char* pb = gtile(s, u, tid);
#pragma unroll
        for (int ai = 0; ai < 2; ++ai) { u32x2 ra[4][2], rb[4][2];
#pragma unroll
            for (int m = 0; m < 4; ++m)
#pragma unroll
                for (int bj = 0; bj < 2; ++bj) { const int e = ((ai * 4 + m) * 2 + bj) * 4096; ra[m][bj] = *(const u32x2*)(pa + e); rb[m][bj] = *(const u32x2*)(pb + e); }
#pragma unroll
            for (int m = 0; m < 4; ++m)
#pragma unroll
                for (int bj = 0; bj < 2; ++bj) { f32x4 a0, a1, b0, b1; unq8(ra[m][bj], a0, a1); unq8(rb[m][bj], b0, b1);
#pragma unroll
                    for (int j = 0; j < 4; ++j) { acc[ai][bj][m][0][j] *= a0[j] * __builtin_amdgcn_rcpf(b0[j]); acc[ai][bj][m][1][j] *= a1[j] * __builtin_amdgcn_rcpf(b1[j]); } } }
    }
    __device__ __forceinline__ void operator()(const f32x4 (&acc)[2][2][4][2], const Unit& u, int wr, int wc, int fr, int fq) const {
        const int row0 = u.pm * BM + wr * 64 + fr, lcol = wc * 32 + 8 * fq, colt = u.pn * 256, tid = (wr * 4 + wc) * 64 + fq * 16 + fr; const unsigned char* pg = gtile(2, u, tid);
#pragma unroll
        for (int ai = 0; ai < 2; ++ai) { u32x2 rg[4][2];
#pragma unroll
            for (int m = 0; m < 4; ++m)
#pragma unroll
                for (int bj = 0; bj < 2; ++bj) rg[m][bj] = *(const u32x2*)(pg + ((ai * 4 + m) * 2 + bj) * 4096);
#pragma unroll
            for (int m = 0; m < 4; ++m)
#pragma unroll
                for (int bj = 0; bj < 2; ++bj) { const int row = row0 + ai * HALF + m * 16, lc = lcol + bj * HALF; f32x4 v0 = acc[ai][bj][m][0], v1 = acc[ai][bj][m][1], g0, g1; unq8(rg[m][bj], g0, g1);
#pragma unroll
                    for (int j = 0; j < 4; ++j) { v0[j] *= g0[j] * (1.f / 255.f); v1[j] *= g1[j] * (1.f / 255.f); }
                    *(u32x4*)(MG + (size_t)row * 1024 + colt + lc) = pack8(v0, v1); } }
    }
};
struct EpiSink {
    static constexpr bool PERM = true, AFTER_DRAIN = false;
    float* O;
    __device__ __forceinline__ void operator()(const f32x4 (&acc)[2][2][4][2], const Unit& u, int wr, int wc, int fr, int fq) const {
        float s = 0.f;
#pragma unroll
        for (int ai = 0; ai < 2; ++ai)
#pragma unroll
            for (int m = 0; m < 4; ++m)
#pragma unroll
                for (int bj = 0; bj < 2; ++bj) { const f32x4 v0 = acc[ai][bj][m][0], v1 = acc[ai][bj][m][1]; s += (v0[0] + v0[1]) + (v0[2] + v0[3]) + (v1[0] + v1[1]) + (v1[2] + v1[3]); }
        if (s == 1.2345678e33f) O[(u.pm * 64 + u.pn) & 1023] = s;
    }
};
struct EpiResid {
    static constexpr bool PERM = true, AFTER_DRAIN = false;
    const bf16_t* X; bf16_t* Y; float alpha; int zero = 0;
    __device__ __forceinline__ void operator()(const f32x4 (&acc)[2][2][4][2], const Unit& u, int wr, int wc, int fr, int fq) const {
        const int row0 = u.pm * BM + wr * 64 + fr, lcol = wc * 32 + 8 * fq, colt = u.pn * 256;
#pragma unroll
        for (int ai = 0; ai < 2; ++ai) { u32x4 xr[4][2];
#pragma unroll
            for (int m = 0; m < 4; ++m)
#pragma unroll
                for (int bj = 0; bj < 2; ++bj) xr[m][bj] = *(const u32x4*)(X + (size_t)(row0 + ai * HALF + m * 16) * 1024 + colt + lcol + bj * HALF);
#pragma unroll
            for (int m = 0; m < 4; ++m)
#pragma unroll
                for (int bj = 0; bj < 2; ++bj) { const size_t off = (size_t)(row0 + ai * HALF + m * 16) * 1024 + colt + lcol + bj * HALF; f32x4 v0 = acc[ai][bj][m][0], v1 = acc[ai][bj][m][1], x0, x1; unpack8(xr[m][bj], x0, x1);
                    if (zero) { v0 = v0 * 0.f; v1 = v1 * 0.f; }
                    v0 = v0 + alpha * x0; v1 = v1 + alpha * x1;
                    *(u32x4*)(Y + off) = pack8(v0, v1); } }
    }
};
struct EpiSwiglu {
    static constexpr bool PERM = true, AFTER_DRAIN = false;
    bf16_t* H; int ldh;
    __device__ __forceinline__ void operator()(const f32x4 (&acc)[2][2][4][2], const Unit& u, int wr, int wc, int fr, int fq) const {
        const int row0 = u.pm * BM + wr * 64 + fr, lcol = wc * 32 + 8 * fq, colt = u.pn * 128;
#pragma unroll
        for (int ai = 0; ai < 2; ++ai)
#pragma unroll
            for (int m = 0; m < 4; ++m) { const int row = row0 + ai * HALF + m * 16;
                f32x4 a0 = acc[ai][0][m][0], a1 = acc[ai][0][m][1]; const f32x4 b0 = acc[ai][1][m][0], b1 = acc[ai][1][m][1];
#pragma unroll
                for (int j = 0; j < 4; ++j) { a0[j] = a0[j] * fsigmoid(a0[j]) * b0[j]; a1[j] = a1[j] * fsigmoid(a1[j]) * b1[j]; }
                *(u32x4*)(H + (size_t)row * ldh + colt + lcol) = pack8(a0, a1); }
    }
};
struct EpiStore {
    static constexpr bool PERM = true, AFTER_DRAIN = false;
    bf16_t* O; int ldc; int pm0 = 0, kbytes = 1; size_t sstride = 0;
    __device__ __forceinline__ void operator()(const f32x4 (&acc)[2][2][4][2], const Unit& u, int wr, int wc, int fr, int fq) const {
        const int row0 = (u.pm - pm0) * BM + wr * 64 + fr, lcol = wc * 32 + 8 * fq, colt = u.pn * 256;
        bf16_t* Ob = O + (size_t)(u.ko / kbytes) * sstride;
        PG8_EPI_LOOP_BEGIN
            *(u32x4*)(Ob + (size_t)row * ldc + colt + lc) = pack8(v0, v1);
        PG8_EPI_LOOP_END
    }
};

__device__ __forceinline__ void glds16s(const char* sbase, unsigned voff, unsigned lds_dst) { unsigned keep;
    asm volatile("s_nop 4\n\ts_mov_b32 %0, m0\n\ts_mov_b32 m0, %3\n\ts_nop 0\n\tglobal_load_lds_dwordx4 %1, %2\n\ts_mov_b32 m0, %0" : "=&s"(keep) : "v"(voff), "s"(sbase), "s"(lds_dst) : "memory"); }
__device__ __forceinline__ void glds16s_fast(const char* sbase, unsigned voff, unsigned lds_dst) { unsigned keep;
    asm volatile("s_mov_b32 %0, m0\n\ts_mov_b32 m0, %3\n\ts_nop 0\n\tglobal_load_lds_dwordx4 %1, %2\n\ts_mov_b32 m0, %0" : "=&s"(keep) : "v"(voff), "s"(sbase), "s"(lds_dst) : "memory"); }
__device__ __forceinline__ void glds16s_pair(const char* sbase, unsigned voff0, unsigned voff1, unsigned lds_dst) {
    asm volatile("s_mov_b32 m0, %3\n\ts_nop 0\n\tglobal_load_lds_dwordx4 %0, %2\n\ts_add_u32 m0, m0, 0x2000\n\ts_nop 0\n\tglobal_load_lds_dwordx4 %1, %2" :: "v"(voff0), "v"(voff1), "s"(sbase), "s"(lds_dst) : "memory", "m0", "scc"); }
template <class Epi, class Sched, bool ALIGN_EPI, bool GATHER, int LDA, int LDB, int KDIM, bool SEG3 = false, int PMODE = 0>
__device__ __forceinline__ void gemm_phase(PG8_LAS unsigned char* lds, const Gemm g, const Sched& S, const Epi& E) {
    int tid_ = threadIdx.x; asm volatile("" : "+v"(tid_));
    const int tid = tid_, wid = __builtin_amdgcn_readfirstlane(tid >> 6), lane = tid & 63, wr = wid >> 2, wc = wid & 3, fr = lane & 15, fq = lane >> 4;
    constexpr int K = KDIM, nt = K / BK;
    unsigned voffA[2], voffB[2]; int rowA[2]; unsigned colA2[2];
#pragma unroll
    for (int i = 0; i < 2; ++i) { int R, C; stage_rc(tid * 16 + i * 8192, R, C); const int Rb = Epi::PERM ? ((R & ~31) + perm32(R & 31)) : R;
        rowA[i] = R; colA2[i] = (unsigned)C * 2u; voffA[i] = (unsigned)(R * LDA + C) * 2u; voffB[i] = (unsigned)(Rb * LDB + C) * 2u; }
    const size_t kstep = (size_t)(BK * 2);
    const unsigned hstepA = (unsigned)HALF * (unsigned)LDA * 2u;
    const size_t hstepB = (size_t)HALF * LDB * 2;
    const size_t tstepA = 2 * (size_t)hstepA, tstepB = 2 * hstepB;
    long adj1 = 0, adj2 = 0; if constexpr (SEG3) { static_assert(KDIM == 24 * BK && !GATHER, "SEG3: three segments of 8 K-tiles"); adj1 = g.aseg1 - 8 * (long)kstep; adj2 = g.aseg2 - 16 * (long)kstep; }
#define PG8_ADJ(tt) (SEG3 ? ((tt) >= 16 ? adj2 : ((tt) >= 8 ? adj1 : 0L)) : 0L)
    const unsigned ldsw = (unsigned)wid * 1024u;
    const unsigned ldsb = (unsigned)(uintptr_t)lds;
    const int aoff = lds_byte(wr * 64 + fr, fq * 8), boff = lds_byte(wc * 32 + fr, fq * 8);
#define PG8_SA(b, h) (((b) * 2 + (h)) * HTB)
#define PG8_SB(b, h) ((4 + (b) * 2 + (h)) * HTB)
#define PG8_STAGE(bufoff, gbase, voff) do { if constexpr (PMODE == 2) break; const char* sb_ = (const char*)(gbase); const unsigned l0_ = ldsb + (unsigned)(bufoff) + ldsw; \
        glds16s_pair(sb_, (voff)[0], (voff)[1], l0_); } while (0)
#define PG8_STAGE_A(bufoff, kbase, h, GO) do { if constexpr (GATHER) PG8_STAGE(bufoff, kbase, GO[h]); else PG8_STAGE(bufoff, (kbase) + (size_t)(h) * hstepA, voffA); } while (0)
#define PG8_LDA(dst, b, h) do { _Pragma("unroll") for (int m = 0; m < 4; ++m) _Pragma("unroll") for (int k = 0; k < 2; ++k) dst[m][k] = *(const PG8_LAS bf16x8*)(lds + PG8_SA(b, h) + aoff + m * 2048 + k * 1024); } while (0)
#define PG8_LDB(dst, b, h) do { _Pragma("unroll") for (int n = 0; n < 2; ++n) _Pragma("unroll") for (int k = 0; k < 2; ++k) dst[n][k] = *(const PG8_LAS bf16x8*)(lds + PG8_SB(b, h) + boff + n * 2048 + k * 1024); } while (0)
#define PG8_MMA(ai, bj, At, Bt) do { if constexpr (PMODE == 1) { _Pragma("unroll") for (int m = 0; m < 4; ++m) _Pragma("unroll") for (int k = 0; k < 2; ++k) { asm volatile("" :: "v"(At[m][k])); } _Pragma("unroll") for (int n = 0; n < 2; ++n) _Pragma("unroll") for (int k = 0; k < 2; ++k) { asm volatile("" :: "v"(Bt[n][k])); } break; } __builtin_amdgcn_s_setprio(1); _Pragma("unroll") for (int m = 0; m < 4; ++m) _Pragma("unroll") for (int n = 0; n < 2; ++n) _Pragma("unroll") for (int k = 0; k < 2; ++k) \
        acc[ai][bj][m][n] = __builtin_amdgcn_mfma_f32_16x16x32_bf16(Bt[n][k], At[m][k], acc[ai][bj][m][n], 0, 0, 0); __builtin_amdgcn_s_setprio(0); } while (0)
#define PG8_WAIT_V(n) asm volatile("s_waitcnt vmcnt(" #n ")" ::: "memory")
#define PG8_WAIT_L(n) asm volatile("s_waitcnt lgkmcnt(" #n ")" ::: "memory")
#define PG8_BAR __builtin_amdgcn_s_barrier()
#define PG8_SCHED __builtin_amdgcn_sched_barrier(0)
#define PG8_SETGO(go, u) do { _Pragma("unroll") for (int _h = 0; _h < 2; ++_h) _Pragma("unroll") for (int _i = 0; _i < 2; ++_i) { \
        if constexpr (GATHER) { const int _tok = g.rows[(u).pm * BM + _h * HALF + rowA[_i]]; go[_h][_i] = (unsigned)_tok * (unsigned)(LDA * 2) + colA2[_i]; asm volatile("" : "+v"(go[_h][_i])); } \
        else go[_h][_i] = 0u; } } while (0)
    Unit cur, nxt; int ui = 0;
    if (!S.next(0, cur)) return;
    f32x4 acc[2][2][4][2];
    bf16x8 At[4][2], B0[2][2], B1[2][2];
    unsigned goC[2][2], goN[2][2];
    PG8_SETGO(goC, cur);
    const char* cA = GATHER ? (const char*)g.A : (const char*)g.A + (size_t)cur.pm * tstepA + cur.ko;
    const char* cB = (const char*)g.Bt + (size_t)cur.e * g.bstride + (size_t)cur.pn * tstepB + cur.ko;
    S.a_ready(cur);
    PG8_STAGE(PG8_SB(0, 0), cB, voffB); PG8_STAGE(PG8_SB(0, 1), cB + hstepB, voffB); PG8_STAGE_A(PG8_SA(0, 0), cA, 0, goC); PG8_STAGE_A(PG8_SA(0, 1), cA, 1, goC);
    if (wr == 1) PG8_BAR;
    PG8_WAIT_V(2); PG8_BAR;
    PG8_STAGE(PG8_SB(1, 0), cB + kstep, voffB); PG8_STAGE_A(PG8_SA(1, 0), cA + kstep, 0, goC); PG8_STAGE(PG8_SB(1, 1), cB + hstepB + kstep, voffB);
    PG8_WAIT_V(6); PG8_BAR;
#pragma unroll
    for (int a = 0; a < 2; ++a)
#pragma unroll
        for (int b = 0; b < 2; ++b)
#pragma unroll
            for (int m = 0; m < 4; ++m)
#pragma unroll
                for (int n = 0; n < 2; ++n) acc[a][b][m][n] = (f32x4){0.f, 0.f, 0.f, 0.f};
    for (;;) {
        const bool has_next = S.next(ui + 1, nxt);
        const char* nA = cA; const char* nB = cB;
        if (has_next) { PG8_SETGO(goN, nxt); nA = GATHER ? (const char*)g.A : (const char*)g.A + (size_t)nxt.pm * tstepA + nxt.ko; nB = (const char*)g.Bt + (size_t)nxt.e * g.bstride + (size_t)nxt.pn * tstepB + nxt.ko; }
        else {
#pragma unroll
            for (int h = 0; h < 2; ++h)
#pragma unroll
                for (int i = 0; i < 2; ++i) goN[h][i] = goC[h][i]; }
        for (int t = 0; t < nt; t += 2) {
            const bool last = (t == nt - 2);
            if constexpr (SEG3) { if (t == 8 || t == 16) E.rescale(acc, cur, wr, wc, fr, fq, t >> 3); }
            const char* a1 = cA + (size_t)(t + 1) * kstep + PG8_ADJ(t + 1);
            const char* a2 = last ? nA : cA + (size_t)(t + 2) * kstep + PG8_ADJ(t + 2); const char* b2 = last ? nB : cB + (size_t)(t + 2) * kstep;
            const char* a3 = a2 + kstep; const char* b3 = b2 + kstep;
            unsigned g2[2][2];
#pragma unroll
            for (int h = 0; h < 2; ++h)
#pragma unroll
                for (int i = 0; i < 2; ++i) g2[h][i] = (GATHER && last) ? goN[h][i] : goC[h][i];
            if (last && has_next) S.a_ready(nxt);
            PG8_LDB(B0, 0, 0); PG8_LDB(B1, 0, 1); PG8_SCHED; PG8_LDA(At, 0, 0); PG8_STAGE_A(PG8_SA(1, 1), a1, 1, goC);
            PG8_WAIT_V(8); PG8_WAIT_L(0); PG8_BAR; PG8_MMA(0, 0, At, B0); PG8_MMA(0, 1, At, B1); PG8_BAR; PG8_SCHED;
            PG8_LDA(At, 0, 1); PG8_STAGE(PG8_SB(0, 0), b2, voffB); PG8_STAGE(PG8_SB(0, 1), b2 + hstepB, voffB); PG8_STAGE_A(PG8_SA(0, 0), a2, 0, g2);
            PG8_WAIT_V(8); PG8_WAIT_L(0); PG8_BAR; PG8_MMA(1, 0, At, B0); PG8_MMA(1, 1, At, B1); PG8_BAR; PG8_SCHED;
            PG8_LDB(B0, 1, 0); PG8_LDB(B1, 1, 1); PG8_SCHED; PG8_LDA(At, 1, 0); PG8_STAGE_A(PG8_SA(0, 1), a2, 1, g2);
            PG8_WAIT_V(8); PG8_WAIT_L(0); PG8_BAR; PG8_MMA(0, 0, At, B0); PG8_MMA(0, 1, At, B1); PG8_BAR; PG8_SCHED;
            PG8_LDA(At, 1, 1); PG8_STAGE(PG8_SB(1, 0), b3, voffB); PG8_STAGE(PG8_SB(1, 1), b3 + hstepB, voffB); PG8_STAGE_A(PG8_SA(1, 0), a3, 0, g2);
            PG8_WAIT_V(8); PG8_WAIT_L(0); PG8_BAR; PG8_MMA(1, 0, At, B0); PG8_MMA(1, 1, At, B1); PG8_BAR; PG8_SCHED;
        }
        if constexpr (ALIGN_EPI) { if (wr == 0) PG8_BAR; }
        E(acc, cur, wr, wc, fr, fq); S.done(cur);
        if (!has_next) break;
#pragma unroll
        for (int a = 0; a < 2; ++a)
#pragma unroll
            for (int b = 0; b < 2; ++b)
#pragma unroll
                for (int m = 0; m < 4; ++m)
#pragma unroll
                    for (int n = 0; n < 2; ++n) acc[a][b][m][n] = (f32x4){0.f, 0.f, 0.f, 0.f};
        cur = nxt; cA = nA; cB = nB; ++ui;
#pragma unroll
        for (int h = 0; h < 2; ++h)
#pragma unroll
            for (int i = 0; i < 2; ++i) goC[h][i] = goN[h][i];
        if constexpr (ALIGN_EPI) { if (wr == 1) PG8_BAR; }
    }
    PG8_WAIT_V(0);
    if constexpr (!ALIGN_EPI) { if (wr == 0) PG8_BAR; }
    PG8_BAR;
#undef PG8_SA
#undef PG8_SB
#undef PG8_STAGE
#undef PG8_STAGE_A
#undef PG8_LDA
#undef PG8_LDB
#undef PG8_MMA
#undef PG8_WAIT_V
#undef PG8_WAIT_L
#undef PG8_BAR
#undef PG8_SCHED
#undef PG8_SETGO
#undef PG8_ADJ
}
}
#include <hip/hip_bf16.h>
#include <cmath>
namespace attn_body {
using bf16=__hip_bfloat16;
using bf16x8=__attribute__((ext_vector_type(8)))short;
using s16x4=__attribute__((ext_vector_type(4)))short;
using f32x16=__attribute__((ext_vector_type(16)))float;
using u32x4=__attribute__((ext_vector_type(4)))unsigned;
constexpr int BATCH=4,NHEAD=8,SEQ=8192,D=64,DM=NHEAD*D;
constexpr int NW=8,QBLK=32,QB=QBLK*NW,KVBLK=64,NQB=SEQ/QB;
constexpr int ATTN_PITCH=DM, ATTN_UNIT_ROWS=QB;
__device__ __forceinline__ int crow(int r,int hi){return (r&3)+8*(r>>2)+4*hi;}
#define SBAR() __builtin_amdgcn_sched_barrier(0)
__device__ __forceinline__ void cmask(f32x16&p0,f32x16&p1,int jb,int qrel,int hi){
  const float NEG=-INFINITY; int kb=64*jb+4*hi;
  #pragma unroll
  for(int r=0;r<16;++r){int kv=kb+(r&3)+8*(r>>2); if(kv>qrel)p0[r]=NEG; if(kv+32>qrel)p1[r]=NEG;}
}

constexpr int NSLOT=3, SLOTB=8192;
constexpr int LDS_K=0, LDS_V=NSLOT*SLOTB, LDS_WS=2*NSLOT*SLOTB, LDS_OST=LDS_WS+NW*64*4, LDS_CB=LDS_OST+NW*4096, LDS_BYTES=LDS_CB+SEQ*4;
constexpr float C2=0.125f*1.4426950408889634f;
__device__ __forceinline__ void glds16(const void*gsrc,unsigned lds_dst){unsigned keep;
  asm volatile("s_mov_b32 %0, m0\n\ts_mov_b32 m0, %2\n\ts_nop 0\n\tglobal_load_lds_dwordx4 %1, off\n\ts_mov_b32 m0, %0":"=&s"(keep):"v"(gsrc),"s"(lds_dst):"memory");}
__device__ __forceinline__ float max3f(float a,float b,float c){float r;asm("v_max3_f32 %0, %1, %2, %3":"=v"(r):"v"(a),"v"(b),"v"(c));return r;}
__device__ __forceinline__ float max2f(float a,float b){float r;asm("v_max_f32_e32 %0, %1, %2":"=v"(r):"v"(a),"v"(b));return r;}
__device__ __forceinline__ float fadd_s(float a,float b){float r;asm("v_add_f32_e32 %0, %1, %2":"=v"(r):"v"(a),"v"(b));return r;}
__device__ __forceinline__ float fsub_s(float a,float b){float r;asm("v_sub_f32_e32 %0, %1, %2":"=v"(r):"v"(a),"v"(b));return r;}
typedef float f32x2_t __attribute__((ext_vector_type(2))); typedef __bf16 bf16x2_t __attribute__((ext_vector_type(2)));
__device__ __forceinline__ unsigned cvtpk_s(float lo,float hi){f32x2_t v={lo,hi};bf16x2_t b=__builtin_convertvector(v,bf16x2_t);return __builtin_bit_cast(unsigned,b);}
#define WAIT_BAR(N) asm volatile("s_waitcnt vmcnt(" #N ") lgkmcnt(0)\n\ts_barrier":::"memory")

__device__ __forceinline__ void qkt(f32x16&p0,f32x16&p1,const char*Kslot,const bf16x8*qr,int r32,int hi){
  const char*kb=Kslot+hi*1024+r32*16;
  #pragma unroll
  for(int d0=0;d0<4;++d0){
    const bf16x8 b0=*reinterpret_cast<const bf16x8*>(kb+d0*2048);
    const bf16x8 b1=*reinterpret_cast<const bf16x8*>(kb+d0*2048+512);
    {p0=__builtin_amdgcn_mfma_f32_32x32x16_bf16(b0,qr[d0],p0,0,0,0);p1=__builtin_amdgcn_mfma_f32_32x32x16_bf16(b1,qr[d0],p1,0,0,0);}}
}
typedef __attribute__((address_space(3))) const char* lds_cptr;
typedef short v4i16_t __attribute__((ext_vector_type(4)));
typedef float f32x4_t __attribute__((ext_vector_type(4)));
__device__ __forceinline__ void kload8(bf16x8*kf,lds_cptr kp){
  kf[0]=*(const __attribute__((address_space(3))) bf16x8*)(kp);      kf[1]=*(const __attribute__((address_space(3))) bf16x8*)(kp+512);
  kf[2]=*(const __attribute__((address_space(3))) bf16x8*)(kp+2048); kf[3]=*(const __attribute__((address_space(3))) bf16x8*)(kp+2560);
  kf[4]=*(const __attribute__((address_space(3))) bf16x8*)(kp+4096); kf[5]=*(const __attribute__((address_space(3))) bf16x8*)(kp+4608);
  kf[6]=*(const __attribute__((address_space(3))) bf16x8*)(kp+6144); kf[7]=*(const __attribute__((address_space(3))) bf16x8*)(kp+6656);
}
__device__ __forceinline__ void kload2(bf16x8*kf,lds_cptr kp,int j){ kf[2*j]=*(const __attribute__((address_space(3))) bf16x8*)(kp+j*2048); kf[2*j+1]=*(const __attribute__((address_space(3))) bf16x8*)(kp+j*2048+512); }
__device__ __forceinline__ s16x4 vtr(lds_cptr p){ return __builtin_bit_cast(s16x4,__builtin_amdgcn_ds_read_tr16_b64_v4i16((__attribute__((address_space(3))) v4i16_t*)p)); }
__device__ __forceinline__ float rowmax(const f32x16&p0,const f32x16&p1){
  float a=max3f(p0[0],p0[1],p1[0]),b=max3f(p0[2],p0[3],p1[1]);a=max3f(a,p1[2],p1[3]);
  #pragma unroll
  for(int r=4;r<16;r+=4){a=max3f(a,p0[r],p0[r+1]);b=max3f(b,p0[r+2],p0[r+3]);a=max3f(a,p1[r],p1[r+1]);b=max3f(b,p1[r+2],p1[r+3]);}
  const float m=max2f(a,b);
  auto rr=__builtin_amdgcn_permlane32_swap(__float_as_uint(m),__float_as_uint(m),false,false);
  return max2f(__uint_as_float(rr[0]),__uint_as_float(rr[1]));
}
__device__ __forceinline__ void pv(f32x16*o,int vb,bf16x8 pa0,bf16x8 pa1,bf16x8 pa2,bf16x8 pa3){
  #pragma unroll
  for(int d0=0;d0<2;++d0){s16x4 lo[4],hi[4];
    #pragma unroll
    for(int ks=0;ks<4;++ks){
      asm volatile("ds_read_b64_tr_b16 %0,%1 offset:%c2":"=&v"(lo[ks]):"v"(vb),"i"(d0*4096+ks*1024):"memory");
      asm volatile("ds_read_b64_tr_b16 %0,%1 offset:%c2":"=&v"(hi[ks]):"v"(vb),"i"(d0*4096+ks*1024+512):"memory");}
    asm volatile("s_waitcnt lgkmcnt(0)":::"memory");SBAR();
    #define PK(k) (bf16x8){lo[k][0],lo[k][1],lo[k][2],lo[k][3],hi[k][0],hi[k][1],hi[k][2],hi[k][3]}
    o[d0]=__builtin_amdgcn_mfma_f32_32x32x16_bf16(pa0,PK(0),o[d0],0,0,0);
    o[d0]=__builtin_amdgcn_mfma_f32_32x32x16_bf16(pa1,PK(1),o[d0],0,0,0);
    o[d0]=__builtin_amdgcn_mfma_f32_32x32x16_bf16(pa2,PK(2),o[d0],0,0,0);
    o[d0]=__builtin_amdgcn_mfma_f32_32x32x16_bf16(pa3,PK(3),o[d0],0,0,0);
    #undef PK
  }
}

#ifndef ATTN_STORE16
#define ATTN_STORE16(p,v) (*(u32x4*)(p)=(v))
#endif
template<int THRL> __device__ __forceinline__ void attn_unit(int b,int h,int qb,const bf16*Q,const bf16*__restrict__ K,const bf16*__restrict__ V,bf16*O,const float*cbg_,char*shm,int ts=0){
  int tid_=threadIdx.x; asm volatile("":"+v"(tid_)); const int tid=tid_,lane=tid&63,r32=lane&31,hi=lane>>5; const int wid=__builtin_amdgcn_readfirstlane(tid>>6);
  const long rowbase=(long)b*SEQ; const int q0=qb*QB;
  const bf16*Qw=Q+(rowbase+q0+wid*QBLK)*DM+h*D;
  const bf16*Kh=K+(rowbase+(long)ts*KVBLK)*DM+h*D,*Vh=V+(rowbase+(long)ts*KVBLK)*DM+h*D; const float*cbg=cbg_+ts*KVBLK;
  const unsigned lds0=(unsigned)(uintptr_t)shm;
  float*wsf=(float*)(shm+LDS_WS)+wid*64;
  const bf16*ksrc=Kh+(long)lane*DM+wid*8;
  const bf16*vsrc=Vh+(long)(16*(wid&3)+(lane>>2))*DM+(wid>>2)*32+(lane&3)*8;
  const unsigned kdst=lds0+LDS_K+wid*1024, vdst=lds0+LDS_V+wid*1024;
  #define DMA_K(t,slot) glds16(ksrc+(long)(t)*KVBLK*DM,(unsigned)__builtin_amdgcn_readfirstlane(kdst+(slot)))
  #define DMA_V(t,slot) glds16(vsrc+(long)(t)*KVBLK*DM,(unsigned)__builtin_amdgcn_readfirstlane(vdst+(slot)))
  const int vb0=(int)(lds0+LDS_V)+((lane>>4)&1)*32+(lane&3)*8+(4*hi+((lane&15)>>2))*64;
  const char*Kbase=shm+LDS_K; bf16x8 kf[8];
  const lds_cptr shm3=(lds_cptr)shm; const lds_cptr kp0=shm3+LDS_K+hi*1024+r32*16; const lds_cptr vp0=shm3+LDS_V+((lane>>4)&1)*32+(lane&3)*8+(4*hi+((lane&15)>>2))*64;
  const int NT=(q0+QB)/KVBLK-ts;
  { const int nfl=q0+QB-ts*KVBLK; for(int i_=tid*4;i_<nfl;i_+=NW*64*4){ const f32x4_t v_=*(const f32x4_t*)(cbg+i_); *(__attribute__((address_space(3))) f32x4_t*)(shm3+LDS_CB+i_*4)=v_; } }
  #define CLOAD(C0,C1,t) do{ const __attribute__((address_space(3))) f32x4_t* cb_=(const __attribute__((address_space(3))) f32x4_t*)(shm3+LDS_CB)+((t)*16+hi); \
    _Pragma("unroll") for(int i_=0;i_<4;++i_){ const f32x4_t b0_=cb_[2*i_], b1_=cb_[8+2*i_]; \
      _Pragma("unroll") for(int j_=0;j_<4;++j_){ C0[4*i_+j_]=b0_[j_]; C1[4*i_+j_]=b1_[j_]; } } }while(0)
  #define CSUB(C0,C1) do{ _Pragma("unroll") for(int r_=0;r_<16;++r_){ C0[r_]-=mhat; C1[r_]-=mhat; } }while(0)
  DMA_K(0,0);DMA_V(0,0);DMA_K(1,SLOTB);
  bf16x8 qr[4];
  #pragma unroll
  for(int d0=0;d0<4;++d0)qr[d0]=*reinterpret_cast<const bf16x8*>(&Qw[(long)r32*DM+d0*16+hi*8]);
  float mhat=0.f,l_reg=0.f;f32x16 o[2];o[0]=f32x16{};o[1]=f32x16{};
  const int qrel=wid*QBLK+r32;
  #define CMASK(P0,P1,t) do{int jb_=(t)-(NT-4); if(jb_>=0)cmask(P0,P1,jb_,qrel,hi);}while(0)
  bool resc=false;
  #define START(P0,P1) do{ const float rm=rowmax(P0,P1); resc=false; \
    { const float dl=rm; mhat=fadd_s(mhat,dl); \
      _Pragma("unroll") for(int r=0;r<16;++r){P0[r]=fsub_s(P0[r],dl);P1[r]=fsub_s(P1[r],dl);} \
      } \
    _Pragma("unroll") for(int r=0;r<16;++r)P0[r]=__builtin_amdgcn_exp2f(P0[r]); }while(0)
  #define RESC() do{ if(resc){ asm volatile("s_waitcnt lgkmcnt(0)":::"memory"); \
      _Pragma("unroll") for(int d_=0;d_<2;++d_) _Pragma("unroll") for(int r=0;r<16;++r)o[d_][r]*=wsf[crow(r,hi)]; } }while(0)
  f32x16 pA0,pA1,pB0,pB1;
  int sl_prev=0,sl_cur=0,sl_next=SLOTB;
  #define ROT() do{sl_prev=sl_cur;sl_cur=sl_next;sl_next=(sl_next==(NSLOT-1)*SLOTB)?0:sl_next+SLOTB;}while(0)
  DMA_K(2,2*SLOTB);
  WAIT_BAR(3);
  CLOAD(pA0,pA1,0); qkt(pA0,pA1,Kbase,qr,r32,hi);asm volatile("s_nop 15\n\ts_nop 7":"+v"(pA0),"+v"(pA1));CMASK(pA0,pA1,0);
  START(pA0,pA1);
  _Pragma("unroll") for(int r=0;r<16;++r)pA1[r]=__builtin_amdgcn_exp2f(pA1[r]);
  CLOAD(pB0,pB1,1);
  WAIT_BAR(0);
  DMA_K(3,0);DMA_V(1,SLOTB);
  ROT();
  kload8(kf,kp0+sl_cur);
  WAIT_BAR(2);
  s16x4 vlo[8],vhi[8]; u32x4 pw0,pw1,pw2,pw3;
  #define PKW(P,B) cvtpk_s(P[B],P[B+1])
  #define PAF(k) __builtin_bit_cast(bf16x8,pw##k)
  #define VFR(i) (bf16x8){vlo[i][0],vlo[i][1],vlo[i][2],vlo[i][3],vhi[i][0],vhi[i][1],vhi[i][2],vhi[i][3]}
  #define PIN(x) asm volatile("":"+v"(x))
  #define MX3(a,b,c) __builtin_fmaxf(__builtin_fmaxf((a),(b)),(c))
  #define GAPA(MF,A0,A1,A2,A3,W0,W1,PW) do{ MF; sacc+=A0; sacc+=A1; sacc+=A2; sacc+=A3; PIN(sacc); W0; W1; PIN(PW); SBAR(); }while(0)
  #define EX(v) __builtin_amdgcn_exp2f(v)
  #define GAPB(MF,X,B) do{ MF; X[B]=EX(X[B]); X[B+1]=EX(X[B+1]); X[B+2]=EX(X[B+2]); X[B+3]=EX(X[B+3]); PIN(X); SBAR(); }while(0)
  #define VRD(i) do{ vlo[i]=vtr(vp_+(((i)>>2)*4096+((i)&3)*1024)); vhi[i]=vtr(vp_+(((i)>>2)*4096+((i)&3)*1024+512)); }while(0)
  #define KRD(G,j) do{ if(G){ kload2(kf,kp0+sl_next,j); SBAR(); } }while(0)
  #define STEP(C0,C1,P0,P1,t,GK,GV,GL) do{ SBAR(); CSUB(C0,C1); SBAR(); \
    const lds_cptr vp_=vp0+sl_prev; \
    VRD(0); SBAR(); float sacc=(P0[0]+P0[1]); \
    GAPA(C0=__builtin_amdgcn_mfma_f32_32x32x16_bf16(kf[0],qr[0],C0,0,0,0), P0[2],P0[3],P0[4],P0[5],     pw0[0]=PKW(P0,0), pw0[1]=PKW(P0,2), pw0); \
    VRD(4); SBAR(); GAPA(C1=__builtin_amdgcn_mfma_f32_32x32x16_bf16(kf[1],qr[0],C1,0,0,0), P0[6],P0[7],P0[8],P0[9],     pw0[2]=PKW(P0,4), pw0[3]=PKW(P0,6), pw0); \
    VRD(1); SBAR(); GAPA(C0=__builtin_amdgcn_mfma_f32_32x32x16_bf16(kf[2],qr[1],C0,0,0,0),   P0[10],P0[11],P0[12],P0[13], pw1[0]=PKW(P0,8), pw1[1]=PKW(P0,10), pw1); \
    VRD(5); SBAR(); GAPA(C1=__builtin_amdgcn_mfma_f32_32x32x16_bf16(kf[3],qr[1],C1,0,0,0),   P0[14],P0[15],P1[0],P1[1],   pw1[2]=PKW(P0,12),pw1[3]=PKW(P0,14), pw1); \
    VRD(2); SBAR(); GAPA(C0=__builtin_amdgcn_mfma_f32_32x32x16_bf16(kf[4],qr[2],C0,0,0,0),   P1[2],P1[3],P1[4],P1[5],     pw2[0]=PKW(P1,0), pw2[1]=PKW(P1,2), pw2); \
    VRD(6); SBAR(); GAPA(C1=__builtin_amdgcn_mfma_f32_32x32x16_bf16(kf[5],qr[2],C1,0,0,0),   P1[6],P1[7],P1[8],P1[9],     pw2[2]=PKW(P1,4), pw2[3]=PKW(P1,6), pw2); \
    VRD(3); SBAR(); GAPA(C0=__builtin_amdgcn_mfma_f32_32x32x16_bf16(kf[6],qr[3],C0,0,0,0),   P1[10],P1[11],P1[12],P1[13], pw3[0]=PKW(P1,8), pw3[1]=PKW(P1,10), pw3); \
    VRD(7); SBAR(); GAPA(C1=__builtin_amdgcn_mfma_f32_32x32x16_bf16(kf[7],qr[3],C1,0,0,0),   P1[14],P1[15],0.f,0.f,       pw3[2]=PKW(P1,12),pw3[3]=PKW(P1,14), pw3); \
    l_reg+=sacc; \
    if(GK){DMA_K((t)+3,sl_cur);} if(GV){DMA_V((t)+1,sl_next);} \
    CMASK(C0,C1,t); \
    { float a=MX3(C0[0],C0[1],C1[0]),b=MX3(C0[2],C0[3],C1[1]); a=MX3(a,C1[2],C1[3]); \
      _Pragma("unroll") for(int r=4;r<16;r+=4){a=MX3(a,C0[r],C0[r+1]);b=MX3(b,C0[r+2],C0[r+3]);a=MX3(a,C1[r],C1[r+1]);b=MX3(b,C1[r+2],C1[r+3]);} \
      float rm=__builtin_fmaxf(a,b); { auto rr=__builtin_amdgcn_permlane32_swap(__float_as_uint(rm),__float_as_uint(rm),false,false); rm=__builtin_fmaxf(__uint_as_float(rr[0]),__uint_as_float(rr[1])); } \
      resc=false; \
      if(__builtin_expect(__any(rm>(float)THRL),0)){ const float dl=__builtin_fmaxf(rm,0.f); mhat+=dl; \
        _Pragma("unroll") for(int r=0;r<16;++r){C0[r]-=dl;C1[r]-=dl;} \
        const float f=__builtin_amdgcn_exp2f(-dl); l_reg*=f; if(hi==0)wsf[r32]=f; resc=true; } } \
    SBAR(); CLOAD(P0,P1,(t)+1); SBAR(); \
    GAPB(o[0]=__builtin_amdgcn_mfma_f32_32x32x16_bf16(PAF(0),VFR(0),o[0],0,0,0), C0,0); \
    GAPB(o[1]=__builtin_amdgcn_mfma_f32_32x32x16_bf16(PAF(0),VFR(4),o[1],0,0,0), C0,4); \
    KRD(GL,0); GAPB(o[0]=__builtin_amdgcn_mfma_f32_32x32x16_bf16(PAF(1),VFR(1),o[0],0,0,0), C0,8); \
    KRD(GL,1); GAPB(o[1]=__builtin_amdgcn_mfma_f32_32x32x16_bf16(PAF(1),VFR(5),o[1],0,0,0), C0,12); \
    KRD(GL,2); GAPB(o[0]=__builtin_amdgcn_mfma_f32_32x32x16_bf16(PAF(2),VFR(2),o[0],0,0,0), C1,0); \
    KRD(GL,3); GAPB(o[1]=__builtin_amdgcn_mfma_f32_32x32x16_bf16(PAF(2),VFR(6),o[1],0,0,0), C1,4); \
    GAPB(o[0]=__builtin_amdgcn_mfma_f32_32x32x16_bf16(PAF(3),VFR(3),o[0],0,0,0), C1,8); \
    GAPB(o[1]=__builtin_amdgcn_mfma_f32_32x32x16_bf16(PAF(3),VFR(7),o[1],0,0,0), C1,12); \
    }while(0)
  int t=1;
  #undef CMASK
  #define CMASK(P0,P1,t) do{}while(0)
  for(;t+5<NT;t+=2){
    STEP(pB0,pB1,pA0,pA1,t,true,true,true);     WAIT_BAR(2); RESC(); ROT();
    STEP(pA0,pA1,pB0,pB1,t+1,true,true,true);   WAIT_BAR(2); RESC(); ROT();
  }
  #undef CMASK
  #define CMASK(P0,P1,t) do{int jb_=(t)-(NT-4); if(jb_>=0)cmask(P0,P1,jb_,qrel,hi);}while(0)
  #define ENDW(tt) do{ if((tt)+3<NT){WAIT_BAR(2);} else if((tt)+2<NT){WAIT_BAR(1);} else {WAIT_BAR(0);} }while(0)
  for(;t+1<NT;t+=2){
    STEP(pB0,pB1,pA0,pA1,t,(t+3<NT),(t+1<NT),(t+1<NT));       ENDW(t);   RESC(); ROT();
    STEP(pA0,pA1,pB0,pB1,t+1,(t+4<NT),(t+2<NT),(t+2<NT));     ENDW(t+1); RESC(); ROT();
  }
  STEP(pB0,pB1,pA0,pA1,NT-1,false,false,false); RESC();
  { float sacc=pB0[0]+pB0[1]; _Pragma("unroll") for(int r=2;r<16;++r)sacc+=pB0[r]; _Pragma("unroll") for(int r=0;r<16;++r)sacc+=pB1[r]; l_reg+=sacc;
    pw0=(u32x4){PKW(pB0,0),PKW(pB0,2),PKW(pB0,4),PKW(pB0,6)};pw1=(u32x4){PKW(pB0,8),PKW(pB0,10),PKW(pB0,12),PKW(pB0,14)};pw2=(u32x4){PKW(pB1,0),PKW(pB1,2),PKW(pB1,4),PKW(pB1,6)};pw3=(u32x4){PKW(pB1,8),PKW(pB1,10),PKW(pB1,12),PKW(pB1,14)};
    SBAR(); pv(o,vb0+sl_cur,PAF(0),PAF(1),PAF(2),PAF(3)); }
  #undef PKW
  #undef PAF
  #undef VFR
  #undef PIN
  #undef MX3
  #undef GAPA
  #undef GAPB
  #undef EX
  #undef VRD
  #undef KRD
  #undef STEP
  #undef ENDW
  {auto rr=__builtin_amdgcn_permlane32_swap(__float_as_uint(l_reg),__float_as_uint(l_reg),false,false);l_reg=__uint_as_float(rr[0])+__uint_as_float(rr[1]);}
  if(hi==0)wsf[32+r32]=l_reg;asm volatile("s_waitcnt lgkmcnt(0)":::"memory");
  float rli[16];
  #pragma unroll
  for(int r=0;r<16;++r)rli[r]=__builtin_amdgcn_rcpf(wsf[32+crow(r,hi)]);
  bf16*Ow=O+(rowbase+q0+wid*QBLK)*DM+h*D;
  { bf16*stg=(bf16*)(shm+LDS_OST)+wid*2048;
    #pragma unroll
    for(int r=0;r<16;++r){const int orow=crow(r,hi);
      #pragma unroll
      for(int d0=0;d0<2;++d0)stg[orow*64+d0*32+r32]=__float2bfloat16(o[d0][r]*rli[r]);}
    asm volatile("s_waitcnt lgkmcnt(0)":::"memory");
    #pragma unroll
    for(int i=0;i<4;++i){const int row=i*8+(lane>>3),ch=lane&7; const u32x4 v=*(const u32x4*)(stg+row*64+ch*8); ATTN_STORE16(Ow+(long)row*DM+ch*8,v);} }
  asm volatile("s_waitcnt lgkmcnt(0)\n\ts_barrier":::"memory");
  #undef DMA_K
  #undef CLOAD
  #undef CSUB
  #undef DMA_V
  #undef CMASK
  #undef START
  #undef RESC
  #undef ROT
}
constexpr int ATTN_LDS_BYTES=LDS_BYTES;
struct AttnTensors { const bf16* Q; const bf16* K; const bf16* V; bf16* O; const float* CB; };
struct AttnUnit { int bh; int qb; };
struct StaticOrder {
  int vcu;
  __device__ __forceinline__ explicit StaticOrder(int grid,int block):vcu((block%8)*(grid/8)+block/8){}
  __device__ __forceinline__ bool next(int i,AttnUnit&u)const{ if(i>=4)return false; const int s=vcu&7; u.bh=vcu>>3; u.qb=(i==0)?s:(i==1)?15-s:(i==2)?16+s:31-s; return true; }
  __device__ __forceinline__ void a_ready(const AttnUnit&)const{}
  __device__ __forceinline__ void done(const AttnUnit&)const{}
};
template<class Sched,int THRL=8> __device__ __forceinline__ void attn_phase(char*lds,const AttnTensors&T,const Sched&S){
  AttnUnit u;
  for(int i=0;S.next(i,u);++i){ S.a_ready(u); attn_unit<THRL>(u.bh/NHEAD,u.bh%NHEAD,u.qb,T.Q,T.K,T.V,T.O,T.CB+(size_t)u.bh*SEQ,lds); S.done(u); }
}
#undef SBAR
#undef WAIT_BAR
}
#define GAS __attribute__((address_space(1)))
#define LAS __attribute__((address_space(3)))
typedef unsigned short bf16;
typedef unsigned v4u __attribute__((ext_vector_type(4)));
typedef float f32x4 __attribute__((ext_vector_type(4)));
typedef short bf16x8 __attribute__((ext_vector_type(8)));
typedef GAS unsigned gu32;
typedef GAS unsigned long long gu64;
#define RLX_AGENT __ATOMIC_RELAXED, __HIP_MEMORY_SCOPE_AGENT
#define LDS_WAIT() asm volatile("s_waitcnt lgkmcnt(0)" ::: "memory")
#define VM_WAIT() asm volatile("s_waitcnt vmcnt(0)" ::: "memory")
__device__ __forceinline__ unsigned long long rt() { return __builtin_amdgcn_s_memrealtime(); }
__device__ __forceinline__ unsigned f2bf(float f) { unsigned u = __builtin_bit_cast(unsigned, f); return (u + 0x7fffu + ((u >> 16) & 1u)) >> 16; }
__device__ __forceinline__ unsigned pk2(float lo, float hi) { return f2bf(lo) | (f2bf(hi) << 16); }

#define XB_TMO      128
#define XB_XCNT(j)  (256  + 64 * (j))
#define XB_XSUB(j)  (1280 + 64 * (j))
#define XB_XGEN(j)  (2304 + 64 * (j))
#define XB_TOP      3328
#define XB_TOPGEN   3392
#define XCD_BAR_WORDS 3456
#define XB_SPIN_CAP (1u << 18)

__device__ __forceinline__ unsigned xb_ld(unsigned* p)              { return __hip_atomic_load(p, __ATOMIC_RELAXED, __HIP_MEMORY_SCOPE_AGENT); }
__device__ __forceinline__ unsigned xb_add(unsigned* p, unsigned v) { return __hip_atomic_fetch_add(p, v, __ATOMIC_RELAXED, __HIP_MEMORY_SCOPE_AGENT); }
__device__ __forceinline__ unsigned xb_xcc_id() { return (unsigned)__builtin_amdgcn_s_getreg((3 << 11) | 20) & 0xFu; }
#define XB_SPIN(cond, bar) do { unsigned _sp = 0; while (cond) { __builtin_amdgcn_s_sleep(1); \
    if ((++_sp & 255u) == 0u) { if (xb_ld(&(bar)[XB_TMO])) break; if (_sp > XB_SPIN_CAP) { atomicAdd(&(bar)[XB_TMO], 1u); break; } } } } while (0)

struct XcdBarrier {
    unsigned* bar; unsigned x;
    volatile LAS unsigned* st;
};

__device__ __forceinline__ XcdBarrier xcd_barrier_post(unsigned* bar, volatile LAS unsigned* st) {
    XcdBarrier b; b.bar = bar; b.x = xb_xcc_id(); b.st = st;
    if (threadIdx.x == 0) (void)xb_add(&bar[XB_XCNT(b.x)], 1u);
    return b;
}
__device__ __forceinline__ void xcd_barrier_complete(unsigned* bar, unsigned x, unsigned& nloc, unsigned& nx) {
    const unsigned G = gridDim.x * gridDim.y * gridDim.z;
    unsigned sum, cnt, mine, sp = 0u;
    for (;;) {
        sum = 0u; cnt = 0u; mine = 0u;
#pragma unroll
        for (unsigned j = 0; j < 16; ++j) { const unsigned c = xb_ld(&bar[XB_XCNT(j)]); sum += c; cnt += (c > 0u) ? 1u : 0u; mine = (j == x) ? c : mine; }
        if (sum == G) break;
        __builtin_amdgcn_s_sleep(1);
        if ((++sp & 255u) == 0u) { if (xb_ld(&bar[XB_TMO])) break; if (sp > XB_SPIN_CAP) { atomicAdd(&bar[XB_TMO], 1u); break; } }
    }
    nloc = mine > 0u ? mine : 1u; nx = cnt > 0u ? cnt : 1u;
}

__device__ __forceinline__ void xcd_barrier(const XcdBarrier& b) {
    asm volatile("s_waitcnt vmcnt(0)" ::: "memory");
    __syncthreads();
    if (threadIdx.x == 0) {
        unsigned* bar = b.bar;
        __builtin_amdgcn_s_waitcnt(0);
        unsigned nloc = b.st[0], nx = b.st[1];
        if (nloc == 0u) { xcd_barrier_complete(bar, b.x, nloc, nx); b.st[0] = nloc; b.st[1] = nx; }
        const unsigned old = xb_add(&bar[XB_XSUB(b.x)], 1u);
        const unsigned gen = old / nloc;
        if (old + 1u == (gen + 1u) * nloc) {
            __builtin_amdgcn_fence(__ATOMIC_RELEASE, "agent");
            asm volatile("s_waitcnt vmcnt(0)" ::: "memory");
            const unsigned og = xb_add(&bar[XB_TOP], 1u);
            const unsigned tg = og / nx;
            if (og + 1u == (tg + 1u) * nx) xb_add(&bar[XB_TOPGEN], 1u);
            else XB_SPIN(xb_ld(&bar[XB_TOPGEN]) == tg, bar);
            __builtin_amdgcn_fence(__ATOMIC_ACQUIRE, "agent");
            xb_add(&bar[XB_XGEN(b.x)], 1u);
            asm volatile("s_waitcnt vmcnt(0)" ::: "memory");
        } else {
            XB_SPIN(xb_ld(&bar[XB_XGEN(b.x)]) == gen, bar);
            __builtin_amdgcn_fence(__ATOMIC_ACQUIRE, "agent");
            asm volatile("s_waitcnt vmcnt(0)" ::: "memory");
        }
    }
    __syncthreads();
}

constexpr int NWAVES = 8, NG = 256, NGW = NG * NWAVES;
constexpr int BATCH = 4, T = 8192, D = 1024, M = BATCH * T, NLAYER = 2;
constexpr int RW = 512, RH = 8;
constexpr int R_COLS = 1792, C_COLS = 1536, IN_COLS = 7944, INA_N = 5120, INP_N = 8192;
constexpr int DFF = 2816, DFFE = 3584, NEXP = 8;
constexpr int MOE_HALF = M / 2, MOE_ROWS = MOE_HALF * 2 + NEXP * 256;
constexpr float LN_EPS = 1e-5f, RWKV_LN_EPS = 64e-5f;
constexpr float DN_ALPHA = 1.4142135623730951f;
constexpr float LOG2E = 1.4426950408889634f;

constexpr size_t MiB = 1u << 20, KiB = 1u << 10;
constexpr size_t WS_CTL = 0, CTL_ZERO_BYTES = 1 * MiB;
constexpr size_t WS_FL = 1 * MiB, WS_CB = 2 * MiB;
constexpr size_t WS_TOKE = 3 * MiB, WS_TOKG = WS_TOKE + 128 * KiB, WS_PPOS = WS_TOKG + 256 * KiB, WS_RTOK = WS_PPOS + 256 * KiB;
constexpr size_t WS_WL = 5 * MiB;
constexpr size_t WS_X = 8 * MiB;
constexpr size_t WS_WIN = 72 * MiB, WS_WUP = 104 * MiB, WS_WOUT = 110 * MiB, WS_W13 = 114 * MiB, WS_W2 = 125 * MiB;
constexpr size_t WS_L = 132 * MiB;
constexpr size_t WS_C = WS_L, WS_FQ = 228 * MiB, WS_FK = 260 * MiB, WS_FV = 292 * MiB, WS_LA = 324 * MiB, WS_LW = 340 * MiB, WS_LAO = 404 * MiB, WS_LG = 436 * MiB,
                 WS_OB = 468 * MiB, WS_OA = 500 * MiB, WS_BV = 532 * MiB;
constexpr size_t WS_G2 = WS_LW, WS_MG = WS_FK, WS_H = WS_L;
constexpr size_t WS_PM = WS_C, WS_QM = WS_C + 32 * MiB, WS_RH = WS_C + 64 * MiB;
constexpr size_t WS_WM13 = 72 * MiB, WS_WM2 = 184 * MiB, WS_HM = 240 * MiB, WS_YP = 478 * MiB, WS_YPS = 546 * MiB, WS_END = 580 * MiB;
constexpr int MOE_MAINP = 128;
static_assert(WS_RTOK + 2 * MOE_ROWS * 4 <= 4 * MiB && WS_WL + 2 * 1536 * 256 * 2 <= WS_X, "small tables");
static_assert(WS_W2 + (size_t)D * DFF * 2 <= WS_L && WS_BV + (size_t)M * RW * 2 <= WS_END && WS_H + (size_t)M * DFF * 2 <= WS_END, "ws map");
static_assert(WS_YPS + (size_t)4 * 8 * 256 * D * 2 <= WS_END && WS_YP + (size_t)MOE_ROWS * D * 2 <= WS_YPS && WS_WM13 + (size_t)NEXP * 2 * DFFE * D * 2 == WS_WM2 && WS_WM2 + (size_t)NEXP * D * DFFE * 2 == WS_HM && WS_HM + (size_t)MOE_ROWS * DFFE * 2 == WS_YP && WS_YP + (size_t)MOE_ROWS * D * 2 <= WS_END, "moe map");
constexpr int CW_TMO = 0, CW_CODE = 1, CW_BAR = 4096, CW_QATT = 8192, CW_CNT = 12288, CW_FILL = 14336, CW_NRM = 16384;

constexpr int RING_OFF = 0, RING_BYTES = 131072;
constexpr int NRM_OFF = RING_BYTES + 512;
constexpr int LDSCTL_OFF = RING_BYTES, MISC_OFF = LDSCTL_OFF + 320, PEXP_OFF = LDSCTL_OFF + 1024, MOFF_OFF = LDSCTL_OFF + 2048, LCNT_OFF = LDSCTL_OFF + 2304, LFIL_OFF = LDSCTL_OFF + 2432, LBAS_OFF = LDSCTL_OFF + 2560;
constexpr int LDS_BYTES = 147456;

struct Args { const float* in[34]; float* out; unsigned char* ws; };
struct Frame {
    LAS unsigned char* lds; volatile LAS unsigned* MISC; gu32* ctl;
    int tid, lane, wave, vcu, G;
};
template <int CTRL> __device__ __forceinline__ float dpp_mov(float v) { return __builtin_bit_cast(float, __builtin_amdgcn_update_dpp(0, __builtin_bit_cast(int, v), CTRL, 0xf, 0xf, false)); }
__device__ __forceinline__ float red8(float v) { v += dpp_mov<0xB1>(v); v += dpp_mov<0x4E>(v); v += dpp_mov<0x141>(v); return v; }
__device__ __forceinline__ float red16(float v) { v = red8(v); v += dpp_mov<0x140>(v); return v; }
__device__ __forceinline__ float swap32_add(float v) { float a = v, b = v; asm volatile("s_nop 1\n\tv_permlane32_swap_b32 %0, %1" : "+v"(a), "+v"(b)); return a + b; }
__device__ __forceinline__ float wave_sum(float v) { v = swap32_add(red16(v));
    const float a = __builtin_bit_cast(float, __builtin_amdgcn_readlane(__builtin_bit_cast(int, v), 0)), b = __builtin_bit_cast(float, __builtin_amdgcn_readlane(__builtin_bit_cast(int, v), 16)); return a + b; }
__device__ __forceinline__ float bfu(unsigned short u) { return __builtin_bit_cast(float, (unsigned)u << 16); }
__device__ __forceinline__ float bflo(unsigned w) { return __builtin_bit_cast(float, w << 16); }
__device__ __forceinline__ float bfhi(unsigned w) { return __builtin_bit_cast(float, w & 0xffff0000u); }
__device__ __forceinline__ float sigm(float x) { return __builtin_amdgcn_rcpf(1.0f + __expf(-x)); }

__device__ __forceinline__ void tr_item(const float* W, int ldw, int sk0, int n0, int nvalid, bf16* dst, int ldk, int dk0, float scale, LAS float* scr, int lane) {
    const int r8 = lane >> 3, c4 = (lane & 7) * 4; f32x4 w[8];
#pragma unroll
    for (int i = 0; i < 8; ++i) { w[i] = (f32x4){0.f, 0.f, 0.f, 0.f}; if (c4 < nvalid) w[i] = *(const GAS f32x4*)(W + (size_t)(sk0 + 8 * i + r8) * ldw + n0 + c4); }
#pragma unroll
    for (int i = 0; i < 8; ++i) { LAS float* d = scr + (8 * i + r8) * 33 + c4; d[0] = w[i][0] * scale; d[1] = w[i][1] * scale; d[2] = w[i][2] * scale; d[3] = w[i][3] * scale; }
    LDS_WAIT(); asm volatile("" ::: "memory");
    const int c = lane & 7;
#pragma unroll
    for (int j = 0; j < 4; ++j) { const int n = (lane >> 3) + 8 * j; const LAS float* s = scr + (8 * c) * 33 + n;
        v4u o; o.x = pk2(s[0 * 33], s[1 * 33]); o.y = pk2(s[2 * 33], s[3 * 33]); o.z = pk2(s[4 * 33], s[5 * 33]); o.w = pk2(s[6 * 33], s[7 * 33]);
        *(GAS v4u*)(dst + (size_t)n * ldk + dk0 + 8 * c) = o; }
    LDS_WAIT(); asm volatile("" ::: "memory");
}

__device__ __forceinline__ void ln_norm(f32x4 (&v)[4], const float* g, const float* b, int lane) {
    float s = 0.f;
#pragma unroll
    for (int j = 0; j < 4; ++j) s += (v[j].x + v[j].y) + (v[j].z + v[j].w);
    const float mean = wave_sum(s) * (1.f / D); float s2 = 0.f;
#pragma unroll
    for (int j = 0; j < 4; ++j) { v[j] = v[j] - mean; s2 += (v[j].x * v[j].x + v[j].y * v[j].y) + (v[j].z * v[j].z + v[j].w * v[j].w); }
    const float rstd = 1.f / sqrtf(wave_sum(s2) * (1.f / D) + LN_EPS);
#pragma unroll
    for (int j = 0; j < 4; ++j) { const f32x4 gg = *(const f32x4*)(g + 4 * lane + 256 * j), bb = *(const f32x4*)(b + 4 * lane + 256 * j); v[j] = v[j] * rstd * gg + bb; }
}
__device__ __forceinline__ void row_store_bf16(bf16* orow, const f32x4 (&v)[4], int lane) {
    GAS unsigned long long* o8 = (GAS unsigned long long*)orow + lane;
#pragma unroll
    for (int j = 0; j < 4; ++j) o8[64 * j] = (unsigned long long)pk2(v[j].x, v[j].y) | ((unsigned long long)pk2(v[j].z, v[j].w) << 32);
}
__device__ __forceinline__ void row_load_bf16(const bf16* row, f32x4 (&v)[4], int lane) {
    const GAS unsigned long long* p = (const GAS unsigned long long*)row + lane;
#pragma unroll
    for (int j = 0; j < 4; ++j) { const unsigned long long w = p[64 * j]; const unsigned lo = (unsigned)w, hi = (unsigned)(w >> 32); v[j] = (f32x4){bflo(lo), bfhi(lo), bflo(hi), bfhi(hi)}; }
}

struct RowRaw { unsigned long long w[4]; };
struct LnGB { f32x4 g[4], b[4]; };
__device__ __forceinline__ void row_fetch(RowRaw& r, const bf16* row, int lane) { const GAS unsigned long long* p = (const GAS unsigned long long*)row + lane;
#pragma unroll
    for (int j = 0; j < 4; ++j) r.w[j] = p[64 * j]; }
__device__ __forceinline__ void row_unpack(const RowRaw& r, f32x4 (&v)[4]) {
#pragma unroll
    for (int j = 0; j < 4; ++j) { const unsigned lo = (unsigned)r.w[j], hi = (unsigned)(r.w[j] >> 32); v[j] = (f32x4){bflo(lo), bfhi(lo), bflo(hi), bfhi(hi)}; } }
__device__ __forceinline__ void ln_load_gb(LnGB& q, const float* g, const float* b, int lane) {
#pragma unroll
    for (int j = 0; j < 4; ++j) { q.g[j] = *(const f32x4*)(g + 4 * lane + 256 * j); q.b[j] = *(const f32x4*)(b + 4 * lane + 256 * j); } }
__device__ __forceinline__ void ln_norm_r(f32x4 (&v)[4], const LnGB& q) {
    float s = 0.f;
#pragma unroll
    for (int j = 0; j < 4; ++j) s += (v[j].x + v[j].y) + (v[j].z + v[j].w);
    const float mean = wave_sum(s) * (1.f / D); float s2 = 0.f;
#pragma unroll
    for (int j = 0; j < 4; ++j) { v[j] = v[j] - mean; s2 += (v[j].x * v[j].x + v[j].y * v[j].y) + (v[j].z * v[j].z + v[j].w * v[j].w); }
    const float rstd = 1.f / sqrtf(wave_sum(s2) * (1.f / D) + LN_EPS);
#pragma unroll
    for (int j = 0; j < 4; ++j) v[j] = v[j] * rstd * q.g[j] + q.b[j];
}

struct DynAttnOrder {
    gu32* ctr; volatile LAS unsigned* slot; int grp;
    __device__ __forceinline__ bool next(int, attn_body::AttnUnit& u) const {
        if (threadIdx.x == 0) slot[0] = __hip_atomic_fetch_add(ctr, 1u, RLX_AGENT);
        __syncthreads();
        const unsigned v = slot[0];
        __syncthreads();
        if (v >= 128u) return false;
        u.qb = 31 - (int)(v >> 2); u.bh = grp * 4 + (int)(v & 3u); return true;
    }
    __device__ __forceinline__ void a_ready(const attn_body::AttnUnit&) const {}
    __device__ __forceinline__ void done(const attn_body::AttnUnit&) const {}
};

constexpr int SC_TC = 32, SC_BUF = 45056;
typedef float f32x2 __attribute__((ext_vector_type(2)));
struct ScanRegs { float r[5], k[5], v[5], a[4], lw[4]; };
__device__ __forceinline__ void rwkv_scan_unit(const Frame& F, int su, const bf16* Rraw, const bf16* LAo, const float* LW, bf16* OA, bf16* BV,
                                               const float* mu_l, const float* kk_l, const float* ka_l, const float* rk_l) {
    const int bh = su >> 2, qq = su & 3, b = bh >> 3, h = bh & 7;
    const int tid = F.tid, lane = F.lane, w = F.wave;
    const float mu_r = mu_l[h * 64 + lane], mu_k = mu_l[512 + h * 64 + lane], mu_v = mu_l[1024 + h * 64 + lane];
    const float kkc = kk_l[h * 64 + lane], kac = ka_l[h * 64 + lane], rkc = rk_l[h * 64 + lane];
    const int hi = lane >> 5, riw = (lane >> 4) & 1, kidx = (lane & 15) + 16 * hi, row16 = 2 * w + riw;
    const size_t m0 = (size_t)b * T;
    const int hc = h * 64 + lane;
    f32x2 s = (f32x2){0.f, 0.f};
    ScanRegs g;
#define SC_LOAD(c) do { const int tb_ = (c) * SC_TC + 4 * w; const size_t mb_ = m0 + tb_; \
        _Pragma("unroll") for (int j = 0; j < 5; ++j) { const bool ok_ = !(j == 0 && tb_ == 0); const bf16* rp_ = Rraw + (mb_ + j - 1) * R_COLS + hc; \
            g.r[j] = ok_ ? bfu(rp_[0]) : 0.f; g.k[j] = ok_ ? bfu(rp_[512]) : 0.f; g.v[j] = ok_ ? bfu(rp_[1024]) : 0.f; } \
        _Pragma("unroll") for (int j = 0; j < 4; ++j) { g.a[j] = bfu(LAo[(mb_ + j) * RW + hc]); g.lw[j] = LW[(mb_ + j) * RW + hc]; } } while (0)
#define SC_PREP(c, bufp) do { LAS float* B_ = (LAS float*)(bufp); const size_t mb_ = m0 + (c) * SC_TC + 4 * w; \
        _Pragma("unroll") for (int j = 0; j < 4; ++j) { const int tt = 4 * w + j; \
            const float r_ = g.r[j + 1] + mu_r * (g.r[j] - g.r[j + 1]), k_ = g.k[j + 1] + mu_k * (g.k[j] - g.k[j + 1]), v_ = g.v[j + 1] + mu_v * (g.v[j] - g.v[j + 1]); \
            const float a_ = g.a[j], d_ = __expf(g.lw[j]); \
            const float kk0 = k_ * kkc; const float n2 = wave_sum(kk0 * kk0); const float kkn = kk0 * __builtin_amdgcn_rsqf(fmaxf(n2, 1e-24f)); \
            const float kmod = k_ * (1.f + (a_ - 1.f) * kac); const float bonus = wave_sum(r_ * kmod * rkc); \
            B_[tt * 64 + lane] = d_; B_[2048 + tt * 64 + lane] = -kkn; B_[4096 + tt * 64 + lane] = kkn * a_; B_[6144 + tt * 64 + lane] = kmod; B_[8192 + tt * 64 + lane] = r_; \
            if ((lane >> 4) == qq) { B_[10240 + tt * 16 + (lane & 15)] = v_; BV[(mb_ + j) * RW + hc] = (bf16)f2bf(bonus * v_); } } } while (0)
    LAS unsigned char* buf0 = F.lds + RING_OFF;
    SC_LOAD(0); SC_PREP(0, buf0);
    __syncthreads();
    for (int c = 0; c < T / SC_TC; ++c) {
        LAS unsigned char* bufc = buf0 + (c & 1) * SC_BUF; LAS unsigned char* bufn = buf0 + ((c + 1) & 1) * SC_BUF;
        if (c + 1 < T / SC_TC) SC_LOAD(c + 1);
        const LAS f32x2* Sd2 = (const LAS f32x2*)bufc; const LAS f32x2* Sa2 = Sd2 + 1024; const LAS f32x2* Sb2 = Sd2 + 2048; const LAS f32x2* Sk2 = Sd2 + 3072; const LAS f32x2* Sr2 = Sd2 + 4096;
        const LAS float* Sv = (const LAS float*)bufc + 10240; LAS float* Sy = (LAS float*)bufc + 10240 + 512;
#pragma unroll 4
        for (int tt = 0; tt < SC_TC; ++tt) {
            const f32x2 dv = Sd2[tt * 32 + kidx], av = Sa2[tt * 32 + kidx], bv = Sb2[tt * 32 + kidx], kv = Sk2[tt * 32 + kidx], rv = Sr2[tt * 32 + kidx]; const float vv = Sv[tt * 16 + row16];
            float p = s.x * av.x + s.y * av.y; p = red16(p); p = swap32_add(p);
            s.x = s.x * dv.x + (p * bv.x + vv * kv.x); s.y = s.y * dv.y + (p * bv.y + vv * kv.y);
            float y = s.x * rv.x + s.y * rv.y; y = red16(y); y = swap32_add(y);
            if ((lane & 47) == 0) Sy[tt * 16 + row16] = y;
        }
        __syncthreads();
        { const int tt = tid >> 4, rr = tid & 15; OA[(m0 + (size_t)c * SC_TC + tt) * RW + h * 64 + 16 * qq + rr] = (bf16)f2bf(Sy[tt * 16 + rr]); }
        if (c + 1 < T / SC_TC) SC_PREP(c + 1, bufn);
        __syncthreads();
    }
#undef SC_LOAD
#undef SC_PREP
}


typedef short s16x4 __attribute__((ext_vector_type(4)));
typedef float f32x16 __attribute__((ext_vector_type(16)));
constexpr int CK_P = 144, CK_MSZ = 64 * CK_P;
constexpr int CK_AT = 0, CK_RT = CK_MSZ, CK_BT = 2 * CK_MSZ, CK_KT = 3 * CK_MSZ, CK_BTT = 4 * CK_MSZ, CK_KTT = 5 * CK_MSZ, CK_VTT = 6 * CK_MSZ,
              CK_AAB = 7 * CK_MSZ, CK_AAK = 8 * CK_MSZ, CK_ARB = 9 * CK_MSZ, CK_ARK = 10 * CK_MSZ, CK_DIAG = 11 * CK_MSZ, CK_TBB = CK_DIAG + 4096, CK_GL = CK_TBB + 2048, CK_CLW = CK_GL + 256,
              CK_WT = CK_BT, CK_ULT = CK_KT, CK_END = CK_CLW + 2048,
              CK_OPM = CK_AT, CK_ORH = CK_AAB, CK_OYL = CK_AAK, CK_OQM = CK_END;
static_assert(CK_END + 8192 <= RING_BYTES, "chunk LDS map");
constexpr int CK_DUMMY_ = 0;
static_assert(CK_END <= RING_BYTES, "chunk LDS map");
__device__ __forceinline__ pg8::bf16x8 ck_frag(LAS unsigned char* base, int row0, int ks, int lane) {
    return *(const LAS pg8::bf16x8*)(base + (row0 + (lane & 15)) * CK_P + (32 * ks + 8 * (lane >> 4)) * 2); }
__device__ __forceinline__ void lds_st16(LAS unsigned char* p, float v) { *(LAS unsigned short*)p = (unsigned short)f2bf(v); }
__device__ __forceinline__ float lds_ld16(const LAS unsigned char* p) { return bfu(*(const LAS unsigned short*)p); }
__device__ __forceinline__ s16x4 pack4(const f32x4 v) { const unsigned lo = pk2(v[0], v[1]), hi = pk2(v[2], v[3]); s16x4 r; r[0] = (short)(lo & 0xffffu); r[1] = (short)(lo >> 16); r[2] = (short)(hi & 0xffffu); r[3] = (short)(hi >> 16); return r; }
__device__ __forceinline__ int ck_perm(int kp) { const int xt = kp >> 5, w5 = kp & 31, s_ = w5 >> 4, w4 = w5 & 15; return 32 * xt + 16 * s_ + 8 * ((w4 >> 2) & 1) + 4 * (w4 >> 3) + (w4 & 3); }

#define CKDUP(bit) for (int rp_ = 0; rp_ < ((((PROBE_DUP) >> (bit)) & 1) ? 2 : 1); ++rp_)
struct CkRaw { unsigned r[9], k[9], v[9], a[8]; float lw[8]; float prm[6]; };
__device__ __forceinline__ void ck_load(CkRaw& g, int task, int w, int lane, const bf16* Rraw, const bf16* LAo, const float* LWp, const float* mu_l, const float* kk_l, const float* ka_l, const float* rk_l) {
    const int bh = task >> 7, c = task & 127, b = bh >> 3, h = bh & 7; const int hc = h * 64 + lane; const size_t mb = (size_t)b * T + (size_t)c * 64 + 8 * w;
#pragma unroll
    for (int j = 0; j < 9; ++j) { const bool ok = !(j == 0 && c == 0 && w == 0); const bf16* rp = Rraw + (mb + j - 1) * R_COLS + hc;
        g.r[j] = ok ? (unsigned)rp[0] : 0u; g.k[j] = ok ? (unsigned)rp[512] : 0u; g.v[j] = ok ? (unsigned)rp[1024] : 0u; }
#pragma unroll
    for (int j = 0; j < 8; ++j) { g.a[j] = (unsigned)LAo[(mb + j) * RW + hc]; g.lw[j] = LWp[(mb + j) * RW + hc]; }
    g.prm[0] = mu_l[hc]; g.prm[1] = mu_l[512 + hc]; g.prm[2] = mu_l[1024 + hc]; g.prm[3] = kk_l[hc]; g.prm[4] = ka_l[hc]; g.prm[5] = rk_l[hc];
}
__device__ __forceinline__ float bfw(unsigned u) { return __builtin_bit_cast(float, u << 16); }
#define CK_BAR() do { asm volatile("s_waitcnt lgkmcnt(0)" ::: "memory"); __builtin_amdgcn_s_barrier(); asm volatile("" ::: "memory"); } while (0)
__device__ __forceinline__ void rwkv_chunk_local(const Frame& F, int task, int next_task, CkRaw& raw, const bf16* Rraw, const bf16* LAo, const float* LWp, bf16* OAo, bf16* BVo, bf16* PMo, bf16* QMo, bf16* RHo,
                                                 const float* mu_l, const float* kk_l, const float* ka_l, const float* rk_l) {
    const int bh = task >> 7, c = task & 127, b = bh >> 3, h = bh & 7;
    const int lane = F.lane, w = F.wave, q = lane >> 4, c15 = lane & 15;
    LAS unsigned char* L = F.lds + RING_OFF;
    const size_t m0 = (size_t)b * T + (size_t)c * 64;
    const int hc = h * 64 + lane;
    {
        const float mu_r = raw.prm[0], mu_k = raw.prm[1], mu_v = raw.prm[2], kkc = raw.prm[3], kac = raw.prm[4], rkc = raw.prm[5];
        float rr[9], kr[9], vr[9], aa[8], lw[8];
        const size_t mb = m0 + 8 * w;
#pragma unroll
        for (int j = 0; j < 9; ++j) { rr[j] = bfw(raw.r[j]); kr[j] = bfw(raw.k[j]); vr[j] = bfw(raw.v[j]); }
#pragma unroll
        for (int j = 0; j < 8; ++j) { aa[j] = bfw(raw.a[j]); lw[j] = raw.lw[j]; }
        if (next_task >= 0) ck_load(raw, next_task, w, lane, Rraw, LAo, LWp, mu_l, kk_l, ka_l, rk_l);
        float cl[8]; float run = 0.f;
#pragma unroll
        for (int j = 0; j < 8; ++j) { run += lw[j]; cl[j] = run; }
        LAS float* clw = (LAS float*)(L + CK_CLW);
        clw[w * 64 + lane] = run;
        CK_BAR();
        float off = 0.f, tot = 0.f;
#pragma unroll
        for (int ww = 0; ww < 8; ++ww) { const float x = clw[ww * 64 + lane]; tot += x; if (ww < w) off += x; }
        if (w == 0) ((LAS float*)(L + CK_GL))[lane] = __expf(tot);
        float vprev = 0.f, btp = 0.f, ktp = 0.f;
        { const float mu_r2 = mu_r, off2 = off;
#pragma unroll
        for (int j = 0; j < 8; ++j) { const int i = 8 * w + j;
            const float r_ = rr[j + 1] + mu_r2 * (rr[j] - rr[j + 1]), k_ = kr[j + 1] + mu_k * (kr[j] - kr[j + 1]), v_ = vr[j + 1] + mu_v * (vr[j] - vr[j + 1]);
            const float a_ = aa[j];
            const float kk0 = k_ * kkc; const float n2 = wave_sum(kk0 * kk0); const float kkn = kk0 * __builtin_amdgcn_rsqf(fmaxf(n2, 1e-24f));
            const float kmod = k_ * (1.f + (a_ - 1.f) * kac); const float bonus = wave_sum(r_ * kmod * rkc);
            const float cc = off2 + cl[j]; const float g = __expf(cc), gm1 = __expf(cc - lw[j]), gi = __expf(-cc);
            const float At = -kkn * gm1, Rt = r_ * g, Bt = kkn * a_ * gi, Kt = kmod * gi;
            lds_st16(L + CK_AT + i * CK_P + lane * 2, At); lds_st16(L + CK_RT + i * CK_P + lane * 2, Rt); lds_st16(L + CK_BT + i * CK_P + lane * 2, Bt); lds_st16(L + CK_KT + i * CK_P + lane * 2, Kt);
            if (j & 1) {
                *(LAS unsigned*)(L + CK_BTT + lane * CK_P + (i - 1) * 2) = pk2(btp, Bt); *(LAS unsigned*)(L + CK_KTT + lane * CK_P + (i - 1) * 2) = pk2(ktp, Kt); *(LAS unsigned*)(L + CK_VTT + lane * CK_P + (i - 1) * 2) = pk2(vprev, v_);
            } else { btp = Bt; ktp = Kt; vprev = v_; }
            BVo[(mb + j) * RW + hc] = (bf16)f2bf(bonus * v_);
        } }
    }
    CK_BAR();
    if (w == 0) {
#pragma unroll
        for (int d = 0; d < 4; ++d) { f32x4 acc = (f32x4){0.f, 0.f, 0.f, 0.f};
#pragma unroll
            for (int ks = 0; ks < 2; ++ks) acc = __builtin_amdgcn_mfma_f32_16x16x32_bf16(ck_frag(L + CK_AT, 16 * d, ks, lane), ck_frag(L + CK_BT, 16 * d, ks, lane), acc, 0, 0, 0);
#pragma unroll
            for (int r = 0; r < 4; ++r) { const int i = 16 * d + 4 * q + r, jcol = 16 * d + c15; const float val = (jcol < i) ? acc[r] : 0.f;
                lds_st16(L + CK_AAB + i * CK_P + jcol * 2, val); ((LAS float*)(L + CK_DIAG))[(d * 16 + 4 * q + r) * 16 + c15] = val; } }
        asm volatile("s_waitcnt lgkmcnt(0)" ::: "memory");
        const LAS float* Dg = (const LAS float*)(L + CK_DIAG) + q * 256; float t[16];
#pragma unroll
        for (int i = 0; i < 16; ++i) { float a0 = (i == c15) ? 1.f : 0.f, a1 = 0.f, a2 = 0.f, a3 = 0.f;
#pragma unroll
            for (int j = 0; j < i; ++j) { const float pr = Dg[i * 16 + j] * t[j]; if ((j & 3) == 0) a0 += pr; else if ((j & 3) == 1) a1 += pr; else if ((j & 3) == 2) a2 += pr; else a3 += pr; }
            t[i] = (a0 + a1) + (a2 + a3); }
#pragma unroll
        for (int i = 0; i < 16; ++i) lds_st16(L + CK_TBB + ((q * 16 + i) * 16 + c15) * 2, t[i]);
    } else {
        for (int idx = w - 1; idx < 36; idx += 7) {
            int p, ti, tj;
            if (idx < 6) { p = 0; ti = (idx >= 3) ? 3 : ((idx >= 1) ? 2 : 1); tj = idx - (ti * (ti - 1)) / 2; }
            else { const int r_ = idx - 6; p = 1 + r_ / 10; const int n = r_ % 10; ti = (n >= 6) ? 3 : ((n >= 3) ? 2 : ((n >= 1) ? 1 : 0)); tj = n - (ti * (ti + 1)) / 2; }
            LAS unsigned char* Ab = L + (p >> 1) * CK_MSZ; LAS unsigned char* Bb = L + (2 + (p & 1)) * CK_MSZ; LAS unsigned char* Ob = L + (7 + p) * CK_MSZ;
            f32x4 acc = (f32x4){0.f, 0.f, 0.f, 0.f};
#pragma unroll
            for (int ks = 0; ks < 2; ++ks) acc = __builtin_amdgcn_mfma_f32_16x16x32_bf16(ck_frag(Ab, 16 * ti, ks, lane), ck_frag(Bb, 16 * tj, ks, lane), acc, 0, 0, 0);
            const int jcol = 16 * tj + c15;
#pragma unroll
            for (int r = 0; r < 4; ++r) { const int i = 16 * ti + 4 * q + r; const bool keep = (p < 2) ? (jcol < i) : (jcol <= i); const float val = keep ? acc[r] : 0.f;
                lds_st16(Ob + i * CK_P + jcol * 2, val);
                if (ti != tj) lds_st16(Ob + (16 * tj + 4 * q + r) * CK_P + (16 * ti + c15) * 2, 0.f); }
        }
    }
    CK_BAR();
    {
        f32x4 z[4];
        const int ntile = w & 3;
        if (w < 4) {
#pragma unroll
            for (int bb = 0; bb < 4; ++bb)
#pragma unroll
                for (int r = 0; r < 4; ++r) z[bb][r] = lds_ld16(L + CK_AT + (16 * bb + 4 * q + r) * CK_P + (16 * ntile + c15) * 2);
        } else {
#pragma unroll
            for (int bb = 0; bb < 4; ++bb) { f32x4 acc = (f32x4){0.f, 0.f, 0.f, 0.f};
#pragma unroll
                for (int ks = 0; ks < 2; ++ks) acc = __builtin_amdgcn_mfma_f32_16x16x32_bf16(ck_frag(L + CK_AAK, 16 * bb, ks, lane), ck_frag(L + CK_VTT, 16 * ntile, ks, lane), acc, 0, 0, 0);
                z[bb] = acc; }
        }
        s16x4 xb[4];
        LAS unsigned char* dst = L + ((w < 4) ? CK_WT : CK_ULT);
#pragma unroll
        for (int bb = 0; bb < 4; ++bb) { f32x4 zz = z[bb];
#pragma unroll
            for (int b2 = 0; b2 < bb; ++b2) { const s16x4 a4 = *(const LAS s16x4*)(L + CK_AAB + (16 * bb + c15) * CK_P + (16 * b2 + 4 * q) * 2); zz = __builtin_amdgcn_mfma_f32_16x16x16bf16_1k(a4, xb[b2], zz, 0, 0, 0); }
            const s16x4 zb = pack4(zz); const s16x4 t4 = *(const LAS s16x4*)(L + CK_TBB + ((bb * 16 + c15) * 16 + 4 * q) * 2);
            const f32x4 x = __builtin_amdgcn_mfma_f32_16x16x16bf16_1k(t4, zb, (f32x4){0.f, 0.f, 0.f, 0.f}, 0, 0, 0);
            xb[bb] = pack4(x);
            *(LAS s16x4*)(dst + (16 * ntile + c15) * CK_P + (16 * bb + 4 * q) * 2) = xb[bb]; }
    }
    CK_BAR();
    bf16* pmo = PMo + (size_t)task * 4096; bf16* qmo = QMo + (size_t)task * 4096; bf16* rho = RHo + (size_t)task * 4096;
    {
        const int ti = w >> 1; const LAS float* GLp = (const LAS float*)(L + CK_GL);
#pragma unroll
        for (int tt = 0; tt < 2; ++tt) { const int tj = 2 * (w & 1) + tt; const int col = 16 * tj + c15, row0 = 16 * ti + 4 * q;
            f32x4 aP = (f32x4){0.f, 0.f, 0.f, 0.f}, aQ = aP, aR = aP, aY = aP;
#pragma unroll
            for (int ks = 0; ks < 2; ++ks) {
                const pg8::bf16x8 fWr = ck_frag(L + CK_WT, 16 * ti, ks, lane), fBc = ck_frag(L + CK_BTT, 16 * tj, ks, lane);
                const pg8::bf16x8 fBr = ck_frag(L + CK_BTT, 16 * ti, ks, lane), fKr = ck_frag(L + CK_KTT, 16 * ti, ks, lane), fUc = ck_frag(L + CK_ULT, 16 * tj, ks, lane), fVc = ck_frag(L + CK_VTT, 16 * tj, ks, lane);
                const pg8::bf16x8 fRbc = ck_frag(L + CK_ARB, 16 * tj, ks, lane), fRkc = ck_frag(L + CK_ARK, 16 * tj, ks, lane);
                const pg8::bf16x8 fUr = ck_frag(L + CK_ULT, 16 * ti, ks, lane), fVr = ck_frag(L + CK_VTT, 16 * ti, ks, lane);
                aP = __builtin_amdgcn_mfma_f32_16x16x32_bf16(fWr, fBc, aP, 0, 0, 0);
                aQ = __builtin_amdgcn_mfma_f32_16x16x32_bf16(fBr, fUc, aQ, 0, 0, 0); aQ = __builtin_amdgcn_mfma_f32_16x16x32_bf16(fKr, fVc, aQ, 0, 0, 0);
                aR = __builtin_amdgcn_mfma_f32_16x16x32_bf16(fWr, fRbc, aR, 0, 0, 0);
                aY = __builtin_amdgcn_mfma_f32_16x16x32_bf16(fUr, fRbc, aY, 0, 0, 0); aY = __builtin_amdgcn_mfma_f32_16x16x32_bf16(fVr, fRkc, aY, 0, 0, 0);
            }
            { const float gl = GLp[col]; pg8::u32x2 o; o.x = pk2(gl * (aP[0] + ((row0 == col) ? 1.f : 0.f)), gl * (aP[1] + ((row0 + 1 == col) ? 1.f : 0.f)));
              o.y = pk2(gl * (aP[2] + ((row0 + 2 == col) ? 1.f : 0.f)), gl * (aP[3] + ((row0 + 3 == col) ? 1.f : 0.f))); *(pg8::u32x2*)(pmo + col * 64 + ck_perm(row0)) = o; }
            { const f32x4 gl4 = *(const LAS f32x4*)(GLp + row0); const int vt = col >> 5, cq = col & 31, kt = row0 >> 5, k5 = row0 & 31, hh = (k5 >> 2) & 1, rg = 4 * (k5 >> 3);
              pg8::u32x2 o; o.x = pk2(gl4[0] * aQ[0], gl4[1] * aQ[1]); o.y = pk2(gl4[2] * aQ[2], gl4[3] * aQ[3]); *(pg8::u32x2*)(qmo + ((vt * 2 + kt) * 64 + 32 * hh + cq) * 16 + rg) = o; }
            { pg8::u32x2 rt = *(const LAS pg8::u32x2*)(L + CK_RT + col * CK_P + row0 * 2); pg8::u32x2 o; o.x = pk2(aR[0] + bflo(rt.x), aR[1] + bfhi(rt.x)); o.y = pk2(aR[2] + bflo(rt.y), aR[3] + bfhi(rt.y)); *(pg8::u32x2*)(rho + col * 64 + row0) = o; }
            { pg8::u32x2 o; o.x = pk2(aY[0], aY[1]); o.y = pk2(aY[2], aY[3]); *(pg8::u32x2*)(OAo + (m0 + col) * RW + h * 64 + row0) = o; }
        }
    }
    CK_BAR();
}

__device__ __forceinline__ void rwkv_carry(const Frame& F, int bh, const bf16* PMi, const bf16* QMio, bf16* SCo) {
    const int w = F.wave, lane = F.lane, r31 = lane & 31, hh = lane >> 5, vt = w & 1;
    LAS unsigned char* ring = F.lds + RING_OFF; const unsigned ringb = (unsigned)(uintptr_t)ring;
    const char* pm = (const char*)(PMi + (size_t)bh * 128 * 4096); const char* qm = (const char*)(QMio + (size_t)bh * 128 * 4096); bf16* sco = SCo + (size_t)bh * 128 * 4096;
    constexpr int R = 6, SLOT = 16384;
    const int lw4 = (w - 2) * 4;
    unsigned voffp[4];
#pragma unroll
    for (int i = 0; i < 4; ++i) { const int p = lw4 + i; voffp[i] = (p < 8) ? (unsigned)((8 * p + (lane >> 3)) * 128 + (((lane & 7) ^ ((lane >> 3) & 7)) * 16)) : (unsigned)((p - 8) * 1024 + lane * 16); }
#define CY_ISSUE(cc) do { const int sl_ = (cc) % R; _Pragma("unroll") for (int i = 0; i < 4; ++i) { const int p = lw4 + i; \
        pg8::glds16s(((p < 8) ? pm : qm) + (size_t)(cc) * 8192, voffp[i], (unsigned)__builtin_amdgcn_readfirstlane((int)(ringb + sl_ * SLOT + p * 1024))); } } while (0)
    f32x16 S0, S1;
#pragma unroll
    for (int i = 0; i < 16; ++i) { S0[i] = 0.f; S1[i] = 0.f; }
    if (w >= 2 && w < 6) {
#pragma unroll
        for (int cc = 0; cc < R - 1; ++cc) CY_ISSUE(cc);
        asm volatile("s_waitcnt vmcnt(16)" ::: "memory");
    }
    __builtin_amdgcn_s_barrier();
    for (int c = 0; c < 128; ++c) {
        if (w >= 2 && w < 6) {
            if (c + R - 1 < 128) { CY_ISSUE(c + R - 1); asm volatile("s_waitcnt vmcnt(16)" ::: "memory"); }
            else asm volatile("s_waitcnt vmcnt(0)" ::: "memory");
        } else if (w < 2) {
            const LAS unsigned char* slot = ring + (c % R) * SLOT;
            pg8::bf16x8 pa[2][4]; pg8::u32x4 qa[2][2];
#pragma unroll
            for (int kt = 0; kt < 2; ++kt) { const int row = 32 * kt + r31;
#pragma unroll
                for (int s4 = 0; s4 < 4; ++s4) pa[kt][s4] = *(const LAS pg8::bf16x8*)(slot + row * 128 + (((2 * s4 + hh) ^ (row & 7)) * 16));
                const LAS pg8::u32x4* qp = (const LAS pg8::u32x4*)(slot + 8192 + ((vt * 2 + kt) * 64 + lane) * 32); qa[kt][0] = qp[0]; qa[kt][1] = qp[1]; }
            pg8::bf16x8 bx[4];
#pragma unroll
            for (int s = 0; s < 2; ++s) { pg8::u32x4 t0, t1;
                t0.x = pg8::cvt_pk_bf16(S0[8 * s + 0], S0[8 * s + 1]); t0.y = pg8::cvt_pk_bf16(S0[8 * s + 2], S0[8 * s + 3]); t0.z = pg8::cvt_pk_bf16(S0[8 * s + 4], S0[8 * s + 5]); t0.w = pg8::cvt_pk_bf16(S0[8 * s + 6], S0[8 * s + 7]);
                t1.x = pg8::cvt_pk_bf16(S1[8 * s + 0], S1[8 * s + 1]); t1.y = pg8::cvt_pk_bf16(S1[8 * s + 2], S1[8 * s + 3]); t1.z = pg8::cvt_pk_bf16(S1[8 * s + 4], S1[8 * s + 5]); t1.w = pg8::cvt_pk_bf16(S1[8 * s + 6], S1[8 * s + 7]);
                bx[s] = __builtin_bit_cast(pg8::bf16x8, t0); bx[2 + s] = __builtin_bit_cast(pg8::bf16x8, t1); }
            { bf16* sc = sco + (size_t)c * 4096 + (32 * vt + r31) * 64;
#pragma unroll
              for (int g4 = 0; g4 < 4; ++g4) { const pg8::u32x4 t0 = __builtin_bit_cast(pg8::u32x4, bx[g4 >> 1]), t1 = __builtin_bit_cast(pg8::u32x4, bx[2 + (g4 >> 1)]);
                  pg8::u32x2 o0, o1; if (g4 & 1) { o0.x = t0.z; o0.y = t0.w; o1.x = t1.z; o1.y = t1.w; } else { o0.x = t0.x; o0.y = t0.y; o1.x = t1.x; o1.y = t1.y; }
                  *(pg8::u32x2*)(sc + 8 * g4 + 4 * hh) = o0; *(pg8::u32x2*)(sc + 32 + 8 * g4 + 4 * hh) = o1; } }
            f32x16 N0, N1;
#pragma unroll
            for (int kt = 0; kt < 2; ++kt) { f32x16 n;
#pragma unroll
                for (int i = 0; i < 2; ++i) { const pg8::u32x4 wq = qa[kt][i]; n[8 * i + 0] = bflo(wq.x); n[8 * i + 1] = bfhi(wq.x); n[8 * i + 2] = bflo(wq.y); n[8 * i + 3] = bfhi(wq.y); n[8 * i + 4] = bflo(wq.z); n[8 * i + 5] = bfhi(wq.z); n[8 * i + 6] = bflo(wq.w); n[8 * i + 7] = bfhi(wq.w); }
#pragma unroll
                for (int s4 = 0; s4 < 4; ++s4) n = __builtin_amdgcn_mfma_f32_32x32x16_bf16(pa[kt][s4], bx[s4], n, 0, 0, 0);
                if (kt == 0) N0 = n; else N1 = n; }
            S0 = N0; S1 = N1;
        }
        asm volatile("s_waitcnt lgkmcnt(0)" ::: "memory");
        __builtin_amdgcn_s_barrier();
    }
#undef CY_ISSUE
    asm volatile("s_waitcnt vmcnt(0)" ::: "memory");
    __syncthreads();
}

struct FxRaw { pg8::bf16x8 bR[2], aS[2][4]; pg8::u32x2 yw[4], bw[4], gw[4]; };
__device__ __forceinline__ void fx_load(FxRaw& g, int pair, int w, int lane, const bf16* RHi, const bf16* SCi, const bf16* OAi, const bf16* BVi, const bf16* LGi) {
    const int q = lane >> 4, c15 = lane & 15, ti = w & 3; const int chunk = 2 * pair + (w >> 2), bh = chunk >> 7, c = chunk & 127, b = bh >> 3, h = bh & 7;
    const bf16* rh = RHi + (size_t)chunk * 4096; const bf16* sc = SCi + (size_t)chunk * 4096;
    const size_t base = ((size_t)b * T + (size_t)c * 64 + 16 * ti + c15) * RW + h * 64 + 4 * q;
#pragma unroll
    for (int ks = 0; ks < 2; ++ks) { g.bR[ks] = *(const pg8::bf16x8*)(rh + (16 * ti + c15) * 64 + 32 * ks + 8 * q);
#pragma unroll
        for (int tv = 0; tv < 4; ++tv) g.aS[ks][tv] = *(const pg8::bf16x8*)(sc + (16 * tv + c15) * 64 + 32 * ks + 8 * q); }
#pragma unroll
    for (int tv = 0; tv < 4; ++tv) { g.yw[tv] = *(const pg8::u32x2*)(OAi + base + 16 * tv); g.bw[tv] = *(const pg8::u32x2*)(BVi + base + 16 * tv); g.gw[tv] = *(const pg8::u32x2*)(LGi + base + 16 * tv); }
}
__device__ __forceinline__ void rwkv_fixup(const Frame& F, int pair, const FxRaw& g, bf16* OAo, const float* lnx_g, const float* lnx_b) {
    const int lane = F.lane, w = F.wave, q = lane >> 4, c15 = lane & 15, ti = w & 3;
    const int chunk = 2 * pair + (w >> 2), bh = chunk >> 7, c = chunk & 127, b = bh >> 3, h = bh & 7;
    const size_t base = ((size_t)b * T + (size_t)c * 64 + 16 * ti + c15) * RW + h * 64 + 4 * q;
    f32x4 acc[4];
#pragma unroll
    for (int tv = 0; tv < 4; ++tv) acc[tv] = (f32x4){0.f, 0.f, 0.f, 0.f};
#pragma unroll
    for (int ks = 0; ks < 2; ++ks)
#pragma unroll
        for (int tv = 0; tv < 4; ++tv) acc[tv] = __builtin_amdgcn_mfma_f32_16x16x32_bf16(g.aS[ks][tv], g.bR[ks], acc[tv], 0, 0, 0);
    float s = 0.f;
#pragma unroll
    for (int tv = 0; tv < 4; ++tv) { const pg8::u32x2 yw = g.yw[tv]; acc[tv][0] += bflo(yw.x); acc[tv][1] += bfhi(yw.x); acc[tv][2] += bflo(yw.y); acc[tv][3] += bfhi(yw.y);
        s += (acc[tv][0] + acc[tv][1]) + (acc[tv][2] + acc[tv][3]); }
    s += __shfl_xor(s, 16); s = swap32_add(s); const float mean = s * (1.f / 64.f); float qv = 0.f;
#pragma unroll
    for (int tv = 0; tv < 4; ++tv) { acc[tv] = acc[tv] - mean; qv += (acc[tv][0] * acc[tv][0] + acc[tv][1] * acc[tv][1]) + (acc[tv][2] * acc[tv][2] + acc[tv][3] * acc[tv][3]); }
    qv += __shfl_xor(qv, 16); qv = swap32_add(qv); const float rstd = __builtin_amdgcn_rsqf(qv * (1.f / 64.f) + RWKV_LN_EPS);
#pragma unroll
    for (int tv = 0; tv < 4; ++tv) { const f32x4 lg = *(const f32x4*)(lnx_g + h * 64 + 16 * tv + 4 * q), lb = *(const f32x4*)(lnx_b + h * 64 + 16 * tv + 4 * q);
        const pg8::u32x2 bw = g.bw[tv], gw = g.gw[tv];
        const f32x4 bv = (f32x4){bflo(bw.x), bfhi(bw.x), bflo(bw.y), bfhi(bw.y)}, gv = (f32x4){bflo(gw.x), bfhi(gw.x), bflo(gw.y), bfhi(gw.y)};
        const f32x4 o = (acc[tv] * rstd * lg + lb + bv) * gv;
        pg8::u32x2 ow; ow.x = pk2(o[0], o[1]); ow.y = pk2(o[2], o[3]); *(pg8::u32x2*)(OAo + base + 16 * tv) = ow; }
}

__global__ void __launch_bounds__(NWAVES * 64, 2) mk_fwd(Args args) {
    extern __shared__ __attribute__((aligned(16))) unsigned char lds[];
    {
        const int t0_ = threadIdx.x;
        for (int u = t0_; u < (LDS_BYTES - LDSCTL_OFF) / 4; u += NWAVES * 64) ((LAS unsigned*)((LAS unsigned char*)lds + LDSCTL_OFF))[u] = 0u;
        __syncthreads();
    }
    const int wave_k_ = __builtin_amdgcn_readfirstlane((int)threadIdx.x >> 6);
    XcdBarrier bar = xcd_barrier_post((unsigned*)((gu32*)(args.ws + WS_CTL) + CW_BAR), (volatile LAS unsigned*)((LAS unsigned char*)lds + MISC_OFF) + 8);
#define GRID_BAR1() do { XcdBarrier b2_ = bar; asm volatile("" : "+s"(b2_.bar), "+s"(b2_.x)); xcd_barrier(b2_); } while (0)
#if (PROBE_DUP >> 8) & 1
#define GRID_BAR() do { GRID_BAR1(); GRID_BAR1(); } while (0)
#else
#define GRID_BAR() GRID_BAR1()
#endif
#ifndef PROBE_DUP
#define PROBE_DUP 0
#endif
#define DUP(bit) for (int dup_ = 0; dup_ < ((((PROBE_DUP) >> (bit)) & 1) ? 2 : 1); ++dup_)
#define PH_BEGIN GAS unsigned char* ws = (GAS unsigned char*)args.ws; GAS float* outp = (GAS float*)args.out; int wv_o_ = wave_k_, bx = blockIdx.x; asm volatile("" : "+s"(ws), "+s"(outp), "+s"(wv_o_), "+s"(bx)); \
    int tid_o_; asm volatile("v_mbcnt_lo_u32_b32 %0, -1, 0\n\tv_mbcnt_hi_u32_b32 %0, -1, %0" : "=v"(tid_o_)); tid_o_ += wv_o_ * 64; \
    gu32* ctl = (gu32*)(ws + WS_CTL); (void)ctl; Frame F; F.lds = (LAS unsigned char*)lds; F.MISC = (volatile LAS unsigned*)(F.lds + MISC_OFF); F.ctl = ctl; \
    F.tid = tid_o_; F.lane = F.tid & 63; F.wave = __builtin_amdgcn_readfirstlane(F.tid >> 6); F.G = NG; F.vcu = (bx % 8) * (NG / 8) + bx / 8; \
    const int lane = F.lane, gw = F.vcu * NWAVES + F.wave; (void)lane; (void)gw
#define GIN(k) ((const float*)(const GAS float*)args.in[k])
#define FL ((float*)(ws + WS_FL))
#define CB ((float*)(ws + WS_CB))
#define TOKE ((unsigned*)(ws + WS_TOKE))
#define TOKG ((float*)(ws + WS_TOKG))
#define PPOS ((unsigned*)(ws + WS_PPOS))
#define RTOK ((int*)(ws + WS_RTOK))
#define WL ((bf16*)(ws + WS_WL))
#define X ((bf16*)(ws + WS_X))
#define WIN ((bf16*)(ws + WS_WIN))
#define WUP ((bf16*)(ws + WS_WUP))
#define WOUT ((bf16*)(ws + WS_WOUT))
#define W13 ((bf16*)(ws + WS_W13))
#define W2 ((bf16*)(ws + WS_W2))
#define Cb ((bf16*)(ws + WS_C))
#define FQ ((bf16*)(ws + WS_FQ))
#define FK ((bf16*)(ws + WS_FK))
#define FV ((bf16*)(ws + WS_FV))
#define LA ((bf16*)(ws + WS_LA))
#define LW ((float*)(ws + WS_LW))
#define LAO ((bf16*)(ws + WS_LAO))
#define LG ((bf16*)(ws + WS_LG))
#define OB ((bf16*)(ws + WS_OB))
#define OA ((bf16*)(ws + WS_OA))
#define BV ((bf16*)(ws + WS_BV))
#define G2 ((bf16*)(ws + WS_G2))
#define PMB ((bf16*)(ws + WS_PM))
#define QMB ((bf16*)(ws + WS_QM))
#define RHB ((bf16*)(ws + WS_RH))
#define MG ((bf16*)(ws + WS_MG))
#define H ((bf16*)(ws + WS_H))
#define WM13 ((bf16*)(ws + WS_WM13))
#define WM2 ((bf16*)(ws + WS_WM2))
#define HM ((bf16*)(ws + WS_HM))
#define YP ((bf16*)(ws + WS_YP))
#define YPS ((bf16*)(ws + WS_YPS))
#define Rr ((bf16*)outp)
#define G0 ((bf16*)outp)
#define G1 ((bf16*)outp + (size_t)M * D)
#define Y ((bf16*)outp)

    {
        PH_BEGIN;
        LAS float* scr = (LAS float*)(F.lds + RING_OFF + F.wave * 16384);
        constexpr int I_IN = (INP_N / 32) * 16, I_UP = 32 * 8, I_OUT = 32 * 16, I_13 = (2 * DFF / 32) * 16, I_2 = 32 * (DFF / 64), I_L = 48 * 4;
        constexpr int NITEMS = 2 * I_IN + 6 * I_UP + 2 * I_OUT + I_13 + I_2 + 2 * I_L;
        DUP(2) for (int it = gw; it < NITEMS; it += NGW) {
            int r = it;
            if (r < 2 * I_IN) { const int l = r / I_IN; r -= l * I_IN; const int rg = r >> 4, kb = r & 15, d0 = 32 * rg; int n0 = d0, nv = 32;
                if (d0 >= INA_N) n0 = d0 - 248; else if (d0 > 4864) nv = 0; else if (d0 == 4864) nv = 8;
                const float sc = (d0 >= 3328 && d0 < 3840) ? attn_body::C2 : 1.f;
                tr_item(GIN(3) + (size_t)l * D * IN_COLS, IN_COLS, 64 * kb, n0, nv, WIN + ((size_t)l * INP_N + d0) * D, D, 64 * kb, sc, scr, lane); continue; }
            r -= 2 * I_IN;
            if (r < 6 * I_UP) { const int q = r / I_UP; r -= q * I_UP; const int l = q / 3, br = q % 3; const int rg = r >> 3, kb = r & 7;
                const float* W = args.in[18 + br] + (size_t)l * RW * D;
                tr_item(W, D, 64 * kb, 32 * rg, 32, WUP + ((size_t)l * D + 32 * rg) * (3 * RW), 3 * RW, br * RW + 64 * kb, 1.f, scr, lane); continue; }
            r -= 6 * I_UP;
            if (r < 2 * I_OUT) { const int l = r / I_OUT; r -= l * I_OUT; const int rg = r >> 4, kb = r & 15;
                tr_item(GIN(21) + (size_t)l * D * D, D, 64 * kb, 32 * rg, 32, WOUT + ((size_t)l * D + 32 * rg) * D, D, 64 * kb, 1.f, scr, lane); continue; }
            r -= 2 * I_OUT;
            if (r < I_13) { const int rg = r >> 4, kb = r & 15, d0 = 32 * rg, tile = d0 >> 8, within = d0 & 255;
                const float* W = (within < 128) ? GIN(26) : GIN(27);
                tr_item(W, DFF, 64 * kb, tile * 128 + (within & 127), 32, W13 + (size_t)d0 * D, D, 64 * kb, 1.f, scr, lane); continue; }
            r -= I_13;
            if (r < I_2) { const int rg = r / (DFF / 64), kb = r % (DFF / 64);
                tr_item(GIN(28), D, 64 * kb, 32 * rg, 32, W2 + (size_t)(32 * rg) * DFF, DFF, 64 * kb, 1.f, scr, lane); continue; }
            r -= I_2;
            { const int l = r / I_L; r -= l * I_L; const int rg = r >> 2, kb = r & 3; const float* W = nullptr; int ldw = RW, sk0 = 0, n0 = 0, nv = 0;
                if (rg < 16) { if (kb == 0) { W = GIN(6) + (size_t)l * 64 * RW; n0 = 32 * rg; nv = 32; } }
                else if (rg < 32) { if (kb == 1) { W = GIN(8) + (size_t)l * 64 * RW; n0 = 32 * (rg - 16); nv = 32; } }
                else { if (kb >= 2) { W = GIN(9) + (size_t)l * 128 * RW; sk0 = 64 * (kb - 2); n0 = 32 * (rg - 32); nv = 32; } }
                tr_item(W, ldw, sk0, n0, nv, WL + ((size_t)l * 1536 + 32 * rg) * 256, 256, 64 * kb, 1.f, scr, lane); }
        }
        { LnGB q; ln_load_gb(q, GIN(1), GIN(2), lane); f32x4 nx[4];
            { const GAS f32x4* xr = (const GAS f32x4*)(GIN(0) + (size_t)gw * D) + lane;
#pragma unroll
              for (int j = 0; j < 4; ++j) nx[j] = xr[64 * j]; }
            DUP(7) for (int m = gw; m < M; m += NGW) { f32x4 v[4];
#pragma unroll
                for (int j = 0; j < 4; ++j) v[j] = nx[j];
                if (m + NGW < M) { const GAS f32x4* xr = (const GAS f32x4*)(GIN(0) + (size_t)(m + NGW) * D) + lane;
#pragma unroll
                    for (int j = 0; j < 4; ++j) nx[j] = xr[64 * j]; }
                ln_norm_r(v, q); row_store_bf16(X + (size_t)m * D, v, lane); } }
    }
    GRID_BAR();

{ constexpr int l = 0;

        {
            PH_BEGIN;
            pg8::Gemm g{X, WIN + (size_t)l * INP_N * D, 0, nullptr}; pg8::StaticOrder S; S.init(M, INA_N, NG, bx);
            pg8::EpiInA E{Rr, Cb, FQ, FL, (size_t)(WS_FK - WS_FQ) / 2};
            DUP(1) pg8::gemm_phase<pg8::EpiInA, pg8::StaticOrder, true, false, D, D, D>(F.lds + RING_OFF, g, S, E);
#ifdef PROBE_A1MODE
            { pg8::EpiSink E9{(float*)LW}; pg8::gemm_phase<pg8::EpiSink, pg8::StaticOrder, true, false, D, D, D, false, PROBE_A1MODE>(F.lds + RING_OFF, g, S, E9); }
#endif
        }
        GRID_BAR();
        {
            PH_BEGIN;
            LAS unsigned* nrm = (LAS unsigned*)(F.lds + NRM_OFF);
            if (F.tid < 96) nrm[F.tid] = 0u;
            __syncthreads();
            if (F.vcu < 32) {
                const int bh = F.vcu, b = bh >> 3, h = bh & 7; const float bf_ = GIN(16)[l * 8 + h];
                LAS float* tot = (LAS float*)(F.lds + RING_OFF);
                float loc[16]; float run = 0.f; const int t0 = F.tid * 16;
#pragma unroll
                for (int i = 0; i < 16; ++i) { const float f = FL[((size_t)b * T + t0 + i) * 8 + h] + bf_; const float ls = fminf(f, 0.f) - log1pf(__expf(-fabsf(f))); run += ls; loc[i] = run; }
                tot[F.tid] = run; __syncthreads();
                float pre = 0.f; for (int i = 0; i < F.tid; ++i) pre += tot[i];
#pragma unroll
                for (int i = 0; i < 16; ++i) CB[(size_t)bh * T + t0 + i] = -(pre + loc[i]) * LOG2E;
                __syncthreads();
            }
            const float* mu = GIN(4) + (size_t)l * R_COLS + 1536; const float* cw = GIN(15) + (size_t)l * 3 * RW;
            const f32x4 mu4 = *(const f32x4*)(mu + 4 * lane);
            f32x4 w0a = *(const f32x4*)(cw + 8 * lane), w0b = *(const f32x4*)(cw + 8 * lane + 4), w1a = *(const f32x4*)(cw + RW + 8 * lane), w1b = *(const f32x4*)(cw + RW + 8 * lane + 4),
                  w2a = *(const f32x4*)(cw + 2 * RW + 8 * lane), w2b = *(const f32x4*)(cw + 2 * RW + 8 * lane + 4);
            struct A2Raw { pg8::u32x2 cu, pv; pg8::u32x4 b, c0, h0, c1, h1, c2, h2, fq, fk; };
            auto a2_fetch = [&](A2Raw& r, int m) { const int t = m & (T - 1);
                const bf16* rp = Rr + (size_t)m * R_COLS + 1536 + 4 * lane; r.cu = *(const pg8::u32x2*)rp; r.pv = (pg8::u32x2){0u, 0u}; if (t > 0) r.pv = *(const pg8::u32x2*)(rp - R_COLS);
                const bf16* cp = Cb + (size_t)m * C_COLS + 8 * lane; const pg8::u32x4 z4 = (pg8::u32x4){0u, 0u, 0u, 0u};
                r.b = *(const pg8::u32x4*)cp; r.c0 = *(const pg8::u32x4*)(cp + 512); r.h0 = *(const pg8::u32x4*)(cp + 1024);
                r.fq = *(const pg8::u32x4*)(FQ + (size_t)m * RW + 8 * lane); r.fk = *(const pg8::u32x4*)(FK + (size_t)m * RW + 8 * lane);
                r.c1 = z4; r.h1 = z4; r.c2 = z4; r.h2 = z4;
                if (t >= 1) { r.c1 = *(const pg8::u32x4*)(cp - C_COLS + 512); r.h1 = *(const pg8::u32x4*)(cp - C_COLS + 1024); }
                if (t >= 2) { r.c2 = *(const pg8::u32x4*)(cp - 2 * C_COLS + 512); r.h2 = *(const pg8::u32x4*)(cp - 2 * C_COLS + 1024); } };
            A2Raw nx; a2_fetch(nx, gw); float mq = 0.f, mk = 0.f, md = 0.f;
            DUP(3) for (int m = gw; m < M; m += NGW) {
                const A2Raw r = nx; if (m + NGW < M) a2_fetch(nx, m + NGW);
                {
                    f32x4 a0, a1; pg8::unpack8(r.fq, a0, a1); float sq = (a0[0] * a0[0] + a0[1] * a0[1]) + (a0[2] * a0[2] + a0[3] * a0[3]) + (a1[0] * a1[0] + a1[1] * a1[1]) + (a1[2] * a1[2] + a1[3] * a1[3]);
                    f32x4 k0, k1; pg8::unpack8(r.fk, k0, k1); float dq = (a0[0] * k0[0] + a0[1] * k0[1]) + (a0[2] * k0[2] + a0[3] * k0[3]) + (a1[0] * k1[0] + a1[1] * k1[1]) + (a1[2] * k1[2] + a1[3] * k1[3]);
                    a0 = k0; a1 = k1; float sk = (a0[0] * a0[0] + a0[1] * a0[1]) + (a0[2] * a0[2] + a0[3] * a0[3]) + (a1[0] * a1[0] + a1[1] * a1[1]) + (a1[2] * a1[2] + a1[3] * a1[3]);
                    sq += __shfl_xor(sq, 1); sk += __shfl_xor(sk, 1); dq += __shfl_xor(dq, 1); sq += __shfl_xor(sq, 2); sk += __shfl_xor(sk, 2); dq += __shfl_xor(dq, 2); sq += __shfl_xor(sq, 4); sk += __shfl_xor(sk, 4); dq += __shfl_xor(dq, 4);
                    mq = fmaxf(mq, sq); mk = fmaxf(mk, sk); md = fmaxf(md, -dq);
                    if (((m >> 11) & 3) == 3) {
                        if ((lane & 7) == 0) { LAS unsigned* e = nrm + ((m >> 13) * 8 + (lane >> 3)) * 3;
                            __hip_atomic_fetch_max(e, __float_as_uint(mq), __ATOMIC_RELAXED, __HIP_MEMORY_SCOPE_WORKGROUP); __hip_atomic_fetch_max(e + 1, __float_as_uint(mk), __ATOMIC_RELAXED, __HIP_MEMORY_SCOPE_WORKGROUP);
                            __hip_atomic_fetch_max(e + 2, __float_as_uint(md), __ATOMIC_RELAXED, __HIP_MEMORY_SCOPE_WORKGROUP); }
                        mq = 0.f; mk = 0.f; md = 0.f; }
                }
                {
                    const pg8::u32x2 cu = r.cu, pv = r.pv;
                    f32x4 c4 = (f32x4){bflo(cu.x), bfhi(cu.x), bflo(cu.y), bfhi(cu.y)}, p4 = (f32x4){bflo(pv.x), bfhi(pv.x), bflo(pv.y), bfhi(pv.y)};
                    f32x4 o = c4 + mu4 * (p4 - c4);
                    if (lane < 16) {
#pragma unroll
                        for (int j = 0; j < 4; ++j) o[j] = 2.f * sigm(2.f * o[j]) - 1.f;
                    } else if (lane >= 32) {
#pragma unroll
                        for (int j = 0; j < 4; ++j) o[j] = sigm(o[j]);
                    }
                    pg8::u32x2 ou; ou.x = pk2(o[0], o[1]); ou.y = pk2(o[2], o[3]); *(pg8::u32x2*)(LA + (size_t)m * 256 + 4 * lane) = ou;
                }
                {
                    f32x4 ba, bb, ca, cb_, ha, hb; pg8::unpack8(r.b, ba, bb);
                    pg8::unpack8(r.c0, ca, cb_); pg8::unpack8(r.h0, ha, hb); const f32x4 u0a = ca * ha, u0b = cb_ * hb;
                    pg8::unpack8(r.c1, ca, cb_); pg8::unpack8(r.h1, ha, hb); const f32x4 u1a = ca * ha, u1b = cb_ * hb;
                    pg8::unpack8(r.c2, ca, cb_); pg8::unpack8(r.h2, ha, hb); const f32x4 u2a = ca * ha, u2b = cb_ * hb;
                    const f32x4 ya = ba * (w0a * u2a + w1a * u1a + w2a * u0a), yb = bb * (w0b * u2b + w1b * u1b + w2b * u0b);
                    *(pg8::u32x4*)(OB + (size_t)m * RW + 8 * lane) = pg8::pack8(ya, yb);
                }
            }
            __syncthreads();
            if (F.tid < 96) { const unsigned v = nrm[F.tid]; if (v) __hip_atomic_fetch_max(ctl + CW_NRM + 128 * l + F.tid, v, RLX_AGENT); }
        }
        GRID_BAR();
        {
            PH_BEGIN;
            pg8::Gemm g{LA, WL + (size_t)l * 1536 * 256, 0, nullptr}; pg8::StaticOrder S; S.init(M, 1536, NG, bx);
            pg8::EpiLora E{LW, LAO, LG, GIN(5) + (size_t)l * RW, GIN(7) + (size_t)l * RW};
            DUP(1) pg8::gemm_phase<pg8::EpiLora, pg8::StaticOrder, true, false, 256, 256, 256>(F.lds + RING_OFF, g, S, E);
        }
        GRID_BAR();
        {
            PH_BEGIN;
#define CK_TASK(it_) (((4 * (bx & 7) + ((((it_) * 32 + (bx >> 3))) >> 7)) << 7) + ((((it_) * 32 + (bx >> 3))) & 127))
            CkRaw raw; ck_load(raw, CK_TASK(0), F.wave, lane, Rr, LAO, LW, GIN(4) + (size_t)l * R_COLS, GIN(10) + (size_t)l * RW, GIN(11) + (size_t)l * RW, GIN(12) + (size_t)l * RW);
            for (int it = 0; it < 16; ++it)
                rwkv_chunk_local(F, CK_TASK(it), (it + 1 < 16) ? CK_TASK(it + 1) : -1, raw, Rr, LAO, LW, OA, BV, PMB, QMB, RHB, GIN(4) + (size_t)l * R_COLS, GIN(10) + (size_t)l * RW, GIN(11) + (size_t)l * RW, GIN(12) + (size_t)l * RW);
        }
        GRID_BAR();
        {
            PH_BEGIN;
            const int grp = bx & 7, jj = bx >> 3;
#if (PROBE_DUP >> 5) & 1
            if (jj < 4) rwkv_carry(F, grp * 4 + jj, PMB, QMB, (bf16*)outp);
#endif
            if (jj < 4) rwkv_carry(F, grp * 4 + jj, PMB, QMB, QMB);
#if (PROBE_DUP >> 15) & 1
            { const attn_orig::AttnTensors AT3{(const attn_orig::bf16*)FQ, (const attn_orig::bf16*)FK, (const attn_orig::bf16*)FV, (attn_orig::bf16*)outp};
              struct DynO { gu32* ctr; volatile LAS unsigned* slot; int grp;
                __device__ __forceinline__ bool next(int, attn_orig::AttnUnit& u) const { if (threadIdx.x == 0) slot[0] = __hip_atomic_fetch_add(ctr, 1u, RLX_AGENT); __syncthreads(); const unsigned v = slot[0]; __syncthreads(); if (v >= 128u) return false; u.qb = 31 - (int)(v >> 2); u.bh = grp * 4 + (int)(v & 3u); return true; }
                __device__ __forceinline__ void a_ready(const attn_orig::AttnUnit&) const {} __device__ __forceinline__ void done(const attn_orig::AttnUnit&) const {} };
              const DynO S3{ctl + CW_QATT + 512 + 1024 * l + 64 * grp, F.MISC + 0, grp};
              attn_orig::attn_phase<DynO, 8>((char*)lds + RING_OFF, AT3, S3); }
#endif
#if (PROBE_DUP >> 4) & 1
            { const attn_body::AttnTensors AT2{(const attn_body::bf16*)FQ, (const attn_body::bf16*)FK, (const attn_body::bf16*)FV, (attn_body::bf16*)outp, CB};
              const DynAttnOrder S2{ctl + CW_QATT + 512 + 1024 * l + 64 * grp, F.MISC + 0, grp};
              attn_body::attn_phase<DynAttnOrder, 24>((char*)lds + RING_OFF, AT2, S2); }
#endif
            const attn_body::AttnTensors AT{(const attn_body::bf16*)FQ, (const attn_body::bf16*)FK, (const attn_body::bf16*)FV, (attn_body::bf16*)FQ, CB};
            {
                volatile LAS unsigned* slot = F.MISC + 0; gu32* ctr0 = ctl + CW_QATT + 1024 * l;
                int cg = grp, tried = 0; unsigned pre = 0u; if (F.tid == 0) pre = __hip_atomic_fetch_add(ctr0 + 64 * cg, 1u, RLX_AGENT);
                for (;;) {
                    if (F.tid == 0) { slot[0] = pre; slot[3] = (unsigned)cg; }
                    __syncthreads(); const unsigned v = slot[0]; const int g = (int)slot[3];
                    if (v < 128u && F.tid < 128) { const int qb_ = 31 - (int)(v >> 2), bh_ = g * 4 + (int)(v & 3u); const float* cbh = CB + (size_t)bh_ * T;
                        const float q2 = __uint_as_float(__hip_atomic_load(ctl + CW_NRM + 128 * l + 3 * bh_, RLX_AGENT)), k2 = __uint_as_float(__hip_atomic_load(ctl + CW_NRM + 128 * l + 3 * bh_ + 1, RLX_AGENT)),
                                    dn = __uint_as_float(__hip_atomic_load(ctl + CW_NRM + 128 * l + 3 * bh_ + 2, RLX_AGENT));
                        const float thr = cbh[qb_ * 256] - (40.5f + 1.01f * (sqrtf(q2 * k2) + dn));
                        const bool sk = (F.tid < 4 * qb_) && (cbh[64 * F.tid + 63] < thr);
                        const unsigned long long bal = __ballot(sk);
                        if (F.lane == 0) slot[1 + F.wave] = (unsigned)__popcll(bal); }
                    __syncthreads();
                    if (v >= 128u) {
                        if (++tried == 8) break;
                        cg = (g + 1) & 7; if (F.tid == 0) pre = __hip_atomic_fetch_add(ctr0 + 64 * cg, 1u, RLX_AGENT);
                        continue; }
                    if (F.tid == 0) pre = __hip_atomic_fetch_add(ctr0 + 64 * g, 1u, RLX_AGENT);
                    const int qb = 31 - (int)(v >> 2), bh = g * 4 + (int)(v & 3u);
                    const int ts = (int)(slot[1] + slot[2]) & ~1;
                    attn_body::attn_unit<24>(bh / attn_body::NHEAD, bh % attn_body::NHEAD, qb, (const attn_body::bf16*)FQ, (const attn_body::bf16*)FK, (const attn_body::bf16*)FV, (attn_body::bf16*)FQ, CB + (size_t)bh * attn_body::SEQ, (char*)lds + RING_OFF, ts);
                }
            }
        }
        GRID_BAR();
        {
            PH_BEGIN;
            {
#define FX_PAIR(it_) (256 * (bx & 7) + (it_) * 32 + (bx >> 3))
                FxRaw fa, fb; fx_load(fa, FX_PAIR(0), F.wave, lane, RHB, QMB, OA, BV, LG);
#pragma unroll 1
                for (int it = 0; it < 8; it += 2) {
                    fx_load(fb, FX_PAIR(it + 1), F.wave, lane, RHB, QMB, OA, BV, LG);
                    rwkv_fixup(F, FX_PAIR(it), fa, OA, GIN(13) + (size_t)l * RW, GIN(14) + (size_t)l * RW);
                    if (it + 2 < 8) fx_load(fa, FX_PAIR(it + 2), F.wave, lane, RHB, QMB, OA, BV, LG);
                    rwkv_fixup(F, FX_PAIR(it + 1), fb, OA, GIN(13) + (size_t)l * RW, GIN(14) + (size_t)l * RW);
                }
            }
            pg8::Gemm g{X, WIN + ((size_t)l * INP_N + INA_N) * D, 0, nullptr}; pg8::StaticOrder S; S.init(M, 3 * D, NG, bx);
            pg8::EpiGate E{(unsigned char*)outp, (unsigned char*)(ws + WS_G2), GIN(17) + (size_t)l * 3 * D, (size_t)M * D};
            DUP(1) pg8::gemm_phase<pg8::EpiGate, pg8::StaticOrder, true, false, D, D, D>(F.lds + RING_OFF, g, S, E);
        }
        GRID_BAR();
        {
            PH_BEGIN;
            pg8::Gemm g{OA, WUP + (size_t)l * D * 3 * RW, 0, nullptr, (long)WS_OB - (long)WS_OA, (long)WS_FQ - (long)WS_OA}; pg8::StaticOrder S; S.init(M, D, NG, bx);
            pg8::EpiUp3 E{(const unsigned char*)outp, (const unsigned char*)(ws + WS_G2), (size_t)M * D, MG};
            DUP(9) pg8::gemm_phase<pg8::EpiUp3, pg8::StaticOrder, true, false, RW, 3 * RW, 3 * RW, true>(F.lds + RING_OFF, g, S, E);
        }
        GRID_BAR();
        {
            PH_BEGIN;
            pg8::Gemm g{MG, WOUT + (size_t)l * D * D, 0, nullptr}; pg8::StaticOrder S; S.init(M, D, NG, bx);
            pg8::EpiResid E{X, Y, DN_ALPHA};
            DUP(1) pg8::gemm_phase<pg8::EpiResid, pg8::StaticOrder, true, false, D, D, D>(F.lds + RING_OFF, g, S, E);
        }
        GRID_BAR();
        {
            PH_BEGIN;
            const float* g1 = GIN(22) + (size_t)l * D; const float* b1 = GIN(23) + (size_t)l * D;
            const bool moe = (l & 1) != 0;
            LAS float* rwl = (LAS float*)(F.lds + RING_OFF);
            if (moe) { for (int i = F.tid; i < D * NEXP / 4; i += NWAVES * 64) ((LAS f32x4*)rwl)[i] = ((const f32x4*)(GIN(29) + (size_t)(l >> 1) * D * NEXP))[i]; __syncthreads(); }
            LnGB q; ln_load_gb(q, g1, b1, lane); RowRaw nx; row_fetch(nx, Y + (size_t)gw * D, lane);
            float rbias[8];
#pragma unroll
            for (int e = 0; e < 8; ++e) rbias[e] = moe ? GIN(30)[(l >> 1) * NEXP + e] : 0.f;
            for (int dup_ = 0; dup_ < ((((PROBE_DUP) >> 7) & 1) && !moe ? 2 : 1); ++dup_) for (int m = gw; m < M; m += NGW) { f32x4 v[4]; row_unpack(nx, v);
                if (m + NGW < M) row_fetch(nx, Y + (size_t)(m + NGW) * D, lane);
                ln_norm_r(v, q); row_store_bf16(X + (size_t)m * D, v, lane);
                if (moe) {
                    float lgt[8];
#pragma unroll
                    for (int e = 0; e < 8; ++e) lgt[e] = 0.f;
#pragma unroll
                    for (int j = 0; j < 4; ++j)
#pragma unroll
                        for (int i = 0; i < 4; ++i) { const LAS f32x4* wp = (const LAS f32x4*)(rwl + (size_t)(4 * lane + 256 * j + i) * 8); const f32x4 wa = wp[0], wb = wp[1]; const float xv = v[j][i];
                            lgt[0] += xv * wa[0]; lgt[1] += xv * wa[1]; lgt[2] += xv * wa[2]; lgt[3] += xv * wa[3]; lgt[4] += xv * wb[0]; lgt[5] += xv * wb[1]; lgt[6] += xv * wb[2]; lgt[7] += xv * wb[3]; }
#pragma unroll
                    for (int e = 0; e < 8; ++e) lgt[e] = wave_sum(lgt[e]) + rbias[e];
                    if (lane == 0) {
                        int e1 = 0; float v1 = lgt[0];
#pragma unroll
                        for (int e = 1; e < 8; ++e) if (lgt[e] > v1) { v1 = lgt[e]; e1 = e; }
                        int e2 = -1; float v2 = -INFINITY;
#pragma unroll
                        for (int e = 0; e < 8; ++e) if (e != e1 && lgt[e] > v2) { v2 = lgt[e]; e2 = e; }
                        const float gA = 1.f / (1.f + __expf(v2 - v1));
                        TOKE[m] = (unsigned)e1 | ((unsigned)e2 << 8); TOKG[2 * m] = gA; TOKG[2 * m + 1] = 1.f - gA;
                        const int hf = m / MOE_HALF;
                        LAS unsigned* lc = (LAS unsigned*)(F.lds + LCNT_OFF); __hip_atomic_fetch_add(lc + hf * 8 + e1, 1u, __ATOMIC_RELAXED, __HIP_MEMORY_SCOPE_WORKGROUP); __hip_atomic_fetch_add(lc + hf * 8 + e2, 1u, __ATOMIC_RELAXED, __HIP_MEMORY_SCOPE_WORKGROUP);
                    }
                }
            }
            if (moe) {
                __syncthreads();
                if (F.tid < 16) { const unsigned cv = ((LAS unsigned*)(F.lds + LCNT_OFF))[F.tid]; if (cv) __hip_atomic_fetch_add(ctl + CW_CNT + 64 * F.tid, cv, RLX_AGENT); }
                LAS float* scr = (LAS float*)(F.lds + RING_OFF + 32768 + F.wave * 8448);
                const int li = l >> 1; constexpr int I_13 = (2 * DFFE / 32) * 16, I_2 = 32 * (DFFE / 64);
                DUP(2) for (int it = gw; it < NEXP * (I_13 + I_2); it += NGW) {
                    const int e = it / (I_13 + I_2); int r = it - e * (I_13 + I_2);
                    if (r < I_13) { const int rg = r >> 4, kb = r & 15, d0 = 32 * rg, tile = d0 >> 8, within = d0 & 255;
                        const float* W = ((within < 128) ? GIN(31) : GIN(32)) + ((size_t)li * NEXP + e) * D * DFFE;
                        tr_item(W, DFFE, 64 * kb, tile * 128 + (within & 127), 32, WM13 + ((size_t)e * 2 * DFFE + d0) * D, D, 64 * kb, 1.f, scr, lane); }
                    else { r -= I_13; const int rg = r / (DFFE / 64), kb = r % (DFFE / 64);
                        tr_item(GIN(33) + ((size_t)li * NEXP + e) * DFFE * D, D, 64 * kb, 32 * rg, 32, WM2 + ((size_t)e * D + 32 * rg) * DFFE, DFFE, 64 * kb, 1.f, scr, lane); }
                }
            }
        }
        GRID_BAR();
        if constexpr ((l & 1) == 0) {
            {
                PH_BEGIN;
                pg8::Gemm g{X, W13, 0, nullptr}; pg8::StaticOrder S; S.init(M, 2 * DFF, NG, bx);
                pg8::EpiSwiglu E{H, DFF};
                DUP(1) pg8::gemm_phase<pg8::EpiSwiglu, pg8::StaticOrder, true, false, D, D, D>(F.lds + RING_OFF, g, S, E);
            }
            GRID_BAR();
            {
                PH_BEGIN;
                pg8::Gemm g{H, W2, 0, nullptr}; pg8::StaticOrder S; S.init(M, D, NG, bx);
                pg8::EpiResid E{X, Y, DN_ALPHA};
#if defined(PROBE_ZERO_FFN) && (PROBE_ZERO_FFN & 1)
                E.zero = 1;
#endif
                DUP(1) pg8::gemm_phase<pg8::EpiResid, pg8::StaticOrder, true, false, DFF, DFF, DFF>(F.lds + RING_OFF, g, S, E);
            }
            GRID_BAR();
            {
                PH_BEGIN;
                const float* g2 = GIN(24) + (size_t)l * D; const float* b2 = GIN(25) + (size_t)l * D;
                LnGB q; ln_load_gb(q, g2, b2, lane); RowRaw nx; row_fetch(nx, Y + (size_t)gw * D, lane);
                DUP(7) for (int m = gw; m < M; m += NGW) { f32x4 v[4]; row_unpack(nx, v);
                    if (m + NGW < M) row_fetch(nx, Y + (size_t)(m + NGW) * D, lane);
                    ln_norm_r(v, q);
                    if (l == NLAYER - 1) { GAS f32x4* o = (GAS f32x4*)(outp + (size_t)m * D) + lane;
#pragma unroll
                        for (int j = 0; j < 4; ++j) o[64 * j] = v[j]; }
                    else row_store_bf16(X + (size_t)m * D, v, lane); }
            }
            GRID_BAR();
        } else {
            LAS int* moff = (LAS int*)((LAS unsigned char*)lds + MOFF_OFF);
            LAS int* pexp = (LAS int*)((LAS unsigned char*)lds + PEXP_OFF);
            { PH_BEGIN;
            if (F.tid < 2) { int o = 0; for (int e = 0; e < NEXP; ++e) { moff[F.tid * 9 + e] = o; const int c = (int)__hip_atomic_load(ctl + CW_CNT + 64 * (F.tid * 8 + e), RLX_AGENT); o += (c + 255) & ~255; } moff[F.tid * 9 + 8] = o; }
            __syncthreads();
            {
                const int m = F.vcu * (NWAVES * 64) + F.tid;
                LAS unsigned* lf = (LAS unsigned*)(F.lds + LFIL_OFF); LAS unsigned* lb = (LAS unsigned*)(F.lds + LBAS_OFF);
                unsigned te = 0u, rk0 = 0u, rk1 = 0u; int hf = 0;
                if (m < M) { hf = m / MOE_HALF; te = TOKE[m];
                    rk0 = __hip_atomic_fetch_add(lf + hf * 8 + (int)(te & 255u), 1u, __ATOMIC_RELAXED, __HIP_MEMORY_SCOPE_WORKGROUP);
                    rk1 = __hip_atomic_fetch_add(lf + hf * 8 + (int)((te >> 8) & 255u), 1u, __ATOMIC_RELAXED, __HIP_MEMORY_SCOPE_WORKGROUP); }
                __syncthreads();
                if (F.tid < 16) { const unsigned cv = lf[F.tid]; lb[F.tid] = cv ? __hip_atomic_fetch_add(ctl + CW_FILL + 64 * F.tid, cv, RLX_AGENT) : 0u; }
                __syncthreads();
                if (m < M) { const int e0 = (int)(te & 255u), e1 = (int)((te >> 8) & 255u);
                    const int p0 = moff[hf * 9 + e0] + (int)(lb[hf * 8 + e0] + rk0), p1 = moff[hf * 9 + e1] + (int)(lb[hf * 8 + e1] + rk1);
                    PPOS[2 * m] = (unsigned)p0; PPOS[2 * m + 1] = (unsigned)p1; RTOK[hf * MOE_ROWS + p0] = m; RTOK[hf * MOE_ROWS + p1] = m; }
                if (F.vcu >= 64 && F.vcu < 66) { const int hf = F.vcu - 64;
                    for (int e = 0; e < NEXP; ++e) { const int c = (int)__hip_atomic_load(ctl + CW_CNT + 64 * (hf * 8 + e), RLX_AGENT); const int p0 = moff[hf * 9 + e] + c, p1 = moff[hf * 9 + e + 1];
                        for (int p = p0 + F.tid; p < p1; p += NWAVES * 64) RTOK[hf * MOE_ROWS + p] = hf * MOE_HALF; } }
            } }
            GRID_BAR();
{ constexpr int hf = 0;

                const int npan = moff[hf * 9 + 8] >> 8;
                __syncthreads();
                int tp_ = threadIdx.x; asm volatile("" : "+v"(tp_));
                for (int p = tp_; p < npan; p += NWAVES * 64) { int e = 0;
#pragma unroll
                    for (int q = 1; q < NEXP; ++q) if (p * 256 >= moff[hf * 9 + q]) e = q;
                    pexp[p] = e; }
                __syncthreads();
                {
                    PH_BEGIN;
                    pg8::Gemm g{X, WM13, (size_t)2 * DFFE * D * 2, RTOK + hf * MOE_ROWS}; pg8::GroupedOrder S; S.so.init_tiles(npan, 2 * DFFE / 256, NG, bx); S.pexp = pexp;
                    pg8::EpiSwiglu E{HM, DFFE};
                    DUP(1) pg8::gemm_phase<pg8::EpiSwiglu, pg8::GroupedOrder, true, true, D, D, D>(F.lds + RING_OFF, g, S, E);
                }
                GRID_BAR();
                {
                    PH_BEGIN;
                    const int npm = npan < MOE_MAINP ? npan : MOE_MAINP;
                    pg8::Gemm g{HM, WM2, (size_t)D * DFFE * 2, nullptr}; pg8::GroupedOrder S; S.so.init_tiles(npm, D / 256, NG, bx); S.pexp = pexp;
                    pg8::EpiStore E{YP, D};
                    pg8::gemm_phase<pg8::EpiStore, pg8::GroupedOrder, true, false, DFFE, DFFE, DFFE>(F.lds + RING_OFF, g, S, E);
                    if (npan > MOE_MAINP) {
                        pg8::SliceOrder T{MOE_MAINP, npan - MOE_MAINP, D / 256, bx, (DFFE / 4) * 2, pexp};
                        pg8::EpiStore E2{YPS, D, MOE_MAINP, (DFFE / 4) * 2, (size_t)8 * 256 * D};
                        pg8::gemm_phase<pg8::EpiStore, pg8::SliceOrder, true, false, DFFE, DFFE, DFFE / 4>(F.lds + RING_OFF, g, T, E2);
                    }
                }
                GRID_BAR();
                {
                    PH_BEGIN;
                    const float* g2 = GIN(24) + (size_t)l * D; const float* b2 = GIN(25) + (size_t)l * D;
                    LnGB q; ln_load_gb(q, g2, b2, lane);
                    constexpr unsigned MAINR = (unsigned)(MOE_MAINP * 256);
                    unsigned np1 = PPOS[2 * (hf * MOE_HALF + gw)], np2 = PPOS[2 * (hf * MOE_HALF + gw) + 1]; float nga = TOKG[2 * (hf * MOE_HALF + gw)], ngb = TOKG[2 * (hf * MOE_HALF + gw) + 1];
                    RowRaw rx, ra, rc; unsigned p1 = np1, p2 = np2; float ga = nga, gb = ngb;
                    row_fetch(rx, X + (size_t)(hf * MOE_HALF + gw) * D, lane);
                    row_fetch(ra, (p1 < MAINR) ? YP + (size_t)p1 * D : YPS + (size_t)(p1 - MAINR) * D, lane); row_fetch(rc, (p2 < MAINR) ? YP + (size_t)p2 * D : YPS + (size_t)(p2 - MAINR) * D, lane);
                    if (gw + NGW < MOE_HALF) { const int m2 = hf * MOE_HALF + gw + NGW; np1 = PPOS[2 * m2]; np2 = PPOS[2 * m2 + 1]; nga = TOKG[2 * m2]; ngb = TOKG[2 * m2 + 1]; }
                    DUP(7) for (int mm = gw; mm < MOE_HALF; mm += NGW) { const int m = hf * MOE_HALF + mm;
                        f32x4 v[4], a[4], c[4]; row_unpack(rx, v); row_unpack(ra, a); row_unpack(rc, c);
                        const unsigned q1 = p1, q2 = p2; const float ha = ga, hb = gb;
                        if (q1 >= MAINR) { f32x4 t4[4];
#pragma unroll
                            for (int sl = 1; sl < 4; ++sl) { row_load_bf16(YPS + (size_t)sl * 8 * 256 * D + (size_t)(q1 - MAINR) * D, t4, lane);
#pragma unroll
                                for (int j = 0; j < 4; ++j) a[j] = a[j] + t4[j]; } }
                        if (q2 >= MAINR) { f32x4 t4[4];
#pragma unroll
                            for (int sl = 1; sl < 4; ++sl) { row_load_bf16(YPS + (size_t)sl * 8 * 256 * D + (size_t)(q2 - MAINR) * D, t4, lane);
#pragma unroll
                                for (int j = 0; j < 4; ++j) c[j] = c[j] + t4[j]; } }
                        if (mm + NGW < MOE_HALF) { const int m1 = m + NGW; p1 = np1; p2 = np2; ga = nga; gb = ngb;
                            row_fetch(rx, X + (size_t)m1 * D, lane);
                            row_fetch(ra, (p1 < MAINR) ? YP + (size_t)p1 * D : YPS + (size_t)(p1 - MAINR) * D, lane); row_fetch(rc, (p2 < MAINR) ? YP + (size_t)p2 * D : YPS + (size_t)(p2 - MAINR) * D, lane);
                            if (mm + 2 * NGW < MOE_HALF) { const int m2 = m + 2 * NGW; np1 = PPOS[2 * m2]; np2 = PPOS[2 * m2 + 1]; nga = TOKG[2 * m2]; ngb = TOKG[2 * m2 + 1]; } }
#pragma unroll
                        for (int j = 0; j < 4; ++j) v[j] = DN_ALPHA * v[j] + PROBE_MOE_SCALE * (ha * a[j] + hb * c[j]);
                        ln_norm_r(v, q);
                        if (l == NLAYER - 1) { GAS f32x4* o = (GAS f32x4*)(outp + (size_t)m * D) + lane;
#pragma unroll
                            for (int j = 0; j < 4; ++j) o[64 * j] = v[j]; }
                        else row_store_bf16(X + (size_t)m * D, v, lane); }
                }

}
{ constexpr int hf = 1;

                const int npan = moff[hf * 9 + 8] >> 8;
                __syncthreads();
                int tp_ = threadIdx.x; asm volatile("" : "+v"(tp_));
                for (int p = tp_; p < npan; p += NWAVES * 64) { int e = 0;
#pragma unroll
                    for (int q = 1; q < NEXP; ++q) if (p * 256 >= moff[hf * 9 + q]) e = q;
                    pexp[p] = e; }
                __syncthreads();
                {
                    PH_BEGIN;
                    pg8::Gemm g{X, WM13, (size_t)2 * DFFE * D * 2, RTOK + hf * MOE_ROWS}; pg8::GroupedOrder S; S.so.init_tiles(npan, 2 * DFFE / 256, NG, bx); S.pexp = pexp;
                    pg8::EpiSwiglu E{HM, DFFE};
                    DUP(1) pg8::gemm_phase<pg8::EpiSwiglu, pg8::GroupedOrder, true, true, D, D, D>(F.lds + RING_OFF, g, S, E);
                }
                GRID_BAR();
                {
                    PH_BEGIN;
                    const int npm = npan < MOE_MAINP ? npan : MOE_MAINP;
                    pg8::Gemm g{HM, WM2, (size_t)D * DFFE * 2, nullptr}; pg8::GroupedOrder S; S.so.init_tiles(npm, D / 256, NG, bx); S.pexp = pexp;
                    pg8::EpiStore E{YP, D};
                    pg8::gemm_phase<pg8::EpiStore, pg8::GroupedOrder, true, false, DFFE, DFFE, DFFE>(F.lds + RING_OFF, g, S, E);
                    if (npan > MOE_MAINP) {
                        pg8::SliceOrder T{MOE_MAINP, npan - MOE_MAINP, D / 256, bx, (DFFE / 4) * 2, pexp};
                        pg8::EpiStore E2{YPS, D, MOE_MAINP, (DFFE / 4) * 2, (size_t)8 * 256 * D};
                        pg8::gemm_phase<pg8::EpiStore, pg8::SliceOrder, true, false, DFFE, DFFE, DFFE / 4>(F.lds + RING_OFF, g, T, E2);
                    }
                }
                GRID_BAR();
                {
                    PH_BEGIN;
                    const float* g2 = GIN(24) + (size_t)l * D; const float* b2 = GIN(25) + (size_t)l * D;
                    LnGB q; ln_load_gb(q, g2, b2, lane);
                    constexpr unsigned MAINR = (unsigned)(MOE_MAINP * 256);
                    unsigned np1 = PPOS[2 * (hf * MOE_HALF + gw)], np2 = PPOS[2 * (hf * MOE_HALF + gw) + 1]; float nga = TOKG[2 * (hf * MOE_HALF + gw)], ngb = TOKG[2 * (hf * MOE_HALF + gw) + 1];
                    RowRaw rx, ra, rc; unsigned p1 = np1, p2 = np2; float ga = nga, gb = ngb;
                    row_fetch(rx, X + (size_t)(hf * MOE_HALF + gw) * D, lane);
                    row_fetch(ra, (p1 < MAINR) ? YP + (size_t)p1 * D : YPS + (size_t)(p1 - MAINR) * D, lane); row_fetch(rc, (p2 < MAINR) ? YP + (size_t)p2 * D : YPS + (size_t)(p2 - MAINR) * D, lane);
                    if (gw + NGW < MOE_HALF) { const int m2 = hf * MOE_HALF + gw + NGW; np1 = PPOS[2 * m2]; np2 = PPOS[2 * m2 + 1]; nga = TOKG[2 * m2]; ngb = TOKG[2 * m2 + 1]; }
                    DUP(7) for (int mm = gw; mm < MOE_HALF; mm += NGW) { const int m = hf * MOE_HALF + mm;
                        f32x4 v[4], a[4], c[4]; row_unpack(rx, v); row_unpack(ra, a); row_unpack(rc, c);
                        const unsigned q1 = p1, q2 = p2; const float ha = ga, hb = gb;
                        if (q1 >= MAINR) { f32x4 t4[4];
#pragma unroll
                            for (int sl = 1; sl < 4; ++sl) { row_load_bf16(YPS + (size_t)sl * 8 * 256 * D + (size_t)(q1 - MAINR) * D, t4, lane);
#pragma unroll
                                for (int j = 0; j < 4; ++j) a[j] = a[j] + t4[j]; } }
                        if (q2 >= MAINR) { f32x4 t4[4];
#pragma unroll
                            for (int sl = 1; sl < 4; ++sl) { row_load_bf16(YPS + (size_t)sl * 8 * 256 * D + (size_t)(q2 - MAINR) * D, t4, lane);
#pragma unroll
                                for (int j = 0; j < 4; ++j) c[j] = c[j] + t4[j]; } }
                        if (mm + NGW < MOE_HALF) { const int m1 = m + NGW; p1 = np1; p2 = np2; ga = nga; gb = ngb;
                            row_fetch(rx, X + (size_t)m1 * D, lane);
                            row_fetch(ra, (p1 < MAINR) ? YP + (size_t)p1 * D : YPS + (size_t)(p1 - MAINR) * D, lane); row_fetch(rc, (p2 < MAINR) ? YP + (size_t)p2 * D : YPS + (size_t)(p2 - MAINR) * D, lane);
                            if (mm + 2 * NGW < MOE_HALF) { const int m2 = m + 2 * NGW; np1 = PPOS[2 * m2]; np2 = PPOS[2 * m2 + 1]; nga = TOKG[2 * m2]; ngb = TOKG[2 * m2 + 1]; } }
#pragma unroll
                        for (int j = 0; j < 4; ++j) v[j] = DN_ALPHA * v[j] + PROBE_MOE_SCALE * (ha * a[j] + hb * c[j]);
                        ln_norm_r(v, q);
                        if (l == NLAYER - 1) { GAS f32x4* o = (GAS f32x4*)(outp + (size_t)m * D) + lane;
#pragma unroll
                            for (int j = 0; j < 4; ++j) o[64 * j] = v[j]; }
                        else row_store_bf16(X + (size_t)m * D, v, lane); }
                }

}

            if (l != NLAYER - 1) GRID_BAR();
        }

}
{ constexpr int l = 1;

        {
            PH_BEGIN;
            pg8::Gemm g{X, WIN + (size_t)l * INP_N * D, 0, nullptr}; pg8::StaticOrder S; S.init(M, INA_N, NG, bx);
            pg8::EpiInA E{Rr, Cb, FQ, FL, (size_t)(WS_FK - WS_FQ) / 2};
            DUP(1) pg8::gemm_phase<pg8::EpiInA, pg8::StaticOrder, true, false, D, D, D>(F.lds + RING_OFF, g, S, E);
#ifdef PROBE_A1MODE
            { pg8::EpiSink E9{(float*)LW}; pg8::gemm_phase<pg8::EpiSink, pg8::StaticOrder, true, false, D, D, D, false, PROBE_A1MODE>(F.lds + RING_OFF, g, S, E9); }
#endif
        }
        GRID_BAR();
        {
            PH_BEGIN;
            LAS unsigned* nrm = (LAS unsigned*)(F.lds + NRM_OFF);
            if (F.tid < 96) nrm[F.tid] = 0u;
            __syncthreads();
            if (F.vcu < 32) {
                const int bh = F.vcu, b = bh >> 3, h = bh & 7; const float bf_ = GIN(16)[l * 8 + h];
                LAS float* tot = (LAS float*)(F.lds + RING_OFF);
                float loc[16]; float run = 0.f; const int t0 = F.tid * 16;
#pragma unroll
                for (int i = 0; i < 16; ++i) { const float f = FL[((size_t)b * T + t0 + i) * 8 + h] + bf_; const float ls = fminf(f, 0.f) - log1pf(__expf(-fabsf(f))); run += ls; loc[i] = run; }
                tot[F.tid] = run; __syncthreads();
                float pre = 0.f; for (int i = 0; i < F.tid; ++i) pre += tot[i];
#pragma unroll
                for (int i = 0; i < 16; ++i) CB[(size_t)bh * T + t0 + i] = -(pre + loc[i]) * LOG2E;
                __syncthreads();
            }
            const float* mu = GIN(4) + (size_t)l * R_COLS + 1536; const float* cw = GIN(15) + (size_t)l * 3 * RW;
            const f32x4 mu4 = *(const f32x4*)(mu + 4 * lane);
            f32x4 w0a = *(const f32x4*)(cw + 8 * lane), w0b = *(const f32x4*)(cw + 8 * lane + 4), w1a = *(const f32x4*)(cw + RW + 8 * lane), w1b = *(const f32x4*)(cw + RW + 8 * lane + 4),
                  w2a = *(const f32x4*)(cw + 2 * RW + 8 * lane), w2b = *(const f32x4*)(cw + 2 * RW + 8 * lane + 4);
            struct A2Raw { pg8::u32x2 cu, pv; pg8::u32x4 b, c0, h0, c1, h1, c2, h2, fq, fk; };
            auto a2_fetch = [&](A2Raw& r, int m) { const int t = m & (T - 1);
                const bf16* rp = Rr + (size_t)m * R_COLS + 1536 + 4 * lane; r.cu = *(const pg8::u32x2*)rp; r.pv = (pg8::u32x2){0u, 0u}; if (t > 0) r.pv = *(const pg8::u32x2*)(rp - R_COLS);
                const bf16* cp = Cb + (size_t)m * C_COLS + 8 * lane; const pg8::u32x4 z4 = (pg8::u32x4){0u, 0u, 0u, 0u};
                r.b = *(const pg8::u32x4*)cp; r.c0 = *(const pg8::u32x4*)(cp + 512); r.h0 = *(const pg8::u32x4*)(cp + 1024);
                r.fq = *(const pg8::u32x4*)(FQ + (size_t)m * RW + 8 * lane); r.fk = *(const pg8::u32x4*)(FK + (size_t)m * RW + 8 * lane);
                r.c1 = z4; r.h1 = z4; r.c2 = z4; r.h2 = z4;
                if (t >= 1) { r.c1 = *(const pg8::u32x4*)(cp - C_COLS + 512); r.h1 = *(const pg8::u32x4*)(cp - C_COLS + 1024); }
                if (t >= 2) { r.c2 = *(const pg8::u32x4*)(cp - 2 * C_COLS + 512); r.h2 = *(const pg8::u32x4*)(cp - 2 * C_COLS + 1024); } };
            A2Raw nx; a2_fetch(nx, gw); float mq = 0.f, mk = 0.f, md = 0.f;
            DUP(3) for (int m = gw; m < M; m += NGW) {
                const A2Raw r = nx; if (m + NGW < M) a2_fetch(nx, m + NGW);
                {
                    f32x4 a0, a1; pg8::unpack8(r.fq, a0, a1); float sq = (a0[0] * a0[0] + a0[1] * a0[1]) + (a0[2] * a0[2] + a0[3] * a0[3]) + (a1[0] * a1[0] + a1[1] * a1[1]) + (a1[2] * a1[2] + a1[3] * a1[3]);
                    f32x4 k0, k1; pg8::unpack8(r.fk, k0, k1); float dq = (a0[0] * k0[0] + a0[1] * k0[1]) + (a0[2] * k0[2] + a0[3] * k0[3]) + (a1[0] * k1[0] + a1[1] * k1[1]) + (a1[2] * k1[2] + a1[3] * k1[3]);
                    a0 = k0; a1 = k1; float sk = (a0[0] * a0[0] + a0[1] * a0[1]) + (a0[2] * a0[2] + a0[3] * a0[3]) + (a1[0] * a1[0] + a1[1] * a1[1]) + (a1[2] * a1[2] + a1[3] * a1[3]);
                    sq += __shfl_xor(sq, 1); sk += __shfl_xor(sk, 1); dq += __shfl_xor(dq, 1); sq += __shfl_xor(sq, 2); sk += __shfl_xor(sk, 2); dq += __shfl_xor(dq, 2); sq += __shfl_xor(sq, 4); sk += __shfl_xor(sk, 4); dq += __shfl_xor(dq, 4);
                    mq = fmaxf(mq, sq); mk = fmaxf(mk, sk); md = fmaxf(md, -dq);
                    if (((m >> 11) & 3) == 3) {
                        if ((lane & 7) == 0) { LAS unsigned* e = nrm + ((m >> 13) * 8 + (lane >> 3)) * 3;
                            __hip_atomic_fetch_max(e, __float_as_uint(mq), __ATOMIC_RELAXED, __HIP_MEMORY_SCOPE_WORKGROUP); __hip_atomic_fetch_max(e + 1, __float_as_uint(mk), __ATOMIC_RELAXED, __HIP_MEMORY_SCOPE_WORKGROUP);
                            __hip_atomic_fetch_max(e + 2, __float_as_uint(md), __ATOMIC_RELAXED, __HIP_MEMORY_SCOPE_WORKGROUP); }
                        mq = 0.f; mk = 0.f; md = 0.f; }
                }
                {
                    const pg8::u32x2 cu = r.cu, pv = r.pv;
                    f32x4 c4 = (f32x4){bflo(cu.x), bfhi(cu.x), bflo(cu.y), bfhi(cu.y)}, p4 = (f32x4){bflo(pv.x), bfhi(pv.x), bflo(pv.y), bfhi(pv.y)};
                    f32x4 o = c4 + mu4 * (p4 - c4);
                    if (lane < 16) {
#pragma unroll
                        for (int j = 0; j < 4; ++j) o[j] = 2.f * sigm(2.f * o[j]) - 1.f;
                    } else if (lane >= 32) {
#pragma unroll
                        for (int j = 0; j < 4; ++j) o[j] = sigm(o[j]);
                    }
                    pg8::u32x2 ou; ou.x = pk2(o[0], o[1]); ou.y = pk2(o[2], o[3]); *(pg8::u32x2*)(LA + (size_t)m * 256 + 4 * lane) = ou;
                }
                {
                    f32x4 ba, bb, ca, cb_, ha, hb; pg8::unpack8(r.b, ba, bb);
                    pg8::unpack8(r.c0, ca, cb_); pg8::unpack8(r.h0, ha, hb); const f32x4 u0a = ca * ha, u0b = cb_ * hb;
                    pg8::unpack8(r.c1, ca, cb_); pg8::unpack8(r.h1, ha, hb); const f32x4 u1a = ca * ha, u1b = cb_ * hb;
                    pg8::unpack8(r.c2, ca, cb_); pg8::unpack8(r.h2, ha, hb); const f32x4 u2a = ca * ha, u2b = cb_ * hb;
                    const f32x4 ya = ba * (w0a * u2a + w1a * u1a + w2a * u0a), yb = bb * (w0b * u2b + w1b * u1b + w2b * u0b);
                    *(pg8::u32x4*)(OB + (size_t)m * RW + 8 * lane) = pg8::pack8(ya, yb);
                }
            }
            __syncthreads();
            if (F.tid < 96) { const unsigned v = nrm[F.tid]; if (v) __hip_atomic_fetch_max(ctl + CW_NRM + 128 * l + F.tid, v, RLX_AGENT); }
        }
        GRID_BAR();
        {
            PH_BEGIN;
            pg8::Gemm g{LA, WL + (size_t)l * 1536 * 256, 0, nullptr}; pg8::StaticOrder S; S.init(M, 1536, NG, bx);
            pg8::EpiLora E{LW, LAO, LG, GIN(5) + (size_t)l * RW, GIN(7) + (size_t)l * RW};
            DUP(1) pg8::gemm_phase<pg8::EpiLora, pg8::StaticOrder, true, false, 256, 256, 256>(F.lds + RING_OFF, g, S, E);
        }
        GRID_BAR();
        {
            PH_BEGIN;
#define CK_TASK(it_) (((4 * (bx & 7) + ((((it_) * 32 + (bx >> 3))) >> 7)) << 7) + ((((it_) * 32 + (bx >> 3))) & 127))
            CkRaw raw; ck_load(raw, CK_TASK(0), F.wave, lane, Rr, LAO, LW, GIN(4) + (size_t)l * R_COLS, GIN(10) + (size_t)l * RW, GIN(11) + (size_t)l * RW, GIN(12) + (size_t)l * RW);
            for (int it = 0; it < 16; ++it)
                rwkv_chunk_local(F, CK_TASK(it), (it + 1 < 16) ? CK_TASK(it + 1) : -1, raw, Rr, LAO, LW, OA, BV, PMB, QMB, RHB, GIN(4) + (size_t)l * R_COLS, GIN(10) + (size_t)l * RW, GIN(11) + (size_t)l * RW, GIN(12) + (size_t)l * RW);
        }
        GRID_BAR();
        {
            PH_BEGIN;
            const int grp = bx & 7, jj = bx >> 3;
#if (PROBE_DUP >> 5) & 1
            if (jj < 4) rwkv_carry(F, grp * 4 + jj, PMB, QMB, (bf16*)outp);
#endif
            if (jj < 4) rwkv_carry(F, grp * 4 + jj, PMB, QMB, QMB);
#if (PROBE_DUP >> 15) & 1
            { const attn_orig::AttnTensors AT3{(const attn_orig::bf16*)FQ, (const attn_orig::bf16*)FK, (const attn_orig::bf16*)FV, (attn_orig::bf16*)outp};
              struct DynO { gu32* ctr; volatile LAS unsigned* slot; int grp;
                __device__ __forceinline__ bool next(int, attn_orig::AttnUnit& u) const { if (threadIdx.x == 0) slot[0] = __hip_atomic_fetch_add(ctr, 1u, RLX_AGENT); __syncthreads(); const unsigned v = slot[0]; __syncthreads(); if (v >= 128u) return false; u.qb = 31 - (int)(v >> 2); u.bh = grp * 4 + (int)(v & 3u); return true; }
                __device__ __forceinline__ void a_ready(const attn_orig::AttnUnit&) const {} __device__ __forceinline__ void done(const attn_orig::AttnUnit&) const {} };
              const DynO S3{ctl + CW_QATT + 512 + 1024 * l + 64 * grp, F.MISC + 0, grp};
              attn_orig::attn_phase<DynO, 8>((char*)lds + RING_OFF, AT3, S3); }
#endif
#if (PROBE_DUP >> 4) & 1
            { const attn_body::AttnTensors AT2{(const attn_body::bf16*)FQ, (const attn_body::bf16*)FK, (const attn_body::bf16*)FV, (attn_body::bf16*)outp, CB};
              const DynAttnOrder S2{ctl + CW_QATT + 512 + 1024 * l + 64 * grp, F.MISC + 0, grp};
              attn_body::attn_phase<DynAttnOrder, 24>((char*)lds + RING_OFF, AT2, S2); }
#endif
            const attn_body::AttnTensors AT{(const attn_body::bf16*)FQ, (const attn_body::bf16*)FK, (const attn_body::bf16*)FV, (attn_body::bf16*)FQ, CB};
            {
                volatile LAS unsigned* slot = F.MISC + 0; gu32* ctr0 = ctl + CW_QATT + 1024 * l;
                int cg = grp, tried = 0; unsigned pre = 0u; if (F.tid == 0) pre = __hip_atomic_fetch_add(ctr0 + 64 * cg, 1u, RLX_AGENT);
                for (;;) {
                    if (F.tid == 0) { slot[0] = pre; slot[3] = (unsigned)cg; }
                    __syncthreads(); const unsigned v = slot[0]; const int g = (int)slot[3];
                    if (v < 128u && F.tid < 128) { const int qb_ = 31 - (int)(v >> 2), bh_ = g * 4 + (int)(v & 3u); const float* cbh = CB + (size_t)bh_ * T;
                        const float q2 = __uint_as_float(__hip_atomic_load(ctl + CW_NRM + 128 * l + 3 * bh_, RLX_AGENT)), k2 = __uint_as_float(__hip_atomic_load(ctl + CW_NRM + 128 * l + 3 * bh_ + 1, RLX_AGENT)),
                                    dn = __uint_as_float(__hip_atomic_load(ctl + CW_NRM + 128 * l + 3 * bh_ + 2, RLX_AGENT));
                        const float thr = cbh[qb_ * 256] - (40.5f + 1.01f * (sqrtf(q2 * k2) + dn));
                        const bool sk = (F.tid < 4 * qb_) && (cbh[64 * F.tid + 63] < thr);
                        const unsigned long long bal = __ballot(sk);
                        if (F.lane == 0) slot[1 + F.wave] = (unsigned)__popcll(bal); }
                    __syncthreads();
                    if (v >= 128u) {
                        if (++tried == 8) break;
                        cg = (g + 1) & 7; if (F.tid == 0) pre = __hip_atomic_fetch_add(ctr0 + 64 * cg, 1u, RLX_AGENT);
                        continue; }
                    if (F.tid == 0) pre = __hip_atomic_fetch_add(ctr0 + 64 * g, 1u, RLX_AGENT);
                    const int qb = 31 - (int)(v >> 2), bh = g * 4 + (int)(v & 3u);
                    const int ts = (int)(slot[1] + slot[2]) & ~1;
                    attn_body::attn_unit<24>(bh / attn_body::NHEAD, bh % attn_body::NHEAD, qb, (const attn_body::bf16*)FQ, (const attn_body::bf16*)FK, (const attn_body::bf16*)FV, (attn_body::bf16*)FQ, CB + (size_t)bh * attn_body::SEQ, (char*)lds + RING_OFF, ts);
                }
            }
        }
        GRID_BAR();
        {
            PH_BEGIN;
            {
#define FX_PAIR(it_) (256 * (bx & 7) + (it_) * 32 + (bx >> 3))
                FxRaw fa, fb; fx_load(fa, FX_PAIR(0), F.wave, lane, RHB, QMB, OA, BV, LG);
#pragma unroll 1
                for (int it = 0; it < 8; it += 2) {
                    fx_load(fb, FX_PAIR(it + 1), F.wave, lane, RHB, QMB, OA, BV, LG);
                    rwkv_fixup(F, FX_PAIR(it), fa, OA, GIN(13) + (size_t)l * RW, GIN(14) + (size_t)l * RW);
                    if (it + 2 < 8) fx_load(fa, FX_PAIR(it + 2), F.wave, lane, RHB, QMB, OA, BV, LG);
                    rwkv_fixup(F, FX_PAIR(it + 1), fb, OA, GIN(13) + (size_t)l * RW, GIN(14) + (size_t)l * RW);
                }
            }
            pg8::Gemm g{X, WIN + ((size_t)l * INP_N + INA_N) * D, 0, nullptr}; pg8::StaticOrder S; S.init(M, 3 * D, NG, bx);
            pg8::EpiGate E{(unsigned char*)outp, (unsigned char*)(ws + WS_G2), GIN(17) + (size_t)l * 3 * D, (size_t)M * D};
            DUP(1) pg8::gemm_phase<pg8::EpiGate, pg8::StaticOrder, true, false, D, D, D>(F.lds + RING_OFF, g, S, E);
        }
        GRID_BAR();
        {
            PH_BEGIN;
            pg8::Gemm g{OA, WUP + (size_t)l * D * 3 * RW, 0, nullptr, (long)WS_OB - (long)WS_OA, (long)WS_FQ - (long)WS_OA}; pg8::StaticOrder S; S.init(M, D, NG, bx);
            pg8::EpiUp3 E{(const unsigned char*)outp, (const unsigned char*)(ws + WS_G2), (size_t)M * D, MG};
            DUP(9) pg8::gemm_phase<pg8::EpiUp3, pg8::StaticOrder, true, false, RW, 3 * RW, 3 * RW, true>(F.lds + RING_OFF, g, S, E);
        }
        GRID_BAR();
        {
            PH_BEGIN;
            pg8::Gemm g{MG, WOUT + (size_t)l * D * D, 0, nullptr}; pg8::StaticOrder S; S.init(M, D, NG, bx);
            pg8::EpiResid E{X, Y, DN_ALPHA};
            DUP(1) pg8::gemm_phase<pg8::EpiResid, pg8::StaticOrder, true, false, D, D, D>(F.lds + RING_OFF, g, S, E);
        }
        GRID_BAR();
        {
            PH_BEGIN;
            const float* g1 = GIN(22) + (size_t)l * D; const float* b1 = GIN(23) + (size_t)l * D;
            const bool moe = (l & 1) != 0;
            LAS float* rwl = (LAS float*)(F.lds + RING_OFF);
            if (moe) { for (int i = F.tid; i < D * NEXP / 4; i += NWAVES * 64) ((LAS f32x4*)rwl)[i] = ((const f32x4*)(GIN(29) + (size_t)(l >> 1) * D * NEXP))[i]; __syncthreads(); }
            LnGB q; ln_load_gb(q, g1, b1, lane); RowRaw nx; row_fetch(nx, Y + (size_t)gw * D, lane);
            float rbias[8];
#pragma unroll
            for (int e = 0; e < 8; ++e) rbias[e] = moe ? GIN(30)[(l >> 1) * NEXP + e] : 0.f;
            for (int dup_ = 0; dup_ < ((((PROBE_DUP) >> 7) & 1) && !moe ? 2 : 1); ++dup_) for (int m = gw; m < M; m += NGW) { f32x4 v[4]; row_unpack(nx, v);
                if (m + NGW < M) row_fetch(nx, Y + (size_t)(m + NGW) * D, lane);
                ln_norm_r(v, q); row_store_bf16(X + (size_t)m * D, v, lane);
                if (moe) {
                    float lgt[8];
#pragma unroll
                    for (int e = 0; e < 8; ++e) lgt[e] = 0.f;
#pragma unroll
                    for (int j = 0; j < 4; ++j)
#pragma unroll
                        for (int i = 0; i < 4; ++i) { const LAS f32x4* wp = (const LAS f32x4*)(rwl + (size_t)(4 * lane + 256 * j + i) * 8); const f32x4 wa = wp[0], wb = wp[1]; const float xv = v[j][i];
                            lgt[0] += xv * wa[0]; lgt[1] += xv * wa[1]; lgt[2] += xv * wa[2]; lgt[3] += xv * wa[3]; lgt[4] += xv * wb[0]; lgt[5] += xv * wb[1]; lgt[6] += xv * wb[2]; lgt[7] += xv * wb[3]; }
#pragma unroll
                    for (int e = 0; e < 8; ++e) lgt[e] = wave_sum(lgt[e]) + rbias[e];
                    if (lane == 0) {
                        int e1 = 0; float v1 = lgt[0];
#pragma unroll
                        for (int e = 1; e < 8; ++e) if (lgt[e] > v1) { v1 = lgt[e]; e1 = e; }
                        int e2 = -1; float v2 = -INFINITY;
#pragma unroll
                        for (int e = 0; e < 8; ++e) if (e != e1 && lgt[e] > v2) { v2 = lgt[e]; e2 = e; }
                        const float gA = 1.f / (1.f + __expf(v2 - v1));
                        TOKE[m] = (unsigned)e1 | ((unsigned)e2 << 8); TOKG[2 * m] = gA; TOKG[2 * m + 1] = 1.f - gA;
                        const int hf = m / MOE_HALF;
                        LAS unsigned* lc = (LAS unsigned*)(F.lds + LCNT_OFF); __hip_atomic_fetch_add(lc + hf * 8 + e1, 1u, __ATOMIC_RELAXED, __HIP_MEMORY_SCOPE_WORKGROUP); __hip_atomic_fetch_add(lc + hf * 8 + e2, 1u, __ATOMIC_RELAXED, __HIP_MEMORY_SCOPE_WORKGROUP);
                    }
                }
            }
            if (moe) {
                __syncthreads();
                if (F.tid < 16) { const unsigned cv = ((LAS unsigned*)(F.lds + LCNT_OFF))[F.tid]; if (cv) __hip_atomic_fetch_add(ctl + CW_CNT + 64 * F.tid, cv, RLX_AGENT); }
                LAS float* scr = (LAS float*)(F.lds + RING_OFF + 32768 + F.wave * 8448);
                const int li = l >> 1; constexpr int I_13 = (2 * DFFE / 32) * 16, I_2 = 32 * (DFFE / 64);
                DUP(2) for (int it = gw; it < NEXP * (I_13 + I_2); it += NGW) {
                    const int e = it / (I_13 + I_2); int r = it - e * (I_13 + I_2);
                    if (r < I_13) { const int rg = r >> 4, kb = r & 15, d0 = 32 * rg, tile = d0 >> 8, within = d0 & 255;
                        const float* W = ((within < 128) ? GIN(31) : GIN(32)) + ((size_t)li * NEXP + e) * D * DFFE;
                        tr_item(W, DFFE, 64 * kb, tile * 128 + (within & 127), 32, WM13 + ((size_t)e * 2 * DFFE + d0) * D, D, 64 * kb, 1.f, scr, lane); }
                    else { r -= I_13; const int rg = r / (DFFE / 64), kb = r % (DFFE / 64);
                        tr_item(GIN(33) + ((size_t)li * NEXP + e) * DFFE * D, D, 64 * kb, 32 * rg, 32, WM2 + ((size_t)e * D + 32 * rg) * DFFE, DFFE, 64 * kb, 1.f, scr, lane); }
                }
            }
        }
        GRID_BAR();
        if constexpr ((l & 1) == 0) {
            {
                PH_BEGIN;
                pg8::Gemm g{X, W13, 0, nullptr}; pg8::StaticOrder S; S.init(M, 2 * DFF, NG, bx);
                pg8::EpiSwiglu E{H, DFF};
                DUP(1) pg8::gemm_phase<pg8::EpiSwiglu, pg8::StaticOrder, true, false, D, D, D>(F.lds + RING_OFF, g, S, E);
            }
            GRID_BAR();
            {
                PH_BEGIN;
                pg8::Gemm g{H, W2, 0, nullptr}; pg8::StaticOrder S; S.init(M, D, NG, bx);
                pg8::EpiResid E{X, Y, DN_ALPHA};
#if defined(PROBE_ZERO_FFN) && (PROBE_ZERO_FFN & 1)
                E.zero = 1;
#endif
                DUP(1) pg8::gemm_phase<pg8::EpiResid, pg8::StaticOrder, true, false, DFF, DFF, DFF>(F.lds + RING_OFF, g, S, E);
            }
            GRID_BAR();
            {
                PH_BEGIN;
                const float* g2 = GIN(24) + (size_t)l * D; const float* b2 = GIN(25) + (size_t)l * D;
                LnGB q; ln_load_gb(q, g2, b2, lane); RowRaw nx; row_fetch(nx, Y + (size_t)gw * D, lane);
                DUP(7) for (int m = gw; m < M; m += NGW) { f32x4 v[4]; row_unpack(nx, v);
                    if (m + NGW < M) row_fetch(nx, Y + (size_t)(m + NGW) * D, lane);
                    ln_norm_r(v, q);
                    if (l == NLAYER - 1) { GAS f32x4* o = (GAS f32x4*)(outp + (size_t)m * D) + lane;
#pragma unroll
                        for (int j = 0; j < 4; ++j) o[64 * j] = v[j]; }
                    else row_store_bf16(X + (size_t)m * D, v, lane); }
            }
            GRID_BAR();
        } else {
            LAS int* moff = (LAS int*)((LAS unsigned char*)lds + MOFF_OFF);
            LAS int* pexp = (LAS int*)((LAS unsigned char*)lds + PEXP_OFF);
            { PH_BEGIN;
            if (F.tid < 2) { int o = 0; for (int e = 0; e < NEXP; ++e) { moff[F.tid * 9 + e] = o; const int c = (int)__hip_atomic_load(ctl + CW_CNT + 64 * (F.tid * 8 + e), RLX_AGENT); o += (c + 255) & ~255; } moff[F.tid * 9 + 8] = o; }
            __syncthreads();
            {
                const int m = F.vcu * (NWAVES * 64) + F.tid;
                LAS unsigned* lf = (LAS unsigned*)(F.lds + LFIL_OFF); LAS unsigned* lb = (LAS unsigned*)(F.lds + LBAS_OFF);
                unsigned te = 0u, rk0 = 0u, rk1 = 0u; int hf = 0;
                if (m < M) { hf = m / MOE_HALF; te = TOKE[m];
                    rk0 = __hip_atomic_fetch_add(lf + hf * 8 + (int)(te & 255u), 1u, __ATOMIC_RELAXED, __HIP_MEMORY_SCOPE_WORKGROUP);
                    rk1 = __hip_atomic_fetch_add(lf + hf * 8 + (int)((te >> 8) & 255u), 1u, __ATOMIC_RELAXED, __HIP_MEMORY_SCOPE_WORKGROUP); }
                __syncthreads();
                if (F.tid < 16) { const unsigned cv = lf[F.tid]; lb[F.tid] = cv ? __hip_atomic_fetch_add(ctl + CW_FILL + 64 * F.tid, cv, RLX_AGENT) : 0u; }
                __syncthreads();
                if (m < M) { const int e0 = (int)(te & 255u), e1 = (int)((te >> 8) & 255u);
                    const int p0 = moff[hf * 9 + e0] + (int)(lb[hf * 8 + e0] + rk0), p1 = moff[hf * 9 + e1] + (int)(lb[hf * 8 + e1] + rk1);
                    PPOS[2 * m] = (unsigned)p0; PPOS[2 * m + 1] = (unsigned)p1; RTOK[hf * MOE_ROWS + p0] = m; RTOK[hf * MOE_ROWS + p1] = m; }
                if (F.vcu >= 64 && F.vcu < 66) { const int hf = F.vcu - 64;
                    for (int e = 0; e < NEXP; ++e) { const int c = (int)__hip_atomic_load(ctl + CW_CNT + 64 * (hf * 8 + e), RLX_AGENT); const int p0 = moff[hf * 9 + e] + c, p1 = moff[hf * 9 + e + 1];
                        for (int p = p0 + F.tid; p < p1; p += NWAVES * 64) RTOK[hf * MOE_ROWS + p] = hf * MOE_HALF; } }
            } }
            GRID_BAR();
{ constexpr int hf = 0;

                const int npan = moff[hf * 9 + 8] >> 8;
                __syncthreads();
                int tp_ = threadIdx.x; asm volatile("" : "+v"(tp_));
                for (int p = tp_; p < npan; p += NWAVES * 64) { int e = 0;
#pragma unroll
                    for (int q = 1; q < NEXP; ++q) if (p * 256 >= moff[hf * 9 + q]) e = q;
                    pexp[p] = e; }
                __syncthreads();
                {
                    PH_BEGIN;
                    pg8::Gemm g{X, WM13, (size_t)2 * DFFE * D * 2, RTOK + hf * MOE_ROWS}; pg8::GroupedOrder S; S.so.init_tiles(npan, 2 * DFFE / 256, NG, bx); S.pexp = pexp;
                    pg8::EpiSwiglu E{HM, DFFE};
                    DUP(1) pg8::gemm_phase<pg8::EpiSwiglu, pg8::GroupedOrder, true, true, D, D, D>(F.lds + RING_OFF, g, S, E);
                }
                GRID_BAR();
                {
                    PH_BEGIN;
                    const int npm = npan < MOE_MAINP ? npan : MOE_MAINP;
                    pg8::Gemm g{HM, WM2, (size_t)D * DFFE * 2, nullptr}; pg8::GroupedOrder S; S.so.init_tiles(npm, D / 256, NG, bx); S.pexp = pexp;
                    pg8::EpiStore E{YP, D};
                    pg8::gemm_phase<pg8::EpiStore, pg8::GroupedOrder, true, false, DFFE, DFFE, DFFE>(F.lds + RING_OFF, g, S, E);
                    if (npan > MOE_MAINP) {
                        pg8::SliceOrder T{MOE_MAINP, npan - MOE_MAINP, D / 256, bx, (DFFE / 4) * 2, pexp};
                        pg8::EpiStore E2{YPS, D, MOE_MAINP, (DFFE / 4) * 2, (size_t)8 * 256 * D};
                        pg8::gemm_phase<pg8::EpiStore, pg8::SliceOrder, true, false, DFFE, DFFE, DFFE / 4>(F.lds + RING_OFF, g, T, E2);
                    }
                }
                GRID_BAR();
                {
                    PH_BEGIN;
                    const float* g2 = GIN(24) + (size_t)l * D; const float* b2 = GIN(25) + (size_t)l * D;
                    LnGB q; ln_load_gb(q, g2, b2, lane);
                    constexpr unsigned MAINR = (unsigned)(MOE_MAINP * 256);
                    unsigned np1 = PPOS[2 * (hf * MOE_HALF + gw)], np2 = PPOS[2 * (hf * MOE_HALF + gw) + 1]; float nga = TOKG[2 * (hf * MOE_HALF + gw)], ngb = TOKG[2 * (hf * MOE_HALF + gw) + 1];
                    RowRaw rx, ra, rc; unsigned p1 = np1, p2 = np2; float ga = nga, gb = ngb;
                    row_fetch(rx, X + (size_t)(hf * MOE_HALF + gw) * D, lane);
                    row_fetch(ra, (p1 < MAINR) ? YP + (size_t)p1 * D : YPS + (size_t)(p1 - MAINR) * D, lane); row_fetch(rc, (p2 < MAINR) ? YP + (size_t)p2 * D : YPS + (size_t)(p2 - MAINR) * D, lane);
                    if (gw + NGW < MOE_HALF) { const int m2 = hf * MOE_HALF + gw + NGW; np1 = PPOS[2 * m2]; np2 = PPOS[2 * m2 + 1]; nga = TOKG[2 * m2]; ngb = TOKG[2 * m2 + 1]; }
                    DUP(7) for (int mm = gw; mm < MOE_HALF; mm += NGW) { const int m = hf * MOE_HALF + mm;
                        f32x4 v[4], a[4], c[4]; row_unpack(rx, v); row_unpack(ra, a); row_unpack(rc, c);
                        const unsigned q1 = p1, q2 = p2; const float ha = ga, hb = gb;
                        if (q1 >= MAINR) { f32x4 t4[4];
#pragma unroll
                            for (int sl = 1; sl < 4; ++sl) { row_load_bf16(YPS + (size_t)sl * 8 * 256 * D + (size_t)(q1 - MAINR) * D, t4, lane);
#pragma unroll
                                for (int j = 0; j < 4; ++j) a[j] = a[j] + t4[j]; } }
                        if (q2 >= MAINR) { f32x4 t4[4];
#pragma unroll
                            for (int sl = 1; sl < 4; ++sl) { row_load_bf16(YPS + (size_t)sl * 8 * 256 * D + (size_t)(q2 - MAINR) * D, t4, lane);
#pragma unroll
                                for (int j = 0; j < 4; ++j) c[j] = c[j] + t4[j]; } }
                        if (mm + NGW < MOE_HALF) { const int m1 = m + NGW; p1 = np1; p2 = np2; ga = nga; gb = ngb;
                            row_fetch(rx, X + (size_t)m1 * D, lane);
                            row_fetch(ra, (p1 < MAINR) ? YP + (size_t)p1 * D : YPS + (size_t)(p1 - MAINR) * D, lane); row_fetch(rc, (p2 < MAINR) ? YP + (size_t)p2 * D : YPS + (size_t)(p2 - MAINR) * D, lane);
                            if (mm + 2 * NGW < MOE_HALF) { const int m2 = m + 2 * NGW; np1 = PPOS[2 * m2]; np2 = PPOS[2 * m2 + 1]; nga = TOKG[2 * m2]; ngb = TOKG[2 * m2 + 1]; } }
#pragma unroll
                        for (int j = 0; j < 4; ++j) v[j] = DN_ALPHA * v[j] + PROBE_MOE_SCALE * (ha * a[j] + hb * c[j]);
                        ln_norm_r(v, q);
                        if (l == NLAYER - 1) { GAS f32x4* o = (GAS f32x4*)(outp + (size_t)m * D) + lane;
#pragma unroll
                            for (int j = 0; j < 4; ++j) o[64 * j] = v[j]; }
                        else row_store_bf16(X + (size_t)m * D, v, lane); }
                }

}
{ constexpr int hf = 1;

                const int npan = moff[hf * 9 + 8] >> 8;
                __syncthreads();
                int tp_ = threadIdx.x; asm volatile("" : "+v"(tp_));
                for (int p = tp_; p < npan; p += NWAVES * 64) { int e = 0;
#pragma unroll
                    for (int q = 1; q < NEXP; ++q) if (p * 256 >= moff[hf * 9 + q]) e = q;
                    pexp[p] = e; }
                __syncthreads();
                {
                    PH_BEGIN;
                    pg8::Gemm g{X, WM13, (size_t)2 * DFFE * D * 2, RTOK + hf * MOE_ROWS}; pg8::GroupedOrder S; S.so.init_tiles(npan, 2 * DFFE / 256, NG, bx); S.pexp = pexp;
                    pg8::EpiSwiglu E{HM, DFFE};
                    DUP(1) pg8::gemm_phase<pg8::EpiSwiglu, pg8::GroupedOrder, true, true, D, D, D>(F.lds + RING_OFF, g, S, E);
                }
                GRID_BAR();
                {
                    PH_BEGIN;
                    const int npm = npan < MOE_MAINP ? npan : MOE_MAINP;
                    pg8::Gemm g{HM, WM2, (size_t)D * DFFE * 2, nullptr}; pg8::GroupedOrder S; S.so.init_tiles(npm, D / 256, NG, bx); S.pexp = pexp;
                    pg8::EpiStore E{YP, D};
                    pg8::gemm_phase<pg8::EpiStore, pg8::GroupedOrder, true, false, DFFE, DFFE, DFFE>(F.lds + RING_OFF, g, S, E);
                    if (npan > MOE_MAINP) {
                        pg8::SliceOrder T{MOE_MAINP, npan - MOE_MAINP, D / 256, bx, (DFFE / 4) * 2, pexp};
                        pg8::EpiStore E2{YPS, D, MOE_MAINP, (DFFE / 4) * 2, (size_t)8 * 256 * D};
                        pg8::gemm_phase<pg8::EpiStore, pg8::SliceOrder, true, false, DFFE, DFFE, DFFE / 4>(F.lds + RING_OFF, g, T, E2);
                    }
                }
                GRID_BAR();
                {
                    PH_BEGIN;
                    const float* g2 = GIN(24) + (size_t)l * D; const float* b2 = GIN(25) + (size_t)l * D;
                    LnGB q; ln_load_gb(q, g2, b2, lane);
                    constexpr unsigned MAINR = (unsigned)(MOE_MAINP * 256);
                    unsigned np1 = PPOS[2 * (hf * MOE_HALF + gw)], np2 = PPOS[2 * (hf * MOE_HALF + gw) + 1]; float nga = TOKG[2 * (hf * MOE_HALF + gw)], ngb = TOKG[2 * (hf * MOE_HALF + gw) + 1];
                    RowRaw rx, ra, rc; unsigned p1 = np1, p2 = np2; float ga = nga, gb = ngb;
                    row_fetch(rx, X + (size_t)(hf * MOE_HALF + gw) * D, lane);
                    row_fetch(ra, (p1 < MAINR) ? YP + (size_t)p1 * D : YPS + (size_t)(p1 - MAINR) * D, lane); row_fetch(rc, (p2 < MAINR) ? YP + (size_t)p2 * D : YPS + (size_t)(p2 - MAINR) * D, lane);
                    if (gw + NGW < MOE_HALF) { const int m2 = hf * MOE_HALF + gw + NGW; np1 = PPOS[2 * m2]; np2 = PPOS[2 * m2 + 1]; nga = TOKG[2 * m2]; ngb = TOKG[2 * m2 + 1]; }
                    DUP(7) for (int mm = gw; mm < MOE_HALF; mm += NGW) { const int m = hf * MOE_HALF + mm;
                        f32x4 v[4], a[4], c[4]; row_unpack(rx, v); row_unpack(ra, a); row_unpack(rc, c);
                        const unsigned q1 = p1, q2 = p2; const float ha = ga, hb = gb;
                        if (q1 >= MAINR) { f32x4 t4[4];
#pragma unroll
                            for (int sl = 1; sl < 4; ++sl) { row_load_bf16(YPS + (size_t)sl * 8 * 256 * D + (size_t)(q1 - MAINR) * D, t4, lane);
#pragma unroll
                                for (int j = 0; j < 4; ++j) a[j] = a[j] + t4[j]; } }
                        if (q2 >= MAINR) { f32x4 t4[4];
#pragma unroll
                            for (int sl = 1; sl < 4; ++sl) { row_load_bf16(YPS + (size_t)sl * 8 * 256 * D + (size_t)(q2 - MAINR) * D, t4, lane);
#pragma unroll
                                for (int j = 0; j < 4; ++j) c[j] = c[j] + t4[j]; } }
                        if (mm + NGW < MOE_HALF) { const int m1 = m + NGW; p1 = np1; p2 = np2; ga = nga; gb = ngb;
                            row_fetch(rx, X + (size_t)m1 * D, lane);
                            row_fetch(ra, (p1 < MAINR) ? YP + (size_t)p1 * D : YPS + (size_t)(p1 - MAINR) * D, lane); row_fetch(rc, (p2 < MAINR) ? YP + (size_t)p2 * D : YPS + (size_t)(p2 - MAINR) * D, lane);
                            if (mm + 2 * NGW < MOE_HALF) { const int m2 = m + 2 * NGW; np1 = PPOS[2 * m2]; np2 = PPOS[2 * m2 + 1]; nga = TOKG[2 * m2]; ngb = TOKG[2 * m2 + 1]; } }
#pragma unroll
                        for (int j = 0; j < 4; ++j) v[j] = DN_ALPHA * v[j] + PROBE_MOE_SCALE * (ha * a[j] + hb * c[j]);
                        ln_norm_r(v, q);
                        if (l == NLAYER - 1) { GAS f32x4* o = (GAS f32x4*)(outp + (size_t)m * D) + lane;
#pragma unroll
                            for (int j = 0; j < 4; ++j) o[64 * j] = v[j]; }
                        else row_store_bf16(X + (size_t)m * D, v, lane); }
                }

}

            if (l != NLAYER - 1) GRID_BAR();
        }

}

}

extern "C" void kernel_launch(void* const* d_in, const int* in_sizes, int n_in, void* d_out, int out_size, void* d_ws, size_t ws_size, hipStream_t stream) {
    static int grid = 0;
    if (grid == 0) {
        if (n_in != 34 || in_sizes[0] != M * D || out_size != M * D || ws_size < WS_END) { fprintf(stderr, "kernel_launch: unexpected shapes / workspace (n_in %d, in0 %d, out %d, ws %zu); nothing launched\n", n_in, n_in > 0 ? in_sizes[0] : -1, out_size, ws_size); grid = -1; return; }
        int dev = 0, cus = 0;
        if (hipGetDevice(&dev) != hipSuccess || hipDeviceGetAttribute(&cus, hipDeviceAttributeMultiprocessorCount, dev) != hipSuccess) { grid = -1; return; }
        if (hipFuncSetAttribute((const void*)mk_fwd, hipFuncAttributeMaxDynamicSharedMemorySize, LDS_BYTES) != hipSuccess) { fprintf(stderr, "kernel_launch: hipFuncSetAttribute failed\n"); grid = -1; return; }
        int per_cu = 0;
        if (hipOccupancyMaxActiveBlocksPerMultiprocessor(&per_cu, (const void*)mk_fwd, NWAVES * 64, LDS_BYTES) != hipSuccess || per_cu < 1) fprintf(stderr, "kernel_launch: occupancy query reports %d workgroups per CU\n", per_cu);
        (void)hipGetLastError();
        if (cus != 256) { fprintf(stderr, "kernel_launch: built for a 256-CU device, found %d; nothing launched\n", cus); grid = -1; return; }
        grid = 256;
    }
    if (grid < 0) return;
    if (hipMemsetAsync((char*)d_ws + WS_CTL, 0, CTL_ZERO_BYTES, stream) != hipSuccess) return;
    Args a{};
    for (int i = 0; i < 34; ++i) a.in[i] = (const float*)d_in[i];
    a.out = (float*)d_out; a.ws = (unsigned char*)d_ws;
    hipLaunchKernelGGL(mk_fwd, dim3(grid), dim3(NWAVES * 64), LDS_BYTES, stream, a);
}
```

```cpp
#define PROBE_DUP 0
#define PROBE_MOE_SCALE 1.f
#include <hip/hip_runtime.h>
#include <hip/hip_bf16.h>
#include <cstdio>
#include <cstdint>
#include <cmath>

namespace pg8 {
#define PG8_LAS __attribute__((address_space(3)))
typedef unsigned short bf16_t;
typedef short bf16x8 __attribute__((ext_vector_type(8)));
typedef float f32x4 __attribute__((ext_vector_type(4)));
typedef unsigned u32x4 __attribute__((ext_vector_type(4)));
typedef unsigned u32x2 __attribute__((ext_vector_type(2)));
constexpr int BM = 256, BK = 64, HALF = 128, HTB = HALF * BK * 2  , STAGE_BYTES = 8 * HTB, NXCD = 8, WGM = 8;

__host__ __device__ __forceinline__ int lds_byte(int r, int c) { const int st = (r >> 4) * 2 + (c >> 5), rr = r & 15, cc = c & 31, ob = rr * 64 + cc * 2; return st * 1024 + (ob ^ (((ob >> 9) & 1) << 5)); }
__host__ __device__ __forceinline__ void stage_rc(int b, int& R, int& C) { const int st = b / 1024, sb = b % 1024, swz = sb ^ (((sb >> 9) & 1) << 5); R = (st >> 1) * 16 + swz / 64; C = (st & 1) * 32 + (swz % 64) / 2; }
__host__ __device__ __forceinline__ int perm32(int rho) { const int n = rho >> 4, i = rho & 15; return 8 * (i >> 2) + 4 * n + (i & 3); }

struct Unit { int pm, pn, e, ko; };
struct Gemm { const bf16_t* A; const bf16_t* Bt; size_t bstride; const int* rows; long aseg1 = 0, aseg2 = 0; };

struct StaticOrder {
    int nM, nN, nwg, G, c;
    __host__ __device__ void init(int M, int N, int G_, int c_) { nM = M / BM; nN = N / BM; nwg = nM * nN; G = G_; c = c_; }
    __host__ __device__ void init_tiles(int nM_, int nN_, int G_, int c_) { nM = nM_; nN = nN_; nwg = nM * nN; G = G_; c = c_; }
    __host__ __device__ bool next(int i, Unit& u) const {
        const long L = (long)i * G + c; if (L >= nwg) return false;
        int wgid = (int)L; { const int q = nwg / NXCD, r = nwg % NXCD, xcd = wgid % NXCD, off = wgid / NXCD; wgid = (xcd < r ? xcd * (q + 1) : r * (q + 1) + (xcd - r) * q) + off; }
        const int nig = WGM * nN, gid = wgid / nig, fm = gid * WGM, gsz = (nM - fm) < WGM ? (nM - fm) : WGM;
        u.pm = fm + ((wgid % nig) % gsz); u.pn = (wgid % nig) / gsz; u.e = 0; u.ko = 0; return true;
    }
    __device__ __forceinline__ void a_ready(const Unit&) const {}
    __device__ __forceinline__ void done(const Unit&) const {}
};
struct GroupedOrder {
    StaticOrder so; const PG8_LAS int* pexp;
    __device__ __forceinline__ bool next(int i, Unit& u) const { if (!so.next(i, u)) return false; u.e = __builtin_amdgcn_readfirstlane(pexp[u.pm]); return true; }
    __device__ __forceinline__ void a_ready(const Unit&) const {}
    __device__ __forceinline__ void done(const Unit&) const {}
};

struct SliceOrder {
    int pm0, np, nN, c, kbytes; const PG8_LAS int* pexp;
    __device__ __forceinline__ bool next(int i, Unit& u) const { if (i != 0 || c >= np * nN * 4) return false; const int sl = c & 3, t = c >> 2; u.pn = t % nN; u.pm = pm0 + t / nN;
        u.e = __builtin_amdgcn_readfirstlane(pexp[u.pm]); u.ko = sl * kbytes; return true; }
    __device__ __forceinline__ void a_ready(const Unit&) const {}
    __device__ __forceinline__ void done(const Unit&) const {}
};

typedef float f32x2 __attribute__((ext_vector_type(2))); typedef __bf16 bf16x2v __attribute__((ext_vector_type(2)));
__device__ __forceinline__ unsigned cvt_pk_bf16(float lo, float hi) { const f32x2 v = {lo, hi}; return __builtin_bit_cast(unsigned, __builtin_convertvector(v, bf16x2v)); }
__device__ __forceinline__ float bf_lo(unsigned w) { return __builtin_bit_cast(float, w << 16); }
__device__ __forceinline__ float bf_hi(unsigned w) { return __builtin_bit_cast(float, w & 0xffff0000u); }
__device__ __forceinline__ float fsigmoid(float x) { return __builtin_amdgcn_rcpf(1.0f + __expf(-x)); }
__device__ __forceinline__ u32x4 pack8(const f32x4 v0, const f32x4 v1) { u32x4 w; w.x = cvt_pk_bf16(v0[0], v0[1]); w.y = cvt_pk_bf16(v0[2], v0[3]); w.z = cvt_pk_bf16(v1[0], v1[1]); w.w = cvt_pk_bf16(v1[2], v1[3]); return w; }
__device__ __forceinline__ void unpack8(const u32x4 w, f32x4& v0, f32x4& v1) { v0 = (f32x4){bf_lo(w.x), bf_hi(w.x), bf_lo(w.y), bf_hi(w.y)}; v1 = (f32x4){bf_lo(w.z), bf_hi(w.z), bf_lo(w.w), bf_hi(w.w)}; }

#define PG8_EPI_LOOP_BEGIN \
    _Pragma("unroll") for (int ai = 0; ai < 2; ++ai) _Pragma("unroll") for (int m = 0; m < 4; ++m) { const int row = row0 + ai * HALF + m * 16; \
    _Pragma("unroll") for (int bj = 0; bj < 2; ++bj) { const int lc = lcol + bj * HALF; f32x4 v0 = acc[ai][bj][m][0], v1 = acc[ai][bj][m][1];
#define PG8_EPI_LOOP_END } }

struct EpiInA {
    static constexpr bool PERM = true, AFTER_DRAIN = false;
    bf16_t *R, *C, *Fq; float* FL; size_t fstride;
    __device__ __forceinline__ void operator()(const f32x4 (&acc)[2][2][4][2], const Unit& u, int wr, int wc, int fr, int fq) const {
        const int pn = u.pn, row0 = u.pm * BM + wr * 64 + fr, lcol = wc * 32 + 8 * fq;
        bf16_t* base; int ldc, colt;
        if (pn < 7) {
            PG8_EPI_LOOP_BEGIN
                *(u32x4*)(R + (size_t)row * 1792 + pn * 256 + lc) = pack8(v0, v1);
            PG8_EPI_LOOP_END
            return;
        }
        else if (pn < 9) { base = C; ldc = 1024; colt = (pn - 7) * 256; }
        else if (pn < 13) {
#pragma unroll
            for (int ai = 0; ai < 2; ++ai)
#pragma unroll
                for (int m = 0; m < 4; ++m) { const int row = row0 + ai * HALF + m * 16;
                    *(u32x4*)(C + (size_t)row * 1024 + 512 + (pn - 9) * 128 + lcol) = pack8(acc[ai][0][m][0] * acc[ai][1][m][0], acc[ai][0][m][1] * acc[ai][1][m][1]); }
            return;
        }
        else if (pn < 19) { const int q = pn - 13; base = C + ((size_t)(Fq - C) + (size_t)(q >> 1) * fstride); ldc = 512; colt = (q & 1) * 256; }
        else {
            if (wc == 0 && fq == 0) {
#pragma unroll
                for (int ai = 0; ai < 2; ++ai)
#pragma unroll
                    for (int m = 0; m < 4; ++m) { float* p = FL + (size_t)(row0 + ai * HALF + m * 16) * 8; *(f32x4*)p = acc[ai][0][m][0]; *(f32x4*)(p + 4) = acc[ai][0][m][1]; }
            }
            return;
        }
        PG8_EPI_LOOP_BEGIN
            *(u32x4*)(base + (size_t)row * ldc + colt + lc) = pack8(v0, v1);
        PG8_EPI_LOOP_END
    }
};
struct EpiLora {
    static constexpr bool PERM = true, AFTER_DRAIN = false;
    float* LW; bf16_t *LAo, *LG; const float *w0, *a0;
    __device__ __forceinline__ void operator()(const f32x4 (&acc)[2][2][4][2], const Unit& u, int wr, int wc, int fr, int fq) const {
        const int pn = u.pn, row0 = u.pm * BM + wr * 64 + fr, lcol = wc * 32 + 8 * fq, colt = (pn & 1) * 256;
        if (pn < 4) {
            const float* bp = ((pn < 2) ? w0 : a0) + colt + lcol; f32x4 bb[2][2];
#pragma unroll
            for (int bj = 0; bj < 2; ++bj) { bb[bj][0] = *(const f32x4*)(bp + bj * HALF); bb[bj][1] = *(const f32x4*)(bp + bj * HALF + 4); }
            if (pn < 2) {
                PG8_EPI_LOOP_BEGIN
                    const int c = colt + lc; f32x4 o0, o1;
#pragma unroll
                    for (int j = 0; j < 4; ++j) { o0[j] = -0.6065306597126334f * fsigmoid(v0[j] + bb[bj][0][j]); o1[j] = -0.6065306597126334f * fsigmoid(v1[j] + bb[bj][1][j]); }
                    float* p = LW + (size_t)row * 512 + c; *(f32x4*)p = o0; *(f32x4*)(p + 4) = o1;
                PG8_EPI_LOOP_END
            } else {
                PG8_EPI_LOOP_BEGIN
                    const int c = colt + lc;
#pragma unroll
                    for (int j = 0; j < 4; ++j) { v0[j] = fsigmoid(v0[j] + bb[bj][0][j]); v1[j] = fsigmoid(v1[j] + bb[bj][1][j]); }
                    *(u32x4*)(LAo + (size_t)row * 512 + c) = pack8(v0, v1);
                PG8_EPI_LOOP_END
            }
        } else {
            PG8_EPI_LOOP_BEGIN
                *(u32x4*)(LG + (size_t)row * 512 + colt + lc) = pack8(v0, v1);
            PG8_EPI_LOOP_END
        }
    }
};
struct EpiGate {
    static constexpr bool PERM = true, AFTER_DRAIN = false;
    unsigned char *G01, *G2; const float* bg; size_t gstride;
    __device__ __forceinline__ static unsigned q8x4(const f32x4 v) { unsigned w = 0u;
#pragma unroll
        for (int j = 0; j < 4; ++j) w = __builtin_amdgcn_cvt_pk_u8_f32(fmaxf(v[j] * 255.f, 1.f), (unsigned)j, w);
        return w; }
    __device__ __forceinline__ void operator()(const f32x4 (&acc)[2][2][4][2], const Unit& u, int wr, int wc, int fr, int fq) const {
        const int pn = u.pn, gi = pn >> 2, lcol = wc * 32 + 8 * fq, colt = (pn & 3) * 256, tid = (wr * 4 + wc) * 64 + fq * 16 + fr;
        unsigned char* base = G01 + (size_t)gi * gstride; if (gi == 2) base = G2; const float* bp = bg + gi * 1024 + colt + lcol;
        base += (size_t)(u.pm * 4 + (pn & 3)) * 65536 + (size_t)tid * 8;
        f32x4 bb[2][2];
#pragma unroll
        for (int bj = 0; bj < 2; ++bj) { bb[bj][0] = *(const f32x4*)(bp + bj * HALF); bb[bj][1] = *(const f32x4*)(bp + bj * HALF + 4); }
#pragma unroll
        for (int ai = 0; ai < 2; ++ai)
#pragma unroll
            for (int m = 0; m < 4; ++m)
#pragma unroll
                for (int bj = 0; bj < 2; ++bj) { f32x4 v0 = acc[ai][bj][m][0], v1 = acc[ai][bj][m][1];
#pragma unroll
                    for (int j = 0; j < 4; ++j) { v0[j] = fsigmoid(v0[j] + bb[bj][0][j]); v1[j] = fsigmoid(v1[j] + bb[bj][1][j]); }
                    u32x2 w; w.x = q8x4(v0); w.y = q8x4(v1); *(u32x2*)(base + ((ai * 4 + m) * 2 + bj) * 4096) = w; }
    }
};
struct EpiUp {
    static constexpr bool PERM = true, AFTER_DRAIN = false;
    const bf16_t* G; bf16_t* MG; int accum; int accum_id;
    __device__ __forceinline__ void operator()(const f32x4 (&acc)[2][2][4][2], const Unit& u, int wr, int wc, int fr, int fq) const {
        const int row0 = u.pm * BM + wr * 64 + fr, lcol = wc * 32 + 8 * fq, colt = u.pn * 256;
        PG8_EPI_LOOP_BEGIN
            const size_t off = (size_t)row * 1024 + colt + lc; f32x4 g0, g1; unpack8(*(const u32x4*)(G + off), g0, g1);
            v0 = v0 * g0; v1 = v1 * g1;
#ifdef PROBE_ZERO_BR
            if ((PROBE_ZERO_BR >> accum_id) & 1) { v0 = v0 * 0.f; v1 = v1 * 0.f; }
#endif
            if (accum) { f32x4 p0, p1; unpack8(*(const u32x4*)(MG + off), p0, p1); v0 = v0 + p0; v1 = v1 + p1; }
            *(u32x4*)(MG + off) = pack8(v0, v1);
        PG8_EPI_LOOP_END
    }
};
struct EpiUp3 {
    static constexpr bool PERM = true, AFTER_DRAIN = false;
    const unsigned char *G01, *G2; size_t gstride; bf16_t* MG;
    __device__ __forceinline__ const unsigned char* gtile(int gi, const Unit& u, int tid) const {
        const unsigned char* b = G01 + (size_t)gi * gstride; if (gi == 2) b = G2; return b + (size_t)(u.pm * 4 + u.pn) * 65536 + (size_t)tid * 8; }
    __device__ __forceinline__ static void unq8(const u32x2 w, f32x4& a0, f32x4& a1) {
        a0 = (f32x4){(float)((w.x >> 0) & 0xffu), (float)((w.x >> 8) & 0xffu), (float)((w.x >> 16) & 0xffu), (float)((w.x >> 24) & 0xffu)};
        a1 = (f32x4){(float)((w.y >> 0) & 0xffu), (float)((w.y >> 8) & 0xffu), (float)((w.y >> 16) & 0xffu), (float)((w.y >> 24) & 0xffu)}; }
    __device__ __forceinline__ void rescale(f32x4 (&acc)[2][2][4][2], const Unit& u, int wr, int wc, int fr, int fq, int s) const {
        const int tid = (wr * 4 + wc) * 64 + fq * 16 + fr; const unsigned char* pa = gtile(s - 1, u, tid); const unsigned char* pb = gtile(s, u, tid);
#pragma unroll
        for (int ai = 0; ai < 2; ++ai) { u32x2 ra[4][2], rb[4][2];
#pragma unroll
            for (int m = 0; m < 4; ++m)
#pragma unroll
                for (int bj = 0; bj < 2; ++bj) { const int e = ((ai * 4 + m) * 2 + bj) * 4096; ra[m][bj] = *(const u32x2*)(pa + e); rb[m][bj] = *(const u32x2*)(pb + e); }
#pragma unroll
            for (int m = 0; m < 4; ++m)
#pragma unroll
                for (int bj = 0; bj < 2; ++bj) { f32x4 a0, a1, b0, b1; unq8(ra[m][bj], a0, a1); unq8(rb[m][bj], b0, b1);
#pragma unroll
                    for (int j = 0; j < 4; ++j) { acc[ai][bj][m][0][j] *= a0[j] * __builtin_amdgcn_rcpf(b0[j]); acc[ai][bj][m][1][j] *= a1[j] * __builtin_amdgcn_rcpf(b1[j]); } } }
    }
    __device__ __forceinline__ void operator()(const f32x4 (&acc)[2][2][4][2], const Unit& u, int wr, int wc, int fr, int fq) const {
        const int row0 = u.pm * BM + wr * 64 + fr, lcol = wc * 32 + 8 * fq, colt = u.pn * 256, tid = (wr * 4 + wc) * 64 + fq * 16 + fr; const unsigned char* pg = gtile(2, u, tid);
#pragma unroll
        for (int ai = 0; ai < 2; ++ai) { u32x2 rg[4][2];
#pragma unroll
            for (int m = 0; m < 4; ++m)
#pragma unroll
                for (int bj = 0; bj < 2; ++bj) rg[m][bj] = *(const u32x2*)(pg + ((ai * 4 + m) * 2 + bj) * 4096);
#pragma unroll
            for (int m = 0; m < 4; ++m)
#pragma unroll
                for (int bj = 0; bj < 2; ++bj) { const int row = row0 + ai * HALF + m * 16, lc = lcol + bj * HALF; f32x4 v0 = acc[ai][bj][m][0], v1 = acc[ai][bj][m][1], g0, g1; unq8(rg[m][bj], g0, g1);
#pragma unroll
                    for (int j = 0; j < 4; ++j) { v0[j] *= g0[j] * (1.f / 255.f); v1[j] *= g1[j] * (1.f / 255.f); }
                    *(u32x4*)(MG + (size_t)row * 1024 + colt + lc) = pack8(v0, v1); } }
    }
};
struct EpiSink {
    static constexpr bool PERM = true, AFTER_DRAIN = false;
    float* O;
    __device__ __forceinline__ void operator()(const f32x4 (&acc)[2][2][4][2], const Unit& u, int wr, int wc, int fr, int fq) const {
        float s = 0.f;
#pragma unroll
        for (int ai = 0; ai < 2; ++ai)
#pragma unroll
            for (int m = 0; m < 4; ++m)
#pragma unroll
                for (int bj = 0; bj < 2; ++bj) { const f32x4 v0 = acc[ai][bj][m][0], v1 = acc[ai][bj][m][1]; s += (v0[0] + v0[1]) + (v0[2] + v0[3]) + (v1[0] + v1[1]) + (v1[2] + v1[3]); }
        if (s == 1.2345678e33f) O[(u.pm * 64 + u.pn) & 1023] = s;
    }
};
struct EpiResid {
    static constexpr bool PERM = true, AFTER_DRAIN = false;
    const bf16_t* X; bf16_t* Y; float alpha; int zero = 0;
    __device__ __forceinline__ void operator()(const f32x4 (&acc)[2][2][4][2], const Unit& u, int wr, int wc, int fr, int fq) const {
        const int row0 = u.pm * BM + wr * 64 + fr, lcol = wc * 32 + 8 * fq, colt = u.pn * 256;
#pragma unroll
        for (int ai = 0; ai < 2; ++ai) { u32x4 xr[4][2];
#pragma unroll
            for (int m = 0; m < 4; ++m)
#pragma unroll
                for (int bj = 0; bj < 2; ++bj) xr[m][bj] = *(const u32x4*)(X + (size_t)(row0 + ai * HALF + m * 16) * 1024 + colt + lcol + bj * HALF);
#pragma unroll
            for (int m = 0; m < 4; ++m)
#pragma unroll
                for (int bj = 0; bj < 2; ++bj) { const size_t off = (size_t)(row0 + ai * HALF + m * 16) * 1024 + colt + lcol + bj * HALF; f32x4 v0 = acc[ai][bj][m][0], v1 = acc[ai][bj][m][1], x0, x1; unpack8(xr[m][bj], x0, x1);
                    if (zero) { v0 = v0 * 0.f; v1 = v1 * 0.f; }
                    v0 = v0 + alpha * x0; v1 = v1 + alpha * x1;
                    *(u32x4*)(Y + off) = pack8(v0, v1); } }
    }
};
struct EpiSwiglu {
    static constexpr bool PERM = true, AFTER_DRAIN = false;
    bf16_t* H; int ldh;
    __device__ __forceinline__ void operator()(const f32x4 (&acc)[2][2][4][2], const Unit& u, int wr, int wc, int fr, int fq) const {
        const int row0 = u.pm * BM + wr * 64 + fr, lcol = wc * 32 + 8 * fq, colt = u.pn * 128;
#pragma unroll
        for (int ai = 0; ai < 2; ++ai)
#pragma unroll
            for (int m = 0; m < 4; ++m) { const int row = row0 + ai * HALF + m * 16;
                f32x4 a0 = acc[ai][0][m][0], a1 = acc[ai][0][m][1]; const f32x4 b0 = acc[ai][1][m][0], b1 = acc[ai][1][m][1];
#pragma unroll
                for (int j = 0; j < 4; ++j) { a0[j] = a0[j] * fsigmoid(a0[j]) * b0[j]; a1[j] = a1[j] * fsigmoid(a1[j]) * b1[j]; }
                *(u32x4*)(H + (size_t)row * ldh + colt + lcol) = pack8(a0, a1); }
    }
};
struct EpiStore {
    static constexpr bool PERM = true, AFTER_DRAIN = false;
    bf16_t* O; int ldc; int pm0 = 0, kbytes = 1; size_t sstride = 0;
    __device__ __forceinline__ void operator()(const f32x4 (&acc)[2][2][4][2], const Unit& u, int wr, int wc, int fr, int fq) const {
        const int row0 = (u.pm - pm0) * BM + wr * 64 + fr, lcol = wc * 32 + 8 * fq, colt = u.pn * 256;
        bf16_t* Ob = O + (size_t)(u.ko / kbytes) * sstride;
        PG8_EPI_LOOP_BEGIN
            *(u32x4*)(Ob + (size_t)row * ldc + colt + lc) = pack8(v0, v1);
        PG8_EPI_LOOP_END
    }
};

__device__ __forceinline__ void glds16s(const char* sbase, unsigned voff, unsigned lds_dst) { unsigned keep;
    asm volatile("s_nop 4\n\ts_mov_b32 %0, m0\n\ts_mov_b32 m0, %3\n\ts_nop 0\n\tglobal_load_lds_dwordx4 %1, %2\n\ts_mov_b32 m0, %0" : "=&s"(keep) : "v"(voff), "s"(sbase), "s"(lds_dst) : "memory"); }
__device__ __forceinline__ void glds16s_fast(const char* sbase, unsigned voff, unsigned lds_dst) { unsigned keep;
    asm volatile("s_mov_b32 %0, m0\n\ts_mov_b32 m0, %3\n\ts_nop 0\n\tglobal_load_lds_dwordx4 %1, %2\n\ts_mov_b32 m0, %0" : "=&s"(keep) : "v"(voff), "s"(sbase), "s"(lds_dst) : "memory"); }
__device__ __forceinline__ void glds16s_pair(const char* sbase, unsigned voff0, unsigned voff1, unsigned lds_dst) {
    asm volatile("s_mov_b32 m0, %3\n\ts_nop 0\n\tglobal_load_lds_dwordx4 %0, %2\n\ts_add_u32 m0, m0, 0x2000\n\ts_nop 0\n\tglobal_load_lds_dwordx4 %1, %2" :: "v"(voff0), "v"(voff1), "s"(sbase), "s"(lds_dst) : "memory", "m0", "scc"); }
template <class Epi, class Sched, bool ALIGN_EPI, bool GATHER, int LDA, int LDB, int KDIM, bool SEG3 = false, int PMODE = 0>
__device__ __forceinline__ void gemm_phase(PG8_LAS unsigned char* lds, const Gemm g, const Sched& S, const Epi& E) {
    int tid_ = threadIdx.x; asm volatile("" : "+v"(tid_));
    const int tid = tid_, wid = __builtin_amdgcn_readfirstlane(tid >> 6), lane = tid & 63, wr = wid >> 2, wc = wid & 3, fr = lane & 15, fq = lane >> 4;
    constexpr int K = KDIM, nt = K / BK;
    unsigned voffA[2], voffB[2]; int rowA[2]; unsigned colA2[2];
#pragma unroll
    for (int i = 0; i < 2; ++i) { int R, C; stage_rc(tid * 16 + i * 8192, R, C); const int Rb = Epi::PERM ? ((R & ~31) + perm32(R & 31)) : R;
        rowA[i] = R; colA2[i] = (unsigned)C * 2u; voffA[i] = (unsigned)(R * LDA + C) * 2u; voffB[i] = (unsigned)(Rb * LDB + C) * 2u; }
    const size_t kstep = (size_t)(BK * 2);
    const unsigned hstepA = (unsigned)HALF * (unsigned)LDA * 2u;
    const size_t hstepB = (size_t)HALF * LDB * 2;
    const size_t tstepA = 2 * (size_t)hstepA, tstepB = 2 * hstepB;
    long adj1 = 0, adj2 = 0; if constexpr (SEG3) { static_assert(KDIM == 24 * BK && !GATHER, "SEG3: three segments of 8 K-tiles"); adj1 = g.aseg1 - 8 * (long)kstep; adj2 = g.aseg2 - 16 * (long)kstep; }
#define PG8_ADJ(tt) (SEG3 ? ((tt) >= 16 ? adj2 : ((tt) >= 8 ? adj1 : 0L)) : 0L)
    const unsigned ldsw = (unsigned)wid * 1024u;
    const unsigned ldsb = (unsigned)(uintptr_t)lds;
    const int aoff = lds_byte(wr * 64 + fr, fq * 8), boff = lds_byte(wc * 32 + fr, fq * 8);
#define PG8_SA(b, h) (((b) * 2 + (h)) * HTB)
#define PG8_SB(b, h) ((4 + (b) * 2 + (h)) * HTB)
#define PG8_STAGE(bufoff, gbase, voff) do { if constexpr (PMODE == 2) break; const char* sb_ = (const char*)(gbase); const unsigned l0_ = ldsb + (unsigned)(bufoff) + ldsw; \
        glds16s_pair(sb_, (voff)[0], (voff)[1], l0_); } while (0)
#define PG8_STAGE_A(bufoff, kbase, h, GO) do { if constexpr (GATHER) PG8_STAGE(bufoff, kbase, GO[h]); else PG8_STAGE(bufoff, (kbase) + (size_t)(h) * hstepA, voffA); } while (0)
#define PG8_LDA(dst, b, h) do { _Pragma("unroll") for (int m = 0; m < 4; ++m) _Pragma("unroll") for (int k = 0; k < 2; ++k) dst[m][k] = *(const PG8_LAS bf16x8*)(lds + PG8_SA(b, h) + aoff + m * 2048 + k * 1024); } while (0)
#define PG8_LDB(dst, b, h) do { _Pragma("unroll") for (int n = 0; n < 2; ++n) _Pragma("unroll") for (int k = 0; k < 2; ++k) dst[n][k] = *(const PG8_LAS bf16x8*)(lds + PG8_SB(b, h) + boff + n * 2048 + k * 1024); } while (0)
#define PG8_MMA(ai, bj, At, Bt) do { if constexpr (PMODE == 1) { _Pragma("unroll") for (int m = 0; m < 4; ++m) _Pragma("unroll") for (int k = 0; k < 2; ++k) { asm volatile("" :: "v"(At[m][k])); } _Pragma("unroll") for (int n = 0; n < 2; ++n) _Pragma("unroll") for (int k = 0; k < 2; ++k) { asm volatile("" :: "v"(Bt[n][k])); } break; } __builtin_amdgcn_s_setprio(1); _Pragma("unroll") for (int m = 0; m < 4; ++m) _Pragma("unroll") for (int n = 0; n < 2; ++n) _Pragma("unroll") for (int k = 0; k < 2; ++k) \
        acc[ai][bj][m][n] = __builtin_amdgcn_mfma_f32_16x16x32_bf16(Bt[n][k], At[m][k], acc[ai][bj][m][n], 0, 0, 0); __builtin_amdgcn_s_setprio(0); } while (0)
#define PG8_WAIT_V(n) asm volatile("s_waitcnt vmcnt(" #n ")" ::: "memory")
#define PG8_WAIT_L(n) asm volatile("s_waitcnt lgkmcnt(" #n ")" ::: "memory")
#define PG8_BAR __builtin_amdgcn_s_barrier()
#define PG8_SCHED __builtin_amdgcn_sched_barrier(0)
#define PG8_SETGO(go, u) do { _Pragma("unroll") for (int _h = 0; _h < 2; ++_h) _Pragma("unroll") for (int _i = 0; _i < 2; ++_i) { \
        if constexpr (GATHER) { const int _tok = g.rows[(u).pm * BM + _h * HALF + rowA[_i]]; go[_h][_i] = (unsigned)_tok * (unsigned)(LDA * 2) + colA2[_i]; asm volatile("" : "+v"(go[_h][_i])); } \
        else go[_h][_i] = 0u; } } while (0)
    Unit cur, nxt; int ui = 0;
    if (!S.next(0, cur)) return;
    f32x4 acc[2][2][4][2];
    bf16x8 At[4][2], B0[2][2], B1[2][2];
    unsigned goC[2][2], goN[2][2];
    PG8_SETGO(goC, cur);
    const char* cA = GATHER ? (const char*)g.A : (const char*)g.A + (size_t)cur.pm * tstepA + cur.ko;
    const char* cB = (const char*)g.Bt + (size_t)cur.e * g.bstride + (size_t)cur.pn * tstepB + cur.ko;
    S.a_ready(cur);
    PG8_STAGE(PG8_SB(0, 0), cB, voffB); PG8_STAGE(PG8_SB(0, 1), cB + hstepB, voffB); PG8_STAGE_A(PG8_SA(0, 0), cA, 0, goC); PG8_STAGE_A(PG8_SA(0, 1), cA, 1, goC);
    if (wr == 1) PG8_BAR;
    PG8_WAIT_V(2); PG8_BAR;
    PG8_STAGE(PG8_SB(1, 0), cB + kstep, voffB); PG8_STAGE_A(PG8_SA(1, 0), cA + kstep, 0, goC); PG8_STAGE(PG8_SB(1, 1), cB + hstepB + kstep, voffB);
    PG8_WAIT_V(6); PG8_BAR;
#pragma unroll
    for (int a = 0; a < 2; ++a)
#pragma unroll
        for (int b = 0; b < 2; ++b)
#pragma unroll
            for (int m = 0; m < 4; ++m)
#pragma unroll
                for (int n = 0; n < 2; ++n) acc[a][b][m][n] = (f32x4){0.f, 0.f, 0.f, 0.f};
    for (;;) {
        const bool has_next = S.next(ui + 1, nxt);
        const char* nA = cA; const char* nB = cB;
        if (has_next) { PG8_SETGO(goN, nxt); nA = GATHER ? (const char*)g.A : (const char*)g.A + (size_t)nxt.pm * tstepA + nxt.ko; nB = (const char*)g.Bt + (size_t)nxt.e * g.bstride + (size_t)nxt.pn * tstepB + nxt.ko; }
        else {
#pragma unroll
            for (int h = 0; h < 2; ++h)
#pragma unroll
                for (int i = 0; i < 2; ++i) goN[h][i] = goC[h][i]; }
        for (int t = 0; t < nt; t += 2) {
            const bool last = (t == nt - 2);
            if constexpr (SEG3) { if (t == 8 || t == 16) E.rescale(acc, cur, wr, wc, fr, fq, t >> 3); }
            const char* a1 = cA + (size_t)(t + 1) * kstep + PG8_ADJ(t + 1);
            const char* a2 = last ? nA : cA + (size_t)(t + 2) * kstep + PG8_ADJ(t + 2); const char* b2 = last ? nB : cB + (size_t)(t + 2) * kstep;
            const char* a3 = a2 + kstep; const char* b3 = b2 + kstep;
            unsigned g2[2][2];
#pragma unroll
            for (int h = 0; h < 2; ++h)
#pragma unroll
                for (int i = 0; i < 2; ++i) g2[h][i] = (GATHER && last) ? goN[h][i] : goC[h][i];
            if (last && has_next) S.a_ready(nxt);
            PG8_LDB(B0, 0, 0); PG8_LDB(B1, 0, 1); PG8_SCHED; PG8_LDA(At, 0, 0); PG8_STAGE_A(PG8_SA(1, 1), a1, 1, goC);
            PG8_WAIT_V(8); PG8_WAIT_L(0); PG8_BAR; PG8_MMA(0, 0, At, B0); PG8_MMA(0, 1, At, B1); PG8_BAR; PG8_SCHED;
            PG8_LDA(At, 0, 1); PG8_STAGE(PG8_SB(0, 0), b2, voffB); PG8_STAGE(PG8_SB(0, 1), b2 + hstepB, voffB); PG8_STAGE_A(PG8_SA(0, 0), a2, 0, g2);
            PG8_WAIT_V(8); PG8_WAIT_L(0); PG8_BAR; PG8_MMA(1, 0, At, B0); PG8_MMA(1, 1, At, B1); PG8_BAR; PG8_SCHED;
            PG8_LDB(B0, 1, 0); PG8_LDB(B1, 1, 1); PG8_SCHED; PG8_LDA(At, 1, 0); PG8_STAGE_A(PG8_SA(0, 1), a2, 1, g2);
            PG8_WAIT_V(8); PG8_WAIT_L(0); PG8_BAR; PG8_MMA(0, 0, At, B0); PG8_MMA(0, 1, At, B1); PG8_BAR; PG8_SCHED;
            PG8_LDA(At, 1, 1); PG8_STAGE(PG8_SB(1, 0), b3, voffB); PG8_STAGE(PG8_SB(1, 1), b3 + hstepB, voffB); PG8_STAGE_A(PG8_SA(1, 0), a3, 0, g2);
            PG8_WAIT_V(8); PG8_WAIT_L(0); PG8_BAR; PG8_MMA(1, 0, At, B0); PG8_MMA(1, 1, At, B1); PG8_BAR; PG8_SCHED;
        }
        if constexpr (ALIGN_EPI) { if (wr == 0) PG8_BAR; }
        E(acc, cur, wr, wc, fr, fq); S.done(cur);
        if (!has_next) break;
#pragma unroll
        for (int a = 0; a < 2; ++a)
#pragma unroll
            for (int b = 0; b < 2; ++b)
#pragma unroll
                for (int m = 0; m < 4; ++m)
#pragma unroll
                    for (int n = 0; n < 2; ++n) acc[a][b][m][n] = (f32x4){0.f, 0.f, 0.f, 0.f};
        cur = nxt; cA = nA; cB = nB; ++ui;
#pragma unroll
        for (int h = 0; h < 2; ++h)
#pragma unroll
            for (int i = 0; i < 2; ++i) goC[h][i] = goN[h][i];
        if constexpr (ALIGN_EPI) { if (wr == 1) PG8_BAR; }
    }
    PG8_WAIT_V(0);
    if constexpr (!ALIGN_EPI) { if (wr == 0) PG8_BAR; }
    PG8_BAR;
#undef PG8_SA
#undef PG8_SB
#undef PG8_STAGE
#undef PG8_STAGE_A
#undef PG8_LDA
#undef PG8_LDB
#undef PG8_MMA
#undef PG8_WAIT_V
#undef PG8_WAIT_L
#undef PG8_BAR
#undef PG8_SCHED
#undef PG8_SETGO
#undef PG8_ADJ
}
}
#include <hip/hip_bf16.h>
#include <cmath>
namespace attn_body {
using bf16=__hip_bfloat16;
using bf16x8=__attribute__((ext_vector_type(8)))short;
using s16x4=__attribute__((ext_vector_type(4)))short;
using f32x16=__attribute__((ext_vector_type(16)))float;
using u32x4=__attribute__((ext_vector_type(4)))unsigned;
constexpr int BATCH=4,NHEAD=8,SEQ=8192,D=64,DM=NHEAD*D;
constexpr int NW=8,QBLK=32,QB=QBLK*NW,KVBLK=64,NQB=SEQ/QB;
constexpr int ATTN_PITCH=DM, ATTN_UNIT_ROWS=QB;
__device__ __forceinline__ int crow(int r,int hi){return (r&3)+8*(r>>2)+4*hi;}
#define SBAR() __builtin_amdgcn_sched_barrier(0)
__device__ __forceinline__ void cmask(f32x16&p0,f32x16&p1,int jb,int qrel,int hi){
  const float NEG=-INFINITY; int kb=64*jb+4*hi;
  #pragma unroll
  for(int r=0;r<16;++r){int kv=kb+(r&3)+8*(r>>2); if(kv>qrel)p0[r]=NEG; if(kv+32>qrel)p1[r]=NEG;}
}

constexpr int NSLOT=3, SLOTB=8192;
constexpr int LDS_K=0, LDS_V=NSLOT*SLOTB, LDS_WS=2*NSLOT*SLOTB, LDS_OST=LDS_WS+NW*64*4, LDS_CB=LDS_OST+NW*4096, LDS_BYTES=LDS_CB+SEQ*4;
constexpr float C2=0.125f*1.4426950408889634f;
__device__ __forceinline__ void glds16(const void*gsrc,unsigned lds_dst){unsigned keep;
  asm volatile("s_mov_b32 %0, m0\n\ts_mov_b32 m0, %2\n\ts_nop 0\n\tglobal_load_lds_dwordx4 %1, off\n\ts_mov_b32 m0, %0":"=&s"(keep):"v"(gsrc),"s"(lds_dst):"memory");}
__device__ __forceinline__ float max3f(float a,float b,float c){float r;asm("v_max3_f32 %0, %1, %2, %3":"=v"(r):"v"(a),"v"(b),"v"(c));return r;}
__device__ __forceinline__ float max2f(float a,float b){float r;asm("v_max_f32_e32 %0, %1, %2":"=v"(r):"v"(a),"v"(b));return r;}
__device__ __forceinline__ float fadd_s(float a,float b){float r;asm("v_add_f32_e32 %0, %1, %2":"=v"(r):"v"(a),"v"(b));return r;}
__device__ __forceinline__ float fsub_s(float a,float b){float r;asm("v_sub_f32_e32 %0, %1, %2":"=v"(r):"v"(a),"v"(b));return r;}
typedef float f32x2_t __attribute__((ext_vector_type(2))); typedef __bf16 bf16x2_t __attribute__((ext_vector_type(2)));
__device__ __forceinline__ unsigned cvtpk_s(float lo,float hi){f32x2_t v={lo,hi};bf16x2_t b=__builtin_convertvector(v,bf16x2_t);return __builtin_bit_cast(unsigned,b);}
#define WAIT_BAR(N) asm volatile("s_waitcnt vmcnt(" #N ") lgkmcnt(0)\n\ts_barrier":::"memory")

__device__ __forceinline__ void qkt(f32x16&p0,f32x16&p1,const char*Kslot,const bf16x8*qr,int r32,int hi){
  const char*kb=Kslot+hi*1024+r32*16;
  #pragma unroll
  for(int d0=0;d0<4;++d0){
    const bf16x8 b0=*reinterpret_cast<const bf16x8*>(kb+d0*2048);
    const bf16x8 b1=*reinterpret_cast<const bf16x8*>(kb+d0*2048+512);
    {p0=__builtin_amdgcn_mfma_f32_32x32x16_bf16(b0,qr[d0],p0,0,0,0);p1=__builtin_amdgcn_mfma_f32_32x32x16_bf16(b1,qr[d0],p1,0,0,0);}}
}
typedef __attribute__((address_space(3))) const char* lds_cptr;
typedef short v4i16_t __attribute__((ext_vector_type(4)));
typedef float f32x4_t __attribute__((ext_vector_type(4)));
__device__ __forceinline__ void kload8(bf16x8*kf,lds_cptr kp){
  kf[0]=*(const __attribute__((address_space(3))) bf16x8*)(kp);      kf[1]=*(const __attribute__((address_space(3))) bf16x8*)(kp+512);
  kf[2]=*(const __attribute__((address_space(3))) bf16x8*)(kp+2048); kf[3]=*(const __attribute__((address_space(3))) bf16x8*)(kp+2560);
  kf[4]=*(const __attribute__((address_space(3))) bf16x8*)(kp+4096); kf[5]=*(const __attribute__((address_space(3))) bf16x8*)(kp+4608);
  kf[6]=*(const __attribute__((address_space(3))) bf16x8*)(kp+6144); kf[7]=*(const __attribute__((address_space(3))) bf16x8*)(kp+6656);
}
__device__ __forceinline__ void kload2(bf16x8*kf,lds_cptr kp,int j){ kf[2*j]=*(const __attribute__((address_space(3))) bf16x8*)(kp+j*2048); kf[2*j+1]=*(const __attribute__((address_space(3))) bf16x8*)(kp+j*2048+512); }
__device__ __forceinline__ s16x4 vtr(lds_cptr p){ return __builtin_bit_cast(s16x4,__builtin_amdgcn_ds_read_tr16_b64_v4i16((__attribute__((address_space(3))) v4i16_t*)p)); }
__device__ __forceinline__ float rowmax(const f32x16&p0,const f32x16&p1){
  float a=max3f(p0[0],p0[1],p1[0]),b=max3f(p0[2],p0[3],p1[1]);a=max3f(a,p1[2],p1[3]);
  #pragma unroll
  for(int r=4;r<16;r+=4){a=max3f(a,p0[r],p0[r+1]);b=max3f(b,p0[r+2],p0[r+3]);a=max3f(a,p1[r],p1[r+1]);b=max3f(b,p1[r+2],p1[r+3]);}
  const float m=max2f(a,b);
  auto rr=__builtin_amdgcn_permlane32_swap(__float_as_uint(m),__float_as_uint(m),false,false);
  return max2f(__uint_as_float(rr[0]),__uint_as_float(rr[1]));
}
__device__ __forceinline__ void pv(f32x16*o,int vb,bf16x8 pa0,bf16x8 pa1,bf16x8 pa2,bf16x8 pa3){
  #pragma unroll
  for(int d0=0;d0<2;++d0){s16x4 lo[4],hi[4];
    #pragma unroll
    for(int ks=0;ks<4;++ks){
      asm volatile("ds_read_b64_tr_b16 %0,%1 offset:%c2":"=&v"(lo[ks]):"v"(vb),"i"(d0*4096+ks*1024):"memory");
      asm volatile("ds_read_b64_tr_b16 %0,%1 offset:%c2":"=&v"(hi[ks]):"v"(vb),"i"(d0*4096+ks*1024+512):"memory");}
    asm volatile("s_waitcnt lgkmcnt(0)":::"memory");SBAR();
    #define PK(k) (bf16x8){lo[k][0],lo[k][1],lo[k][2],lo[k][3],hi[k][0],hi[k][1],hi[k][2],hi[k][3]}
    o[d0]=__builtin_amdgcn_mfma_f32_32x32x16_bf16(pa0,PK(0),o[d0],0,0,0);
    o[d0]=__builtin_amdgcn_mfma_f32_32x32x16_bf16(pa1,PK(1),o[d0],0,0,0);
    o[d0]=__builtin_amdgcn_mfma_f32_32x32x16_bf16(pa2,PK(2),o[d0],0,0,0);
    o[d0]=__builtin_amdgcn_mfma_f32_32x32x16_bf16(pa3,PK(3),o[d0],0,0,0);
    #undef PK
  }
}

#ifndef ATTN_STORE16
#define ATTN_STORE16(p,v) (*(u32x4*)(p)=(v))
#endif
template<int THRL> __device__ __forceinline__ void attn_unit(int b,int h,int qb,const bf16*Q,const bf16*__restrict__ K,const bf16*__restrict__ V,bf16*O,const float*cbg_,char*shm,int ts=0){
  int tid_=threadIdx.x; asm volatile("":"+v"(tid_)); const int tid=tid_,lane=tid&63,r32=lane&31,hi=lane>>5; const int wid=__builtin_amdgcn_readfirstlane(tid>>6);
  const long rowbase=(long)b*SEQ; const int q0=qb*QB;
  const bf16*Qw=Q+(rowbase+q0+wid*QBLK)*DM+h*D;
  const bf16*Kh=K+(rowbase+(long)ts*KVBLK)*DM+h*D,*Vh=V+(rowbase+(long)ts*KVBLK)*DM+h*D; const float*cbg=cbg_+ts*KVBLK;
  const unsigned lds0=(unsigned)(uintptr_t)shm;
  float*wsf=(float*)(shm+LDS_WS)+wid*64;
  const bf16*ksrc=Kh+(long)lane*DM+wid*8;
  const bf16*vsrc=Vh+(long)(16*(wid&3)+(lane>>2))*DM+(wid>>2)*32+(lane&3)*8;
  const unsigned kdst=lds0+LDS_K+wid*1024, vdst=lds0+LDS_V+wid*1024;
  #define DMA_K(t,slot) glds16(ksrc+(long)(t)*KVBLK*DM,(unsigned)__builtin_amdgcn_readfirstlane(kdst+(slot)))
  #define DMA_V(t,slot) glds16(vsrc+(long)(t)*KVBLK*DM,(unsigned)__builtin_amdgcn_readfirstlane(vdst+(slot)))
  const int vb0=(int)(lds0+LDS_V)+((lane>>4)&1)*32+(lane&3)*8+(4*hi+((lane&15)>>2))*64;
  const char*Kbase=shm+LDS_K; bf16x8 kf[8];
  const lds_cptr shm3=(lds_cptr)shm; const lds_cptr kp0=shm3+LDS_K+hi*1024+r32*16; const lds_cptr vp0=shm3+LDS_V+((lane>>4)&1)*32+(lane&3)*8+(4*hi+((lane&15)>>2))*64;
  const int NT=(q0+QB)/KVBLK-ts;
  { const int nfl=q0+QB-ts*KVBLK; for(int i_=tid*4;i_<nfl;i_+=NW*64*4){ const f32x4_t v_=*(const f32x4_t*)(cbg+i_); *(__attribute__((address_space(3))) f32x4_t*)(shm3+LDS_CB+i_*4)=v_; } }
  #define CLOAD(C0,C1,t) do{ const __attribute__((address_space(3))) f32x4_t* cb_=(const __attribute__((address_space(3))) f32x4_t*)(shm3+LDS_CB)+((t)*16+hi); \
    _Pragma("unroll") for(int i_=0;i_<4;++i_){ const f32x4_t b0_=cb_[2*i_], b1_=cb_[8+2*i_]; \
      _Pragma("unroll") for(int j_=0;j_<4;++j_){ C0[4*i_+j_]=b0_[j_]; C1[4*i_+j_]=b1_[j_]; } } }while(0)
  #define CSUB(C0,C1) do{ _Pragma("unroll") for(int r_=0;r_<16;++r_){ C0[r_]-=mhat; C1[r_]-=mhat; } }while(0)
  DMA_K(0,0);DMA_V(0,0);DMA_K(1,SLOTB);
  bf16x8 qr[4];
  #pragma unroll
  for(int d0=0;d0<4;++d0)qr[d0]=*reinterpret_cast<const bf16x8*>(&Qw[(long)r32*DM+d0*16+hi*8]);
  float mhat=0.f,l_reg=0.f;f32x16 o[2];o[0]=f32x16{};o[1]=f32x16{};
  const int qrel=wid*QBLK+r32;
  #define CMASK(P0,P1,t) do{int jb_=(t)-(NT-4); if(jb_>=0)cmask(P0,P1,jb_,qrel,hi);}while(0)
  bool resc=false;
  #define START(P0,P1) do{ const float rm=rowmax(P0,P1); resc=false; \
    { const float dl=rm; mhat=fadd_s(mhat,dl); \
      _Pragma("unroll") for(int r=0;r<16;++r){P0[r]=fsub_s(P0[r],dl);P1[r]=fsub_s(P1[r],dl);} \
      } \
    _Pragma("unroll") for(int r=0;r<16;++r)P0[r]=__builtin_amdgcn_exp2f(P0[r]); }while(0)
  #define RESC() do{ if(resc){ asm volatile("s_waitcnt lgkmcnt(0)":::"memory"); \
      _Pragma("unroll") for(int d_=0;d_<2;++d_) _Pragma("unroll") for(int r=0;r<16;++r)o[d_][r]*=wsf[crow(r,hi)]; } }while(0)
  f32x16 pA0,pA1,pB0,pB1;
  int sl_prev=0,sl_cur=0,sl_next=SLOTB;
  #define ROT() do{sl_prev=sl_cur;sl_cur=sl_next;sl_next=(sl_next==(NSLOT-1)*SLOTB)?0:sl_next+SLOTB;}while(0)
  DMA_K(2,2*SLOTB);
  WAIT_BAR(3);
  CLOAD(pA0,pA1,0); qkt(pA0,pA1,Kbase,qr,r32,hi);asm volatile("s_nop 15\n\ts_nop 7":"+v"(pA0),"+v"(pA1));CMASK(pA0,pA1,0);
  START(pA0,pA1);
  _Pragma("unroll") for(int r=0;r<16;++r)pA1[r]=__builtin_amdgcn_exp2f(pA1[r]);
  CLOAD(pB0,pB1,1);
  WAIT_BAR(0);
  DMA_K(3,0);DMA_V(1,SLOTB);
  ROT();
  kload8(kf,kp0+sl_cur);
  WAIT_BAR(2);
  s16x4 vlo[8],vhi[8]; u32x4 pw0,pw1,pw2,pw3;
  #define PKW(P,B) cvtpk_s(P[B],P[B+1])
  #define PAF(k) __builtin_bit_cast(bf16x8,pw##k)
  #define VFR(i) (bf16x8){vlo[i][0],vlo[i][1],vlo[i][2],vlo[i][3],vhi[i][0],vhi[i][1],vhi[i][2],vhi[i][3]}
  #define PIN(x) asm volatile("":"+v"(x))
  #define MX3(a,b,c) __builtin_fmaxf(__builtin_fmaxf((a),(b)),(c))
  #define GAPA(MF,A0,A1,A2,A3,W0,W1,PW) do{ MF; sacc+=A0; sacc+=A1; sacc+=A2; sacc+=A3; PIN(sacc); W0; W1; PIN(PW); SBAR(); }while(0)
  #define EX(v) __builtin_amdgcn_exp2f(v)
  #define GAPB(MF,X,B) do{ MF; X[B]=EX(X[B]); X[B+1]=EX(X[B+1]); X[B+2]=EX(X[B+2]); X[B+3]=EX(X[B+3]); PIN(X); SBAR(); }while(0)
  #define VRD(i) do{ vlo[i]=vtr(vp_+(((i)>>2)*4096+((i)&3)*1024)); vhi[i]=vtr(vp_+(((i)>>2)*4096+((i)&3)*1024+512)); }while(0)
  #define KRD(G,j) do{ if(G){ kload2(kf,kp0+sl_next,j); SBAR(); } }while(0)
  #define STEP(C0,C1,P0,P1,t,GK,GV,GL) do{ SBAR(); CSUB(C0,C1); SBAR(); \
    const lds_cptr vp_=vp0+sl_prev; \
    VRD(0); SBAR(); float sacc=(P0[0]+P0[1]); \
    GAPA(C0=__builtin_amdgcn_mfma_f32_32x32x16_bf16(kf[0],qr[0],C0,0,0,0), P0[2],P0[3],P0[4],P0[5],     pw0[0]=PKW(P0,0), pw0[1]=PKW(P0,2), pw0); \
    VRD(4); SBAR(); GAPA(C1=__builtin_amdgcn_mfma_f32_32x32x16_bf16(kf[1],qr[0],C1,0,0,0), P0[6],P0[7],P0[8],P0[9],     pw0[2]=PKW(P0,4), pw0[3]=PKW(P0,6), pw0); \
    VRD(1); SBAR(); GAPA(C0=__builtin_amdgcn_mfma_f32_32x32x16_bf16(kf[2],qr[1],C0,0,0,0),   P0[10],P0[11],P0[12],P0[13], pw1[0]=PKW(P0,8), pw1[1]=PKW(P0,10), pw1); \
    VRD(5); SBAR(); GAPA(C1=__builtin_amdgcn_mfma_f32_32x32x16_bf16(kf[3],qr[1],C1,0,0,0),   P0[14],P0[15],P1[0],P1[1],   pw1[2]=PKW(P0,12),pw1[3]=PKW(P0,14), pw1); \
    VRD(2); SBAR(); GAPA(C0=__builtin_amdgcn_mfma_f32_32x32x16_bf16(kf[4],qr[2],C0,0,0,0),   P1[2],P1[3],P1[4],P1[5],     pw2[0]=PKW(P1,0), pw2[1]=PKW(P1,2), pw2); \
    VRD(6); SBAR(); GAPA(C1=__builtin_amdgcn_mfma_f32_32x32x16_bf16(kf[5],qr[2],C1,0,0,0),   P1[6],P1[7],P1[8],P1[9],     pw2[2]=PKW(P1,4), pw2[3]=PKW(P1,6), pw2); \
    VRD(3); SBAR(); GAPA(C0=__builtin_amdgcn_mfma_f32_32x32x16_bf16(kf[6],qr[3],C0,0,0,0),   P1[10],P1[11],P1[12],P1[13], pw3[0]=PKW(P1,8), pw3[1]=PKW(P1,10), pw3); \
    VRD(7); SBAR(); GAPA(C1=__builtin_amdgcn_mfma_f32_32x32x16_bf16(kf[7],qr[3],C1,0,0,0),   P1[14],P1[15],0.f,0.f,       pw3[2]=PKW(P1,12),pw3[3]=PKW(P1,14), pw3); \
    l_reg+=sacc; \
    if(GK){DMA_K((t)+3,sl_cur);} if(GV){DMA_V((t)+1,sl_next);} \
    CMASK(C0,C1,t); \
    { float a=MX3(C0[0],C0[1],C1[0]),b=MX3(C0[2],C0[3],C1[1]); a=MX3(a,C1[2],C1[3]); \
      _Pragma("unroll") for(int r=4;r<16;r+=4){a=MX3(a,C0[r],C0[r+1]);b=MX3(b,C0[r+2],C0[r+3]);a=MX3(a,C1[r],C1[r+1]);b=MX3(b,C1[r+2],C1[r+3]);} \
      float rm=__builtin_fmaxf(a,b); { auto rr=__builtin_amdgcn_permlane32_swap(__float_as_uint(rm),__float_as_uint(rm),false,false); rm=__builtin_fmaxf(__uint_as_float(rr[0]),__uint_as_float(rr[1])); } \
      resc=false; \
      if(__builtin_expect(__any(rm>(float)THRL),0)){ const float dl=__builtin_fmaxf(rm,0.f); mhat+=dl; \
        _Pragma("unroll") for(int r=0;r<16;++r){C0[r]-=dl;C1[r]-=dl;} \
        const float f=__builtin_amdgcn_exp2f(-dl); l_reg*=f; if(hi==0)wsf[r32]=f; resc=true; } } \
    SBAR(); CLOAD(P0,P1,(t)+1); SBAR(); \
    GAPB(o[0]=__builtin_amdgcn_mfma_f32_32x32x16_bf16(PAF(0),VFR(0),o[0],0,0,0), C0,0); \
    GAPB(o[1]=__builtin_amdgcn_mfma_f32_32x32x16_bf16(PAF(0),VFR(4),o[1],0,0,0), C0,4); \
    KRD(GL,0); GAPB(o[0]=__builtin_amdgcn_mfma_f32_32x32x16_bf16(PAF(1),VFR(1),o[0],0,0,0), C0,8); \
    KRD(GL,1); GAPB(o[1]=__builtin_amdgcn_mfma_f32_32x32x16_bf16(PAF(1),VFR(5),o[1],0,0,0), C0,12); \
    KRD(GL,2); GAPB(o[0]=__builtin_amdgcn_mfma_f32_32x32x16_bf16(PAF(2),VFR(2),o[0],0,0,0), C1,0); \
    KRD(GL,3); GAPB(o[1]=__builtin_amdgcn_mfma_f32_32x32x16_bf16(PAF(2),VFR(6),o[1],0,0,0), C1,4); \
    GAPB(o[0]=__builtin_amdgcn_mfma_f32_32x32x16_bf16(PAF(3),VFR(3),o[0],0,0,0), C1,8); \
    GAPB(o[1]=__builtin_amdgcn_mfma_f32_32x32x16_bf16(PAF(3),VFR(7),o[1],0,0,0), C1,12); \
    }while(0)
  int t=1;
  #undef CMASK
  #define CMASK(P0,P1,t) do{}while(0)
  for(;t+5<NT;t+=2){
    STEP(pB0,pB1,pA0,pA1,t,true,true,true);     WAIT_BAR(2); RESC(); ROT();
    STEP(pA0,pA1,pB0,pB1,t+1,true,true,true);   WAIT_BAR(2); RESC(); ROT();
  }
  #undef CMASK
  #define CMASK(P0,P1,t) do{int jb_=(t)-(NT-4); if(jb_>=0)cmask(P0,P1,jb_,qrel,hi);}while(0)
  #define ENDW(tt) do{ if((tt)+3<NT){WAIT_BAR(2);} else if((tt)+2<NT){WAIT_BAR(1);} else {WAIT_BAR(0);} }while(0)
  for(;t+1<NT;t+=2){
    STEP(pB0,pB1,pA0,pA1,t,(t+3<NT),(t+1<NT),(t+1<NT));       ENDW(t);   RESC(); ROT();
    STEP(pA0,pA1,pB0,pB1,t+1,(t+4<NT),(t+2<NT),(t+2<NT));     ENDW(t+1); RESC(); ROT();
  }
  STEP(pB0,pB1,pA0,pA1,NT-1,false,false,false); RESC();
  { float sacc=pB0[0]+pB0[1]; _Pragma("unroll") for(int r=2;r<16;++r)sacc+=pB0[r]; _Pragma("unroll") for(int r=0;r<16;++r)sacc+=pB1[r]; l_reg+=sacc;
    pw0=(u32x4){PKW(pB0,0),PKW(pB0,2),PKW(pB0,4),PKW(pB0,6)};pw1=(u32x4){PKW(pB0,8),PKW(pB0,10),PKW(pB0,12),PKW(pB0,14)};pw2=(u32x4){PKW(pB1,0),PKW(pB1,2),PKW(pB1,4),PKW(pB1,6)};pw3=(u32x4){PKW(pB1,8),PKW(pB1,10),PKW(pB1,12),PKW(pB1,14)};
    SBAR(); pv(o,vb0+sl_cur,PAF(0),PAF(1),PAF(2),PAF(3)); }
  #undef PKW
  #undef PAF
  #undef VFR
  #undef PIN
  #undef MX3
  #undef GAPA
  #undef GAPB
  #undef EX
  #undef VRD
  #undef KRD
  #undef STEP
  #undef ENDW
  {auto rr=__builtin_amdgcn_permlane32_swap(__float_as_uint(l_reg),__float_as_uint(l_reg),false,false);l_reg=__uint_as_float(rr[0])+__uint_as_float(rr[1]);}
  if(hi==0)wsf[32+r32]=l_reg;asm volatile("s_waitcnt lgkmcnt(0)":::"memory");
  float rli[16];
  #pragma unroll
  for(int r=0;r<16;++r)rli[r]=__builtin_amdgcn_rcpf(wsf[32+crow(r,hi)]);
  bf16*Ow=O+(rowbase+q0+wid*QBLK)*DM+h*D;
  { bf16*stg=(bf16*)(shm+LDS_OST)+wid*2048;
    #pragma unroll
    for(int r=0;r<16;++r){const int orow=crow(r,hi);
      #pragma unroll
      for(int d0=0;d0<2;++d0)stg[orow*64+d0*32+r32]=__float2bfloat16(o[d0][r]*rli[r]);}
    asm volatile("s_waitcnt lgkmcnt(0)":::"memory");
    #pragma unroll
    for(int i=0;i<4;++i){const int row=i*8+(lane>>3),ch=lane&7; const u32x4 v=*(const u32x4*)(stg+row*64+ch*8); ATTN_STORE16(Ow+(long)row*DM+ch*8,v);} }
  asm volatile("s_waitcnt lgkmcnt(0)\n\ts_barrier":::"memory");
  #undef DMA_K
  #undef CLOAD
  #undef CSUB
  #undef DMA_V
  #undef CMASK
  #undef START
  #undef RESC
  #undef ROT
}
constexpr int ATTN_LDS_BYTES=LDS_BYTES;
struct AttnTensors { const bf16* Q; const bf16* K; const bf16* V; bf16* O; const float* CB; };
struct AttnUnit { int bh; int qb; };
struct StaticOrder {
  int vcu;
  __device__ __forceinline__ explicit StaticOrder(int grid,int block):vcu((block%8)*(grid/8)+block/8){}
  __device__ __forceinline__ bool next(int i,AttnUnit&u)const{ if(i>=4)return false; const int s=vcu&7; u.bh=vcu>>3; u.qb=(i==0)?s:(i==1)?15-s:(i==2)?16+s:31-s; return true; }
  __device__ __forceinline__ void a_ready(const AttnUnit&)const{}
  __device__ __forceinline__ void done(const AttnUnit&)const{}
};
template<class Sched,int THRL=8> __device__ __forceinline__ void attn_phase(char*lds,const AttnTensors&T,const Sched&S){
  AttnUnit u;
  for(int i=0;S.next(i,u);++i){ S.a_ready(u); attn_unit<THRL>(u.bh/NHEAD,u.bh%NHEAD,u.qb,T.Q,T.K,T.V,T.O,T.CB+(size_t)u.bh*SEQ,lds); S.done(u); }
}
#undef SBAR
#undef WAIT_BAR
}
#define GAS __attribute__((address_space(1)))
#define LAS __attribute__((address_space(3)))
typedef unsigned short bf16;
typedef unsigned v4u __attribute__((ext_vector_type(4)));
typedef float f32x4 __attribute__((ext_vector_type(4)));
typedef short bf16x8 __attribute__((ext_vector_type(8)));
typedef GAS unsigned gu32;
typedef GAS unsigned long long gu64;
#define RLX_AGENT __ATOMIC_RELAXED, __HIP_MEMORY_SCOPE_AGENT
#define LDS_WAIT() asm volatile("s_waitcnt lgkmcnt(0)" ::: "memory")
#define VM_WAIT() asm volatile("s_waitcnt vmcnt(0)" ::: "memory")
__device__ __forceinline__ unsigned long long rt() { return __builtin_amdgcn_s_memrealtime(); }
__device__ __forceinline__ unsigned f2bf(float f) { unsigned u = __builtin_bit_cast(unsigned, f); return (u + 0x7fffu + ((u >> 16) & 1u)) >> 16; }
__device__ __forceinline__ unsigned pk2(float lo, float hi) { return f2bf(lo) | (f2bf(hi) << 16); }

#define XB_TMO      128
#define XB_XCNT(j)  (256  + 64 * (j))
#define XB_XSUB(j)  (1280 + 64 * (j))
#define XB_XGEN(j)  (2304 + 64 * (j))
#define XB_TOP      3328
#define XB_TOPGEN   3392
#define XCD_BAR_WORDS 3456
#define XB_SPIN_CAP (1u << 18)

__device__ __forceinline__ unsigned xb_ld(unsigned* p)              { return __hip_atomic_load(p, __ATOMIC_RELAXED, __HIP_MEMORY_SCOPE_AGENT); }
__device__ __forceinline__ unsigned xb_add(unsigned* p, unsigned v) { return __hip_atomic_fetch_add(p, v, __ATOMIC_RELAXED, __HIP_MEMORY_SCOPE_AGENT); }
__device__ __forceinline__ unsigned xb_xcc_id() { return (unsigned)__builtin_amdgcn_s_getreg((3 << 11) | 20) & 0xFu; }
#define XB_SPIN(cond, bar) do { unsigned _sp = 0; while (cond) { __builtin_amdgcn_s_sleep(1); \
    if ((++_sp & 255u) == 0u) { if (xb_ld(&(bar)[XB_TMO])) break; if (_sp > XB_SPIN_CAP) { atomicAdd(&(bar)[XB_TMO], 1u); break; } } } } while (0)

struct XcdBarrier {
    unsigned* bar; unsigned x;
    volatile LAS unsigned* st;
};

__device__ __forceinline__ XcdBarrier xcd_barrier_post(unsigned* bar, volatile LAS unsigned* st) {
    XcdBarrier b; b.bar = bar; b.x = xb_xcc_id(); b.st = st;
    if (threadIdx.x == 0) (void)xb_add(&bar[XB_XCNT(b.x)], 1u);
    return b;
}
__device__ __forceinline__ void xcd_barrier_complete(unsigned* bar, unsigned x, unsigned& nloc, unsigned& nx) {
    const unsigned G = gridDim.x * gridDim.y * gridDim.z;
    unsigned sum, cnt, mine, sp = 0u;
    for (;;) {
        sum = 0u; cnt = 0u; mine = 0u;
#pragma unroll
        for (unsigned j = 0; j < 16; ++j) { const unsigned c = xb_ld(&bar[XB_XCNT(j)]); sum += c; cnt += (c > 0u) ? 1u : 0u; mine = (j == x) ? c : mine; }
        if (sum == G) break;
        __builtin_amdgcn_s_sleep(1);
        if ((++sp & 255u) == 0u) { if (xb_ld(&bar[XB_TMO])) break; if (sp > XB_SPIN_CAP) { atomicAdd(&bar[XB_TMO], 1u); break; } }
    }
    nloc = mine > 0u ? mine : 1u; nx = cnt > 0u ? cnt : 1u;
}

__device__ __forceinline__ void xcd_barrier(const XcdBarrier& b) {
    asm volatile("s_waitcnt vmcnt(0)" ::: "memory");
    __syncthreads();
    if (threadIdx.x == 0) {
        unsigned* bar = b.bar;
        __builtin_amdgcn_s_waitcnt(0);
        unsigned nloc = b.st[0], nx = b.st[1];
        if (nloc == 0u) { xcd_barrier_complete(bar, b.x, nloc, nx); b.st[0] = nloc; b.st[1] = nx; }
        const unsigned old = xb_add(&bar[XB_XSUB(b.x)], 1u);
        const unsigned gen = old / nloc;
        if (old + 1u == (gen + 1u) * nloc) {
            __builtin_amdgcn_fence(__ATOMIC_RELEASE, "agent");
            asm volatile("s_waitcnt vmcnt(0)" ::: "memory");
            const unsigned og = xb_add(&bar[XB_TOP], 1u);
            const unsigned tg = og / nx;
            if (og + 1u == (tg + 1u) * nx) xb_add(&bar[XB_TOPGEN], 1u);
            else XB_SPIN(xb_ld(&bar[XB_TOPGEN]) == tg, bar);
            __builtin_amdgcn_fence(__ATOMIC_ACQUIRE, "agent");
            xb_add(&bar[XB_XGEN(b.x)], 1u);
            asm volatile("s_waitcnt vmcnt(0)" ::: "memory");
        } else {
            XB_SPIN(xb_ld(&bar[XB_XGEN(b.x)]) == gen, bar);
            __builtin_amdgcn_fence(__ATOMIC_ACQUIRE, "agent");
            asm volatile("s_waitcnt vmcnt(0)" ::: "memory");
        }
    }
    __syncthreads();
}

constexpr int NWAVES = 8, NG = 256, NGW = NG * NWAVES;
constexpr int BATCH = 4, T = 8192, D = 1024, M = BATCH * T, NLAYER = 2;
constexpr int RW = 512, RH = 8;
constexpr int R_COLS = 1792, C_COLS = 1024  , IN_COLS = 7944, INA_N = 5120, INP_N = 8192;
constexpr int DFF = 2816, DFFE = 3584, NEXP = 8;
constexpr int MOE_HALF = M / 2, MOE_ROWS = MOE_HALF * 2 + NEXP * 256;
constexpr float LN_EPS = 1e-5f, RWKV_LN_EPS = 64e-5f;
constexpr float DN_ALPHA = 1.4142135623730951f;
constexpr float LOG2E = 1.4426950408889634f;

constexpr size_t MiB = 1u << 20, KiB = 1u << 10;
constexpr size_t WS_CTL = 0, CTL_ZERO_BYTES = 1 * MiB;
constexpr size_t WS_FL = 1 * MiB, WS_CB = 2 * MiB;
constexpr size_t WS_TOKE = 3 * MiB, WS_TOKG = WS_TOKE + 128 * KiB, WS_PPOS = WS_TOKG + 256 * KiB, WS_RTOK = WS_PPOS + 256 * KiB;
constexpr size_t WS_WL = 5 * MiB;
constexpr size_t WS_X = 8 * MiB;
constexpr size_t WS_WIN = 72 * MiB, WS_WUP = 104 * MiB, WS_WOUT = 110 * MiB, WS_W13 = 114 * MiB, WS_W2 = 125 * MiB;
constexpr size_t WS_L = 132 * MiB;
constexpr size_t WS_C = WS_L, WS_FQ = 228 * MiB, WS_FK = 260 * MiB, WS_FV = 292 * MiB, WS_LA = 324 * MiB, WS_LW = 340 * MiB, WS_LAO = 404 * MiB, WS_LG = 436 * MiB,
                 WS_OB = 468 * MiB, WS_OA = 500 * MiB, WS_BV = 532 * MiB;
constexpr size_t WS_G2 = WS_LW, WS_MG = WS_FK, WS_H = WS_L;
constexpr size_t WS_PM = WS_C, WS_QM = WS_C + 32 * MiB, WS_RH = WS_C + 64 * MiB;
constexpr size_t WS_WM13 = 72 * MiB, WS_WM2 = 184 * MiB, WS_HM = 240 * MiB, WS_YP = 478 * MiB, WS_YPS = 546 * MiB, WS_END = 580 * MiB;
constexpr int MOE_MAINP = 128;
static_assert(WS_RTOK + 2 * MOE_ROWS * 4 <= 4 * MiB && WS_WL + 2 * 1536 * 256 * 2 <= WS_X, "small tables");
static_assert(WS_W2 + (size_t)D * DFF * 2 <= WS_L && WS_BV + (size_t)M * RW * 2 <= WS_END && WS_H + (size_t)M * DFF * 2 <= WS_END, "ws map");
static_assert(WS_YPS + (size_t)4 * 8 * 256 * D * 2 <= WS_END && WS_YP + (size_t)MOE_ROWS * D * 2 <= WS_YPS && WS_WM13 + (size_t)NEXP * 2 * DFFE * D * 2 == WS_WM2 && WS_WM2 + (size_t)NEXP * D * DFFE * 2 == WS_HM && WS_HM + (size_t)MOE_ROWS * DFFE * 2 == WS_YP && WS_YP + (size_t)MOE_ROWS * D * 2 <= WS_END, "moe map");
constexpr int CW_TMO = 0, CW_CODE = 1, CW_BAR = 4096, CW_QATT = 8192, CW_CNT = 12288, CW_FILL = 14336, CW_NRM = 16384;

constexpr int RING_OFF = 0, RING_BYTES = 131072;
constexpr int NRM_OFF = RING_BYTES + 512;
constexpr int LDSCTL_OFF = RING_BYTES, MISC_OFF = LDSCTL_OFF + 320, PEXP_OFF = LDSCTL_OFF + 1024, MOFF_OFF = LDSCTL_OFF + 2048, LCNT_OFF = LDSCTL_OFF + 2304, LFIL_OFF = LDSCTL_OFF + 2432, LBAS_OFF = LDSCTL_OFF + 2560;
constexpr int LDS_BYTES = 147456;

struct Args { const float* in[34]; float* out; unsigned char* ws; };
struct Frame {
    LAS unsigned char* lds; volatile LAS unsigned* MISC; gu32* ctl;
    int tid, lane, wave, vcu, G;
};
template <int CTRL> __device__ __forceinline__ float dpp_mov(float v) { return __builtin_bit_cast(float, __builtin_amdgcn_update_dpp(0, __builtin_bit_cast(int, v), CTRL, 0xf, 0xf, false)); }
__device__ __forceinline__ float red8(float v) { v += dpp_mov<0xB1>(v); v += dpp_mov<0x4E>(v); v += dpp_mov<0x141>(v); return v; }
__device__ __forceinline__ float red16(float v) { v = red8(v); v += dpp_mov<0x140>(v); return v; }
__device__ __forceinline__ float swap32_add(float v) { float a = v, b = v; asm volatile("s_nop 1\n\tv_permlane32_swap_b32 %0, %1" : "+v"(a), "+v"(b)); return a + b; }
__device__ __forceinline__ float wave_sum(float v) { v = swap32_add(red16(v));
    const float a = __builtin_bit_cast(float, __builtin_amdgcn_readlane(__builtin_bit_cast(int, v), 0)), b = __builtin_bit_cast(float, __builtin_amdgcn_readlane(__builtin_bit_cast(int, v), 16)); return a + b; }
__device__ __forceinline__ float bfu(unsigned short u) { return __builtin_bit_cast(float, (unsigned)u << 16); }
__device__ __forceinline__ float bflo(unsigned w) { return __builtin_bit_cast(float, w << 16); }
__device__ __forceinline__ float bfhi(unsigned w) { return __builtin_bit_cast(float, w & 0xffff0000u); }
__device__ __forceinline__ float sigm(float x) { return __builtin_amdgcn_rcpf(1.0f + __expf(-x)); }

__device__ __forceinline__ void tr_item(const float* W, int ldw, int sk0, int n0, int nvalid, bf16* dst, int ldk, int dk0, float scale, LAS float* scr, int lane) {
    const int r8 = lane >> 3, c4 = (lane & 7) * 4; f32x4 w[8];
#pragma unroll
    for (int i = 0; i < 8; ++i) { w[i] = (f32x4){0.f, 0.f, 0.f, 0.f}; if (c4 < nvalid) w[i] = *(const GAS f32x4*)(W + (size_t)(sk0 + 8 * i + r8) * ldw + n0 + c4); }
#pragma unroll
    for (int i = 0; i < 8; ++i) { LAS float* d = scr + (8 * i + r8) * 33 + c4; d[0] = w[i][0] * scale; d[1] = w[i][1] * scale; d[2] = w[i][2] * scale; d[3] = w[i][3] * scale; }
    LDS_WAIT(); asm volatile("" ::: "memory");
    const int c = lane & 7;
#pragma unroll
    for (int j = 0; j < 4; ++j) { const int n = (lane >> 3) + 8 * j; const LAS float* s = scr + (8 * c) * 33 + n;
        v4u o; o.x = pk2(s[0 * 33], s[1 * 33]); o.y = pk2(s[2 * 33], s[3 * 33]); o.z = pk2(s[4 * 33], s[5 * 33]); o.w = pk2(s[6 * 33], s[7 * 33]);
        *(GAS v4u*)(dst + (size_t)n * ldk + dk0 + 8 * c) = o; }
    LDS_WAIT(); asm volatile("" ::: "memory");
}

__device__ __forceinline__ void ln_norm(f32x4 (&v)[4], const float* g, const float* b, int lane) {
    float s = 0.f;
#pragma unroll
    for (int j = 0; j < 4; ++j) s += (v[j].x + v[j].y) + (v[j].z + v[j].w);
    const float mean = wave_sum(s) * (1.f / D); float s2 = 0.f;
#pragma unroll
    for (int j = 0; j < 4; ++j) { v[j] = v[j] - mean; s2 += (v[j].x * v[j].x + v[j].y * v[j].y) + (v[j].z * v[j].z + v[j].w * v[j].w); }
    const float rstd = 1.f / sqrtf(wave_sum(s2) * (1.f / D) + LN_EPS);
#pragma unroll
    for (int j = 0; j < 4; ++j) { const f32x4 gg = *(const f32x4*)(g + 4 * lane + 256 * j), bb = *(const f32x4*)(b + 4 * lane + 256 * j); v[j] = v[j] * rstd * gg + bb; }
}
__device__ __forceinline__ void row_store_bf16(bf16* orow, const f32x4 (&v)[4], int lane) {
    GAS unsigned long long* o8 = (GAS unsigned long long*)orow + lane;
#pragma unroll
    for (int j = 0; j < 4; ++j) o8[64 * j] = (unsigned long long)pk2(v[j].x, v[j].y) | ((unsigned long long)pk2(v[j].z, v[j].w) << 32);
}
__device__ __forceinline__ void row_load_bf16(const bf16* row, f32x4 (&v)[4], int lane) {
    const GAS unsigned long long* p = (const GAS unsigned long long*)row + lane;
#pragma unroll
    for (int j = 0; j < 4; ++j) { const unsigned long long w = p[64 * j]; const unsigned lo = (unsigned)w, hi = (unsigned)(w >> 32); v[j] = (f32x4){bflo(lo), bfhi(lo), bflo(hi), bfhi(hi)}; }
}

struct RowRaw { unsigned long long w[4]; };
struct LnGB { f32x4 g[4], b[4]; };
__device__ __forceinline__ void row_fetch(RowRaw& r, const bf16* row, int lane) { const GAS unsigned long long* p = (const GAS unsigned long long*)row + lane;
#pragma unroll
    for (int j = 0; j < 4; ++j) r.w[j] = p[64 * j]; }
__device__ __forceinline__ void row_unpack(const RowRaw& r, f32x4 (&v)[4]) {
#pragma unroll
    for (int j = 0; j < 4; ++j) { const unsigned lo = (unsigned)r.w[j], hi = (unsigned)(r.w[j] >> 32); v[j] = (f32x4){bflo(lo), bfhi(lo), bflo(hi), bfhi(hi)}; } }
__device__ __forceinline__ void ln_load_gb(LnGB& q, const float* g, const float* b, int lane) {
#pragma unroll
    for (int j = 0; j < 4; ++j) { q.g[j] = *(const f32x4*)(g + 4 * lane + 256 * j); q.b[j] = *(const f32x4*)(b + 4 * lane + 256 * j); } }
__device__ __forceinline__ void ln_norm_r(f32x4 (&v)[4], const LnGB& q) {
    float s = 0.f;
#pragma unroll
    for (int j = 0; j < 4; ++j) s += (v[j].x + v[j].y) + (v[j].z + v[j].w);
    const float mean = wave_sum(s) * (1.f / D); float s2 = 0.f;
#pragma unroll
    for (int j = 0; j < 4; ++j) { v[j] = v[j] - mean; s2 += (v[j].x * v[j].x + v[j].y * v[j].y) + (v[j].z * v[j].z + v[j].w * v[j].w); }
    const float rstd = 1.f / sqrtf(wave_sum(s2) * (1.f / D) + LN_EPS);
#pragma unroll
    for (int j = 0; j < 4; ++j) v[j] = v[j] * rstd * q.g[j] + q.b[j];
}

struct DynAttnOrder {
    gu32* ctr; volatile LAS unsigned* slot; int grp;
    __device__ __forceinline__ bool next(int, attn_body::AttnUnit& u) const {
        if (threadIdx.x == 0) slot[0] = __hip_atomic_fetch_add(ctr, 1u, RLX_AGENT);
        __syncthreads();
        const unsigned v = slot[0];
        __syncthreads();
        if (v >= 128u) return false;
        u.qb = 31 - (int)(v >> 2); u.bh = grp * 4 + (int)(v & 3u); return true;
    }
    __device__ __forceinline__ void a_ready(const attn_body::AttnUnit&) const {}
    __device__ __forceinline__ void done(const attn_body::AttnUnit&) const {}
};

constexpr int SC_TC = 32, SC_BUF = 45056;
typedef float f32x2 __attribute__((ext_vector_type(2)));
struct ScanRegs { float r[5], k[5], v[5], a[4], lw[4]; };
__device__ __forceinline__ void rwkv_scan_unit(const Frame& F, int su, const bf16* Rraw, const bf16* LAo, const float* LW, bf16* OA, bf16* BV,
                                               const float* mu_l, const float* kk_l, const float* ka_l, const float* rk_l) {
    const int bh = su >> 2, qq = su & 3, b = bh >> 3, h = bh & 7;
    const int tid = F.tid, lane = F.lane, w = F.wave;
    const float mu_r = mu_l[h * 64 + lane], mu_k = mu_l[512 + h * 64 + lane], mu_v = mu_l[1024 + h * 64 + lane];
    const float kkc = kk_l[h * 64 + lane], kac = ka_l[h * 64 + lane], rkc = rk_l[h * 64 + lane];
    const int hi = lane >> 5, riw = (lane >> 4) & 1, kidx = (lane & 15) + 16 * hi, row16 = 2 * w + riw;
    const size_t m0 = (size_t)b * T;
    const int hc = h * 64 + lane;
    f32x2 s = (f32x2){0.f, 0.f};
    ScanRegs g;
#define SC_LOAD(c) do { const int tb_ = (c) * SC_TC + 4 * w; const size_t mb_ = m0 + tb_; \
        _Pragma("unroll") for (int j = 0; j < 5; ++j) { const bool ok_ = !(j == 0 && tb_ == 0); const bf16* rp_ = Rraw + (mb_ + j - 1) * R_COLS + hc; \
            g.r[j] = ok_ ? bfu(rp_[0]) : 0.f; g.k[j] = ok_ ? bfu(rp_[512]) : 0.f; g.v[j] = ok_ ? bfu(rp_[1024]) : 0.f; } \
        _Pragma("unroll") for (int j = 0; j < 4; ++j) { g.a[j] = bfu(LAo[(mb_ + j) * RW + hc]); g.lw[j] = LW[(mb_ + j) * RW + hc]; } } while (0)
#define SC_PREP(c, bufp) do { LAS float* B_ = (LAS float*)(bufp); const size_t mb_ = m0 + (c) * SC_TC + 4 * w; \
        _Pragma("unroll") for (int j = 0; j < 4; ++j) { const int tt = 4 * w + j; \
            const float r_ = g.r[j + 1] + mu_r * (g.r[j] - g.r[j + 1]), k_ = g.k[j + 1] + mu_k * (g.k[j] - g.k[j + 1]), v_ = g.v[j + 1] + mu_v * (g.v[j] - g.v[j + 1]); \
            const float a_ = g.a[j], d_ = __expf(g.lw[j]); \
            const float kk0 = k_ * kkc; const float n2 = wave_sum(kk0 * kk0); const float kkn = kk0 * __builtin_amdgcn_rsqf(fmaxf(n2, 1e-24f)); \
            const float kmod = k_ * (1.f + (a_ - 1.f) * kac); const float bonus = wave_sum(r_ * kmod * rkc); \
            B_[tt * 64 + lane] = d_; B_[2048 + tt * 64 + lane] = -kkn; B_[4096 + tt * 64 + lane] = kkn * a_; B_[6144 + tt * 64 + lane] = kmod; B_[8192 + tt * 64 + lane] = r_; \
            if ((lane >> 4) == qq) { B_[10240 + tt * 16 + (lane & 15)] = v_; BV[(mb_ + j) * RW + hc] = (bf16)f2bf(bonus * v_); } } } while (0)
    LAS unsigned char* buf0 = F.lds + RING_OFF;
    SC_LOAD(0); SC_PREP(0, buf0);
    __syncthreads();
    for (int c = 0; c < T / SC_TC; ++c) {
        LAS unsigned char* bufc = buf0 + (c & 1) * SC_BUF; LAS unsigned char* bufn = buf0 + ((c + 1) & 1) * SC_BUF;
        if (c + 1 < T / SC_TC) SC_LOAD(c + 1);
        const LAS f32x2* Sd2 = (const LAS f32x2*)bufc; const LAS f32x2* Sa2 = Sd2 + 1024; const LAS f32x2* Sb2 = Sd2 + 2048; const LAS f32x2* Sk2 = Sd2 + 3072; const LAS f32x2* Sr2 = Sd2 + 4096;
        const LAS float* Sv = (const LAS float*)bufc + 10240; LAS float* Sy = (LAS float*)bufc + 10240 + 512;
#pragma unroll 4
        for (int tt = 0; tt < SC_TC; ++tt) {
            const f32x2 dv = Sd2[tt * 32 + kidx], av = Sa2[tt * 32 + kidx], bv = Sb2[tt * 32 + kidx], kv = Sk2[tt * 32 + kidx], rv = Sr2[tt * 32 + kidx]; const float vv = Sv[tt * 16 + row16];
            float p = s.x * av.x + s.y * av.y; p = red16(p); p = swap32_add(p);
            s.x = s.x * dv.x + (p * bv.x + vv * kv.x); s.y = s.y * dv.y + (p * bv.y + vv * kv.y);
            float y = s.x * rv.x + s.y * rv.y; y = red16(y); y = swap32_add(y);
            if ((lane & 47) == 0) Sy[tt * 16 + row16] = y;
        }
        __syncthreads();
        { const int tt = tid >> 4, rr = tid & 15; OA[(m0 + (size_t)c * SC_TC + tt) * RW + h * 64 + 16 * qq + rr] = (bf16)f2bf(Sy[tt * 16 + rr]); }
        if (c + 1 < T / SC_TC) SC_PREP(c + 1, bufn);
        __syncthreads();
    }
#undef SC_LOAD
#undef SC_PREP
}


typedef short s16x4 __attribute__((ext_vector_type(4)));
typedef float f32x16 __attribute__((ext_vector_type(16)));
constexpr int CK_P = 144, CK_MSZ = 64 * CK_P;
constexpr int CK_AT = 0, CK_RT = CK_MSZ, CK_BT = 2 * CK_MSZ, CK_KT = 3 * CK_MSZ, CK_BTT = 4 * CK_MSZ, CK_KTT = 5 * CK_MSZ, CK_VTT = 6 * CK_MSZ,
              CK_AAB = 7 * CK_MSZ, CK_AAK = 8 * CK_MSZ, CK_ARB = 9 * CK_MSZ, CK_ARK = 10 * CK_MSZ, CK_DIAG = 11 * CK_MSZ, CK_TBB = CK_DIAG + 4096, CK_GL = CK_TBB + 2048, CK_CLW = CK_GL + 256,
              CK_WT = CK_BT, CK_ULT = CK_KT, CK_END = CK_CLW + 2048,
              CK_OPM = CK_AT, CK_ORH = CK_AAB, CK_OYL = CK_AAK, CK_OQM = CK_END;
static_assert(CK_END + 8192 <= RING_BYTES, "chunk LDS map");
constexpr int CK_DUMMY_ = 0;
static_assert(CK_END <= RING_BYTES, "chunk LDS map");
__device__ __forceinline__ pg8::bf16x8 ck_frag(LAS unsigned char* base, int row0, int ks, int lane) {
    return *(const LAS pg8::bf16x8*)(base + (row0 + (lane & 15)) * CK_P + (32 * ks + 8 * (lane >> 4)) * 2); }
__device__ __forceinline__ void lds_st16(LAS unsigned char* p, float v) { *(LAS unsigned short*)p = (unsigned short)f2bf(v); }
__device__ __forceinline__ float lds_ld16(const LAS unsigned char* p) { return bfu(*(const LAS unsigned short*)p); }
__device__ __forceinline__ s16x4 pack4(const f32x4 v) { const unsigned lo = pk2(v[0], v[1]), hi = pk2(v[2], v[3]); s16x4 r; r[0] = (short)(lo & 0xffffu); r[1] = (short)(lo >> 16); r[2] = (short)(hi & 0xffffu); r[3] = (short)(hi >> 16); return r; }
__device__ __forceinline__ int ck_perm(int kp) { const int xt = kp >> 5, w5 = kp & 31, s_ = w5 >> 4, w4 = w5 & 15; return 32 * xt + 16 * s_ + 8 * ((w4 >> 2) & 1) + 4 * (w4 >> 3) + (w4 & 3); }

#define CKDUP(bit) for (int rp_ = 0; rp_ < ((((PROBE_DUP) >> (bit)) & 1) ? 2 : 1); ++rp_)
struct CkRaw { unsigned r[9], k[9], v[9], a[8]; float lw[8]; float prm[6]; };
__device__ __forceinline__ void ck_load(CkRaw& g, int task, int w, int lane, const bf16* Rraw, const bf16* LAo, const float* LWp, const float* mu_l, const float* kk_l, const float* ka_l, const float* rk_l) {
    const int bh = task >> 7, c = task & 127, b = bh >> 3, h = bh & 7; const int hc = h * 64 + lane; const size_t mb = (size_t)b * T + (size_t)c * 64 + 8 * w;
#pragma unroll
    for (int j = 0; j < 9; ++j) { const bool ok = !(j == 0 && c == 0 && w == 0); const bf16* rp = Rraw + (mb + j - 1) * R_COLS + hc;
        g.r[j] = ok ? (unsigned)rp[0] : 0u; g.k[j] = ok ? (unsigned)rp[512] : 0u; g.v[j] = ok ? (unsigned)rp[1024] : 0u; }
#pragma unroll
    for (int j = 0; j < 8; ++j) { g.a[j] = (unsigned)LAo[(mb + j) * RW + hc]; g.lw[j] = LWp[(mb + j) * RW + hc]; }
    g.prm[0] = mu_l[hc]; g.prm[1] = mu_l[512 + hc]; g.prm[2] = mu_l[1024 + hc]; g.prm[3] = kk_l[hc]; g.prm[4] = ka_l[hc]; g.prm[5] = rk_l[hc];
}
__device__ __forceinline__ float bfw(unsigned u) { return __builtin_bit_cast(float, u << 16); }
#define CK_BAR() do { asm volatile("s_waitcnt lgkmcnt(0)" ::: "memory"); __builtin_amdgcn_s_barrier(); asm volatile("" ::: "memory"); } while (0)
__device__ __forceinline__ void rwkv_chunk_local(const Frame& F, int task, int next_task, CkRaw& raw, const bf16* Rraw, const bf16* LAo, const float* LWp, bf16* OAo, bf16* BVo, bf16* PMo, bf16* QMo, bf16* RHo,
                                                 const float* mu_l, const float* kk_l, const float* ka_l, const float* rk_l) {
    const int bh = task >> 7, c = task & 127, b = bh >> 3, h = bh & 7;
    const int lane = F.lane, w = F.wave, q = lane >> 4, c15 = lane & 15;
    LAS unsigned char* L = F.lds + RING_OFF;
    const size_t m0 = (size_t)b * T + (size_t)c * 64;
    const int hc = h * 64 + lane;
    {
        const float mu_r = raw.prm[0], mu_k = raw.prm[1], mu_v = raw.prm[2], kkc = raw.prm[3], kac = raw.prm[4], rkc = raw.prm[5];
        float rr[9], kr[9], vr[9], aa[8], lw[8];
        const size_t mb = m0 + 8 * w;
#pragma unroll
        for (int j = 0; j < 9; ++j) { rr[j] = bfw(raw.r[j]); kr[j] = bfw(raw.k[j]); vr[j] = bfw(raw.v[j]); }
#pragma unroll
        for (int j = 0; j < 8; ++j) { aa[j] = bfw(raw.a[j]); lw[j] = raw.lw[j]; }
        if (next_task >= 0) ck_load(raw, next_task, w, lane, Rraw, LAo, LWp, mu_l, kk_l, ka_l, rk_l);
        float cl[8]; float run = 0.f;
#pragma unroll
        for (int j = 0; j < 8; ++j) { run += lw[j]; cl[j] = run; }
        LAS float* clw = (LAS float*)(L + CK_CLW);
        clw[w * 64 + lane] = run;
        CK_BAR();
        float off = 0.f, tot = 0.f;
#pragma unroll
        for (int ww = 0; ww < 8; ++ww) { const float x = clw[ww * 64 + lane]; tot += x; if (ww < w) off += x; }
        if (w == 0) ((LAS float*)(L + CK_GL))[lane] = __expf(tot);
        float vprev = 0.f, btp = 0.f, ktp = 0.f;
        { const float mu_r2 = mu_r, off2 = off;
#pragma unroll
        for (int j = 0; j < 8; ++j) { const int i = 8 * w + j;
            const float r_ = rr[j + 1] + mu_r2 * (rr[j] - rr[j + 1]), k_ = kr[j + 1] + mu_k * (kr[j] - kr[j + 1]), v_ = vr[j + 1] + mu_v * (vr[j] - vr[j + 1]);
            const float a_ = aa[j];
            const float kk0 = k_ * kkc; const float n2 = wave_sum(kk0 * kk0); const float kkn = kk0 * __builtin_amdgcn_rsqf(fmaxf(n2, 1e-24f));
            const float kmod = k_ * (1.f + (a_ - 1.f) * kac); const float bonus = wave_sum(r_ * kmod * rkc);
            const float cc = off2 + cl[j]; const float g = __expf(cc), gm1 = __expf(cc - lw[j]), gi = __expf(-cc);
            const float At = -kkn * gm1, Rt = r_ * g, Bt = kkn * a_ * gi, Kt = kmod * gi;
            lds_st16(L + CK_AT + i * CK_P + lane * 2, At); lds_st16(L + CK_RT + i * CK_P + lane * 2, Rt); lds_st16(L + CK_BT + i * CK_P + lane * 2, Bt); lds_st16(L + CK_KT + i * CK_P + lane * 2, Kt);
            if (j & 1) {
                *(LAS unsigned*)(L + CK_BTT + lane * CK_P + (i - 1) * 2) = pk2(btp, Bt); *(LAS unsigned*)(L + CK_KTT + lane * CK_P + (i - 1) * 2) = pk2(ktp, Kt); *(LAS unsigned*)(L + CK_VTT + lane * CK_P + (i - 1) * 2) = pk2(vprev, v_);
            } else { btp = Bt; ktp = Kt; vprev = v_; }
            BVo[(mb + j) * RW + hc] = (bf16)f2bf(bonus * v_);
        } }
    }
    CK_BAR();
    if (w == 0) {
#pragma unroll
        for (int d = 0; d < 4; ++d) { f32x4 acc = (f32x4){0.f, 0.f, 0.f, 0.f};
#pragma unroll
            for (int ks = 0; ks < 2; ++ks) acc = __builtin_amdgcn_mfma_f32_16x16x32_bf16(ck_frag(L + CK_AT, 16 * d, ks, lane), ck_frag(L + CK_BT, 16 * d, ks, lane), acc, 0, 0, 0);
#pragma unroll
            for (int r = 0; r < 4; ++r) { const int i = 16 * d + 4 * q + r, jcol = 16 * d + c15; const float val = (jcol < i) ? acc[r] : 0.f;
                lds_st16(L + CK_AAB + i * CK_P + jcol * 2, val); ((LAS float*)(L + CK_DIAG))[(d * 16 + 4 * q + r) * 16 + c15] = val; } }
        asm volatile("s_waitcnt lgkmcnt(0)" ::: "memory");
        const LAS float* Dg = (const LAS float*)(L + CK_DIAG) + q * 256; float t[16];
#pragma unroll
        for (int i = 0; i < 16; ++i) { float a0 = (i == c15) ? 1.f : 0.f, a1 = 0.f, a2 = 0.f, a3 = 0.f;
#pragma unroll
            for (int j = 0; j < i; ++j) { const float pr = Dg[i * 16 + j] * t[j]; if ((j & 3) == 0) a0 += pr; else if ((j & 3) == 1) a1 += pr; else if ((j & 3) == 2) a2 += pr; else a3 += pr; }
            t[i] = (a0 + a1) + (a2 + a3); }
#pragma unroll
        for (int i = 0; i < 16; ++i) lds_st16(L + CK_TBB + ((q * 16 + i) * 16 + c15) * 2, t[i]);
    } else {
        for (int idx = w - 1; idx < 36; idx += 7) {
            int p, ti, tj;
            if (idx < 6) { p = 0; ti = (idx >= 3) ? 3 : ((idx >= 1) ? 2 : 1); tj = idx - (ti * (ti - 1)) / 2; }
            else { const int r_ = idx - 6; p = 1 + r_ / 10; const int n = r_ % 10; ti = (n >= 6) ? 3 : ((n >= 3) ? 2 : ((n >= 1) ? 1 : 0)); tj = n - (ti * (ti + 1)) / 2; }
            LAS unsigned char* Ab = L + (p >> 1) * CK_MSZ; LAS unsigned char* Bb = L + (2 + (p & 1)) * CK_MSZ; LAS unsigned char* Ob = L + (7 + p) * CK_MSZ;
            f32x4 acc = (f32x4){0.f, 0.f, 0.f, 0.f};
#pragma unroll
            for (int ks = 0; ks < 2; ++ks) acc = __builtin_amdgcn_mfma_f32_16x16x32_bf16(ck_frag(Ab, 16 * ti, ks, lane), ck_frag(Bb, 16 * tj, ks, lane), acc, 0, 0, 0);
            const int jcol = 16 * tj + c15;
#pragma unroll
            for (int r = 0; r < 4; ++r) { const int i = 16 * ti + 4 * q + r; const bool keep = (p < 2) ? (jcol < i) : (jcol <= i); const float val = keep ? acc[r] : 0.f;
                lds_st16(Ob + i * CK_P + jcol * 2, val);
                if (ti != tj) lds_st16(Ob + (16 * tj + 4 * q + r) * CK_P + (16 * ti + c15) * 2, 0.f); }
        }
    }
    CK_BAR();
    {
        f32x4 z[4];
        const int ntile = w & 3;
        if (w < 4) {
#pragma unroll
            for (int bb = 0; bb < 4; ++bb)
#pragma unroll
                for (int r = 0; r < 4; ++r) z[bb][r] = lds_ld16(L + CK_AT + (16 * bb + 4 * q + r) * CK_P + (16 * ntile + c15) * 2);
        } else {
#pragma unroll
            for (int bb = 0; bb < 4; ++bb) { f32x4 acc = (f32x4){0.f, 0.f, 0.f, 0.f};
#pragma unroll
                for (int ks = 0; ks < 2; ++ks) acc = __builtin_amdgcn_mfma_f32_16x16x32_bf16(ck_frag(L + CK_AAK, 16 * bb, ks, lane), ck_frag(L + CK_VTT, 16 * ntile, ks, lane), acc, 0, 0, 0);
                z[bb] = acc; }
        }
        s16x4 xb[4];
        LAS unsigned char* dst = L + ((w < 4) ? CK_WT : CK_ULT);
#pragma unroll
        for (int bb = 0; bb < 4; ++bb) { f32x4 zz = z[bb];
#pragma unroll
            for (int b2 = 0; b2 < bb; ++b2) { const s16x4 a4 = *(const LAS s16x4*)(L + CK_AAB + (16 * bb + c15) * CK_P + (16 * b2 + 4 * q) * 2); zz = __builtin_amdgcn_mfma_f32_16x16x16bf16_1k(a4, xb[b2], zz, 0, 0, 0); }
            const s16x4 zb = pack4(zz); const s16x4 t4 = *(const LAS s16x4*)(L + CK_TBB + ((bb * 16 + c15) * 16 + 4 * q) * 2);
            const f32x4 x = __builtin_amdgcn_mfma_f32_16x16x16bf16_1k(t4, zb, (f32x4){0.f, 0.f, 0.f, 0.f}, 0, 0, 0);
            xb[bb] = pack4(x);
            *(LAS s16x4*)(dst + (16 * ntile + c15) * CK_P + (16 * bb + 4 * q) * 2) = xb[bb]; }
    }
    CK_BAR();
    bf16* pmo = PMo + (size_t)task * 4096; bf16* qmo = QMo + (size_t)task * 4096; bf16* rho = RHo + (size_t)task * 4096;
    {
        const int ti = w >> 1; const LAS float* GLp = (const LAS float*)(L + CK_GL);
#pragma unroll
        for (int tt = 0; tt < 2; ++tt) { const int tj = 2 * (w & 1) + tt; const int col = 16 * tj + c15, row0 = 16 * ti + 4 * q;
            f32x4 aP = (f32x4){0.f, 0.f, 0.f, 0.f}, aQ = aP, aR = aP, aY = aP;
#pragma unroll
            for (int ks = 0; ks < 2; ++ks) {
                const pg8::bf16x8 fWr = ck_frag(L + CK_WT, 16 * ti, ks, lane), fBc = ck_frag(L + CK_BTT, 16 * tj, ks, lane);
                const pg8::bf16x8 fBr = ck_frag(L + CK_BTT, 16 * ti, ks, lane), fKr = ck_frag(L + CK_KTT, 16 * ti, ks, lane), fUc = ck_frag(L + CK_ULT, 16 * tj, ks, lane), fVc = ck_frag(L + CK_VTT, 16 * tj, ks, lane);
                const pg8::bf16x8 fRbc = ck_frag(L + CK_ARB, 16 * tj, ks, lane), fRkc = ck_frag(L + CK_ARK, 16 * tj, ks, lane);
                const pg8::bf16x8 fUr = ck_frag(L + CK_ULT, 16 * ti, ks, lane), fVr = ck_frag(L + CK_VTT, 16 * ti, ks, lane);
                aP = __builtin_amdgcn_mfma_f32_16x16x32_bf16(fWr, fBc, aP, 0, 0, 0);
                aQ = __builtin_amdgcn_mfma_f32_16x16x32_bf16(fBr, fUc, aQ, 0, 0, 0); aQ = __builtin_amdgcn_mfma_f32_16x16x32_bf16(fKr, fVc, aQ, 0, 0, 0);
                aR = __builtin_amdgcn_mfma_f32_16x16x32_bf16(fWr, fRbc, aR, 0, 0, 0);
                aY = __builtin_amdgcn_mfma_f32_16x16x32_bf16(fUr, fRbc, aY, 0, 0, 0); aY = __builtin_amdgcn_mfma_f32_16x16x32_bf16(fVr, fRkc, aY, 0, 0, 0);
            }
            { const float gl = GLp[col]; pg8::u32x2 o; o.x = pk2(gl * (aP[0] + ((row0 == col) ? 1.f : 0.f)), gl * (aP[1] + ((row0 + 1 == col) ? 1.f : 0.f)));
              o.y = pk2(gl * (aP[2] + ((row0 + 2 == col) ? 1.f : 0.f)), gl * (aP[3] + ((row0 + 3 == col) ? 1.f : 0.f))); *(pg8::u32x2*)(pmo + col * 64 + ck_perm(row0)) = o; }
            { const f32x4 gl4 = *(const LAS f32x4*)(GLp + row0); const int vt = col >> 5, cq = col & 31, kt = row0 >> 5, k5 = row0 & 31, hh = (k5 >> 2) & 1, rg = 4 * (k5 >> 3);
              pg8::u32x2 o; o.x = pk2(gl4[0] * aQ[0], gl4[1] * aQ[1]); o.y = pk2(gl4[2] * aQ[2], gl4[3] * aQ[3]); *(pg8::u32x2*)(qmo + ((vt * 2 + kt) * 64 + 32 * hh + cq) * 16 + rg) = o; }
            { pg8::u32x2 rt = *(const LAS pg8::u32x2*)(L + CK_RT + col * CK_P + row0 * 2); pg8::u32x2 o; o.x = pk2(aR[0] + bflo(rt.x), aR[1] + bfhi(rt.x)); o.y = pk2(aR[2] + bflo(rt.y), aR[3] + bfhi(rt.y)); *(pg8::u32x2*)(rho + col * 64 + row0) = o; }
            { pg8::u32x2 o; o.x = pk2(aY[0], aY[1]); o.y = pk2(aY[2], aY[3]); *(pg8::u32x2*)(OAo + (m0 + col) * RW + h * 64 + row0) = o; }
        }
    }
    CK_BAR();
}

__device__ __forceinline__ void rwkv_carry(const Frame& F, int bh, const bf16* PMi, const bf16* QMio, bf16* SCo) {
    const int w = F.wave, lane = F.lane, r31 = lane & 31, hh = lane >> 5, vt = w & 1;
    LAS unsigned char* ring = F.lds + RING_OFF; const unsigned ringb = (unsigned)(uintptr_t)ring;
    const char* pm = (const char*)(PMi + (size_t)bh * 128 * 4096); const char* qm = (const char*)(QMio + (size_t)bh * 128 * 4096); bf16* sco = SCo + (size_t)bh * 128 * 4096;
    constexpr int R = 6, SLOT = 16384;
    const int lw4 = (w - 2) * 4;
    unsigned voffp[4];
#pragma unroll
    for (int i = 0; i < 4; ++i) { const int p = lw4 + i; voffp[i] = (p < 8) ? (unsigned)((8 * p + (lane >> 3)) * 128 + (((lane & 7) ^ ((lane >> 3) & 7)) * 16)) : (unsigned)((p - 8) * 1024 + lane * 16); }
#define CY_ISSUE(cc) do { const int sl_ = (cc) % R; _Pragma("unroll") for (int i = 0; i < 4; ++i) { const int p = lw4 + i; \
        pg8::glds16s(((p < 8) ? pm : qm) + (size_t)(cc) * 8192, voffp[i], (unsigned)__builtin_amdgcn_readfirstlane((int)(ringb + sl_ * SLOT + p * 1024))); } } while (0)
    f32x16 S0, S1;
#pragma unroll
    for (int i = 0; i < 16; ++i) { S0[i] = 0.f; S1[i] = 0.f; }
    if (w >= 2 && w < 6) {
#pragma unroll
        for (int cc = 0; cc < R - 1; ++cc) CY_ISSUE(cc);
        asm volatile("s_waitcnt vmcnt(16)" ::: "memory");
    }
    __builtin_amdgcn_s_barrier();
    for (int c = 0; c < 128; ++c) {
        if (w >= 2 && w < 6) {
            if (c + R - 1 < 128) { CY_ISSUE(c + R - 1); asm volatile("s_waitcnt vmcnt(16)" ::: "memory"); }
            else asm volatile("s_waitcnt vmcnt(0)" ::: "memory");
        } else if (w < 2) {
            const LAS unsigned char* slot = ring + (c % R) * SLOT;
            pg8::bf16x8 pa[2][4]; pg8::u32x4 qa[2][2];
#pragma unroll
            for (int kt = 0; kt < 2; ++kt) { const int row = 32 * kt + r31;
#pragma unroll
                for (int s4 = 0; s4 < 4; ++s4) pa[kt][s4] = *(const LAS pg8::bf16x8*)(slot + row * 128 + (((2 * s4 + hh) ^ (row & 7)) * 16));
                const LAS pg8::u32x4* qp = (const LAS pg8::u32x4*)(slot + 8192 + ((vt * 2 + kt) * 64 + lane) * 32); qa[kt][0] = qp[0]; qa[kt][1] = qp[1]; }
            pg8::bf16x8 bx[4];
#pragma unroll
            for (int s = 0; s < 2; ++s) { pg8::u32x4 t0, t1;
                t0.x = pg8::cvt_pk_bf16(S0[8 * s + 0], S0[8 * s + 1]); t0.y = pg8::cvt_pk_bf16(S0[8 * s + 2], S0[8 * s + 3]); t0.z = pg8::cvt_pk_bf16(S0[8 * s + 4], S0[8 * s + 5]); t0.w = pg8::cvt_pk_bf16(S0[8 * s + 6], S0[8 * s + 7]);
                t1.x = pg8::cvt_pk_bf16(S1[8 * s + 0], S1[8 * s + 1]); t1.y = pg8::cvt_pk_bf16(S1[8 * s + 2], S1[8 * s + 3]); t1.z = pg8::cvt_pk_bf16(S1[8 * s + 4], S1[8 * s + 5]); t1.w = pg8::cvt_pk_bf16(S1[8 * s + 6], S1[8 * s + 7]);
                bx[s] = __builtin_bit_cast(pg8::bf16x8, t0); bx[2 + s] = __builtin_bit_cast(pg8::bf16x8, t1); }
            { bf16* sc = sco + (size_t)c * 4096 + (32 * vt + r31) * 64;
#pragma unroll
              for (int g4 = 0; g4 < 4; ++g4) { const pg8::u32x4 t0 = __builtin_bit_cast(pg8::u32x4, bx[g4 >> 1]), t1 = __builtin_bit_cast(pg8::u32x4, bx[2 + (g4 >> 1)]);
                  pg8::u32x2 o0, o1; if (g4 & 1) { o0.x = t0.z; o0.y = t0.w; o1.x = t1.z; o1.y = t1.w; } else { o0.x = t0.x; o0.y = t0.y; o1.x = t1.x; o1.y = t1.y; }
                  *(pg8::u32x2*)(sc + 8 * g4 + 4 * hh) = o0; *(pg8::u32x2*)(sc + 32 + 8 * g4 + 4 * hh) = o1; } }
            f32x16 N0, N1;
#pragma unroll
            for (int kt = 0; kt < 2; ++kt) { f32x16 n;
#pragma unroll
                for (int i = 0; i < 2; ++i) { const pg8::u32x4 wq = qa[kt][i]; n[8 * i + 0] = bflo(wq.x); n[8 * i + 1] = bfhi(wq.x); n[8 * i + 2] = bflo(wq.y); n[8 * i + 3] = bfhi(wq.y); n[8 * i + 4] = bflo(wq.z); n[8 * i + 5] = bfhi(wq.z); n[8 * i + 6] = bflo(wq.w); n[8 * i + 7] = bfhi(wq.w); }
#pragma unroll
                for (int s4 = 0; s4 < 4; ++s4) n = __builtin_amdgcn_mfma_f32_32x32x16_bf16(pa[kt][s4], bx[s4], n, 0, 0, 0);
                if (kt == 0) N0 = n; else N1 = n; }
            S0 = N0; S1 = N1;
        }
        asm volatile("s_waitcnt lgkmcnt(0)" ::: "memory");
        __builtin_amdgcn_s_barrier();
    }
#undef CY_ISSUE
    asm volatile("s_waitcnt vmcnt(0)" ::: "memory");
    __syncthreads();
}

struct FxRaw { pg8::bf16x8 bR[2], aS[2][4]; pg8::u32x2 yw[4], bw[4], gw[4]; };
__device__ __forceinline__ void fx_load(FxRaw& g, int pair, int w, int lane, const bf16* RHi, const bf16* SCi, const bf16* OAi, const bf16* BVi, const bf16* LGi) {
    const int q = lane >> 4, c15 = lane & 15, ti = w & 3; const int chunk = 2 * pair + (w >> 2), bh = chunk >> 7, c = chunk & 127, b = bh >> 3, h = bh & 7;
    const bf16* rh = RHi + (size_t)chunk * 4096; const bf16* sc = SCi + (size_t)chunk * 4096;
    const size_t base = ((size_t)b * T + (size_t)c * 64 + 16 * ti + c15) * RW + h * 64 + 4 * q;
#pragma unroll
    for (int ks = 0; ks < 2; ++ks) { g.bR[ks] = *(const pg8::bf16x8*)(rh + (16 * ti + c15) * 64 + 32 * ks + 8 * q);
#pragma unroll
        for (int tv = 0; tv < 4; ++tv) g.aS[ks][tv] = *(const pg8::bf16x8*)(sc + (16 * tv + c15) * 64 + 32 * ks + 8 * q); }
#pragma unroll
    for (int tv = 0; tv < 4; ++tv) { g.yw[tv] = *(const pg8::u32x2*)(OAi + base + 16 * tv); g.bw[tv] = *(const pg8::u32x2*)(BVi + base + 16 * tv); g.gw[tv] = *(const pg8::u32x2*)(LGi + base + 16 * tv); }
}
__device__ __forceinline__ void rwkv_fixup(const Frame& F, int pair, const FxRaw& g, bf16* OAo, const float* lnx_g, const float* lnx_b) {
    const int lane = F.lane, w = F.wave, q = lane >> 4, c15 = lane & 15, ti = w & 3;
    const int chunk = 2 * pair + (w >> 2), bh = chunk >> 7, c = chunk & 127, b = bh >> 3, h = bh & 7;
    const size_t base = ((size_t)b * T + (size_t)c * 64 + 16 * ti + c15) * RW + h * 64 + 4 * q;
    f32x4 acc[4];
#pragma unroll
    for (int tv = 0; tv < 4; ++tv) acc[tv] = (f32x4){0.f, 0.f, 0.f, 0.f};
#pragma unroll
    for (int ks = 0; ks < 2; ++ks)
#pragma unroll
        for (int tv = 0; tv < 4; ++tv) acc[tv] = __builtin_amdgcn_mfma_f32_16x16x32_bf16(g.aS[ks][tv], g.bR[ks], acc[tv], 0, 0, 0);
    float s = 0.f;
#pragma unroll
    for (int tv = 0; tv < 4; ++tv) { const pg8::u32x2 yw = g.yw[tv]; acc[tv][0] += bflo(yw.x); acc[tv][1] += bfhi(yw.x); acc[tv][2] += bflo(yw.y); acc[tv][3] += bfhi(yw.y);
        s += (acc[tv][0] + acc[tv][1]) + (acc[tv][2] + acc[tv][3]); }
    s += __shfl_xor(s, 16); s = swap32_add(s); const float mean = s * (1.f / 64.f); float qv = 0.f;
#pragma unroll
    for (int tv = 0; tv < 4; ++tv) { acc[tv] = acc[tv] - mean; qv += (acc[tv][0] * acc[tv][0] + acc[tv][1] * acc[tv][1]) + (acc[tv][2] * acc[tv][2] + acc[tv][3] * acc[tv][3]); }
    qv += __shfl_xor(qv, 16); qv = swap32_add(qv); const float rstd = __builtin_amdgcn_rsqf(qv * (1.f / 64.f) + RWKV_LN_EPS);
#pragma unroll
    for (int tv = 0; tv < 4; ++tv) { const f32x4 lg = *(const f32x4*)(lnx_g + h * 64 + 16 * tv + 4 * q), lb = *(const f32x4*)(lnx_b + h * 64 + 16 * tv + 4 * q);
        const pg8::u32x2 bw = g.bw[tv], gw = g.gw[tv];
        const f32x4 bv = (f32x4){bflo(bw.x), bfhi(bw.x), bflo(bw.y), bfhi(bw.y)}, gv = (f32x4){bflo(gw.x), bfhi(gw.x), bflo(gw.y), bfhi(gw.y)};
        const f32x4 o = (acc[tv] * rstd * lg + lb + bv) * gv;
        pg8::u32x2 ow; ow.x = pk2(o[0], o[1]); ow.y = pk2(o[2], o[3]); *(pg8::u32x2*)(OAo + base + 16 * tv) = ow; }
}

__global__ void __launch_bounds__(NWAVES * 64, 2) mk_fwd(Args args) {
    extern __shared__ __attribute__((aligned(16))) unsigned char lds[];
    {
        const int t0_ = threadIdx.x;
        for (int u = t0_; u < (LDS_BYTES - LDSCTL_OFF) / 4; u += NWAVES * 64) ((LAS unsigned*)((LAS unsigned char*)lds + LDSCTL_OFF))[u] = 0u;
        __syncthreads();
    }
    const int wave_k_ = __builtin_amdgcn_readfirstlane((int)threadIdx.x >> 6);
    XcdBarrier bar = xcd_barrier_post((unsigned*)((gu32*)(args.ws + WS_CTL) + CW_BAR), (volatile LAS unsigned*)((LAS unsigned char*)lds + MISC_OFF) + 8);
#define GRID_BAR1() do { XcdBarrier b2_ = bar; asm volatile("" : "+s"(b2_.bar), "+s"(b2_.x)); xcd_barrier(b2_); } while (0)
#if (PROBE_DUP >> 8) & 1
#define GRID_BAR() do { GRID_BAR1(); GRID_BAR1(); } while (0)
#else
#define GRID_BAR() GRID_BAR1()
#endif
#ifndef PROBE_DUP
#define PROBE_DUP 0
#endif
#define DUP(bit) for (int dup_ = 0; dup_ < ((((PROBE_DUP) >> (bit)) & 1) ? 2 : 1); ++dup_)
#define PH_BEGIN GAS unsigned char* ws = (GAS unsigned char*)args.ws; GAS float* outp = (GAS float*)args.out; int wv_o_ = wave_k_, bx = blockIdx.x; asm volatile("" : "+s"(ws), "+s"(outp), "+s"(wv_o_), "+s"(bx)); \
    int tid_o_; asm volatile("v_mbcnt_lo_u32_b32 %0, -1, 0\n\tv_mbcnt_hi_u32_b32 %0, -1, %0" : "=v"(tid_o_)); tid_o_ += wv_o_ * 64; \
    gu32* ctl = (gu32*)(ws + WS_CTL); (void)ctl; Frame F; F.lds = (LAS unsigned char*)lds; F.MISC = (volatile LAS unsigned*)(F.lds + MISC_OFF); F.ctl = ctl; \
    F.tid = tid_o_; F.lane = F.tid & 63; F.wave = __builtin_amdgcn_readfirstlane(F.tid >> 6); F.G = NG; F.vcu = (bx % 8) * (NG / 8) + bx / 8; \
    const int lane = F.lane, gw = F.vcu * NWAVES + F.wave; (void)lane; (void)gw
#define GIN(k) ((const float*)(const GAS float*)args.in[k])
#define FL ((float*)(ws + WS_FL))
#define CB ((float*)(ws + WS_CB))
#define TOKE ((unsigned*)(ws + WS_TOKE))
#define TOKG ((float*)(ws + WS_TOKG))
#define PPOS ((unsigned*)(ws + WS_PPOS))
#define RTOK ((int*)(ws + WS_RTOK))
#define WL ((bf16*)(ws + WS_WL))
#define X ((bf16*)(ws + WS_X))
#define WIN ((bf16*)(ws + WS_WIN))
#define WUP ((bf16*)(ws + WS_WUP))
#define WOUT ((bf16*)(ws + WS_WOUT))
#define W13 ((bf16*)(ws + WS_W13))
#define W2 ((bf16*)(ws + WS_W2))
#define Cb ((bf16*)(ws + WS_C))
#define FQ ((bf16*)(ws + WS_FQ))
#define FK ((bf16*)(ws + WS_FK))
#define FV ((bf16*)(ws + WS_FV))
#define LA ((bf16*)(ws + WS_LA))
#define LW ((float*)(ws + WS_LW))
#define LAO ((bf16*)(ws + WS_LAO))
#define LG ((bf16*)(ws + WS_LG))
#define OB ((bf16*)(ws + WS_OB))
#define OA ((bf16*)(ws + WS_OA))
#define BV ((bf16*)(ws + WS_BV))
#define G2 ((bf16*)(ws + WS_G2))
#define PMB ((bf16*)(ws + WS_PM))
#define QMB ((bf16*)(ws + WS_QM))
#define RHB ((bf16*)(ws + WS_RH))
#define MG ((bf16*)(ws + WS_MG))
#define H ((bf16*)(ws + WS_H))
#define WM13 ((bf16*)(ws + WS_WM13))
#define WM2 ((bf16*)(ws + WS_WM2))
#define HM ((bf16*)(ws + WS_HM))
#define YP ((bf16*)(ws + WS_YP))
#define YPS ((bf16*)(ws + WS_YPS))
#define Rr ((bf16*)outp)
#define G0 ((bf16*)outp)
#define G1 ((bf16*)outp + (size_t)M * D)
#define Y ((bf16*)outp)

    {
        PH_BEGIN;
        LAS float* scr = (LAS float*)(F.lds + RING_OFF + F.wave * 16384);
        constexpr int I_IN = (INP_N / 32) * 16, I_UP = 32 * 8, I_OUT = 32 * 16, I_13 = (2 * DFF / 32) * 16, I_2 = 32 * (DFF / 64), I_L = 48 * 4;
        constexpr int NITEMS = 2 * I_IN + 6 * I_UP + 2 * I_OUT + I_13 + I_2 + 2 * I_L;
        DUP(2) for (int it = gw; it < NITEMS; it += NGW) {
            int r = it;
            if (r < 2 * I_IN) { const int l = r / I_IN; r -= l * I_IN; const int rg = r >> 4, kb = r & 15, d0 = 32 * rg; int n0 = d0, nv = 32;
                if (d0 >= INA_N) n0 = d0 - 248; else if (d0 > 4864) nv = 0; else if (d0 == 4864) nv = 8;
                else if (d0 >= 2304 && d0 < 3328) { const int tw = d0 - 2304, tau = tw >> 8, w_ = tw & 255; n0 = (w_ < 128) ? 2304 + 128 * tau + w_ : 2816 + 128 * tau + (w_ - 128); }
                const float sc = (d0 >= 3328 && d0 < 3840) ? attn_body::C2 : 1.f;
                tr_item(GIN(3) + (size_t)l * D * IN_COLS, IN_COLS, 64 * kb, n0, nv, WIN + ((size_t)l * INP_N + d0) * D, D, 64 * kb, sc, scr, lane); continue; }
            r -= 2 * I_IN;
            if (r < 6 * I_UP) { const int q = r / I_UP; r -= q * I_UP; const int l = q / 3, br = q % 3; const int rg = r >> 3, kb = r & 7;
                const float* W = args.in[18 + br] + (size_t)l * RW * D;
                tr_item(W, D, 64 * kb, 32 * rg, 32, WUP + ((size_t)l * D + 32 * rg) * (3 * RW), 3 * RW, br * RW + 64 * kb, 1.f, scr, lane); continue; }
            r -= 6 * I_UP;
            if (r < 2 * I_OUT) { const int l = r / I_OUT; r -= l * I_OUT; const int rg = r >> 4, kb = r & 15;
                tr_item(GIN(21) + (size_t)l * D * D, D, 64 * kb, 32 * rg, 32, WOUT + ((size_t)l * D + 32 * rg) * D, D, 64 * kb, 1.f, scr, lane); continue; }
            r -= 2 * I_OUT;
            if (r < I_13) { const int rg = r >> 4, kb = r & 15, d0 = 32 * rg, tile = d0 >> 8, within = d0 & 255;
                const float* W = (within < 128) ? GIN(26) : GIN(27);
                tr_item(W, DFF, 64 * kb, tile * 128 + (within & 127), 32, W13 + (size_t)d0 * D, D, 64 * kb, 1.f, scr, lane); continue; }
            r -= I_13;
            if (r < I_2) { const int rg = r / (DFF / 64), kb = r % (DFF / 64);
                tr_item(GIN(28), D, 64 * kb, 32 * rg, 32, W2 + (size_t)(32 * rg) * DFF, DFF, 64 * kb, 1.f, scr, lane); continue; }
            r -= I_2;
            { const int l = r / I_L; r -= l * I_L; const int rg = r >> 2, kb = r & 3; const float* W = nullptr; int ldw = RW, sk0 = 0, n0 = 0, nv = 0;
                if (rg < 16) { if (kb == 0) { W = GIN(6) + (size_t)l * 64 * RW; n0 = 32 * rg; nv = 32; } }
                else if (rg < 32) { if (kb == 1) { W = GIN(8) + (size_t)l * 64 * RW; n0 = 32 * (rg - 16); nv = 32; } }
                else { if (kb >= 2) { W = GIN(9) + (size_t)l * 128 * RW; sk0 = 64 * (kb - 2); n0 = 32 * (rg - 32); nv = 32; } }
                tr_item(W, ldw, sk0, n0, nv, WL + ((size_t)l * 1536 + 32 * rg) * 256, 256, 64 * kb, 1.f, scr, lane); }
        }
        { LnGB q; ln_load_gb(q, GIN(1), GIN(2), lane); f32x4 nx[4];
            { const GAS f32x4* xr = (const GAS f32x4*)(GIN(0) + (size_t)gw * D) + lane;
#pragma unroll
              for (int j = 0; j < 4; ++j) nx[j] = xr[64 * j]; }
            DUP(7) for (int m = gw; m < M; m += NGW) { f32x4 v[4];
#pragma unroll
                for (int j = 0; j < 4; ++j) v[j] = nx[j];
                if (m + NGW < M) { const GAS f32x4* xr = (const GAS f32x4*)(GIN(0) + (size_t)(m + NGW) * D) + lane;
#pragma unroll
                    for (int j = 0; j < 4; ++j) nx[j] = xr[64 * j]; }
                ln_norm_r(v, q); row_store_bf16(X + (size_t)m * D, v, lane); } }
    }
    GRID_BAR();

{ constexpr int l = 0;

        {
            PH_BEGIN;
            pg8::Gemm g{X, WIN + (size_t)l * INP_N * D, 0, nullptr}; pg8::StaticOrder S; S.init(M, INA_N, NG, bx);
            pg8::EpiInA E{Rr, Cb, FQ, FL, (size_t)(WS_FK - WS_FQ) / 2};
            DUP(1) pg8::gemm_phase<pg8::EpiInA, pg8::StaticOrder, true, false, D, D, D>(F.lds + RING_OFF, g, S, E);
#ifdef PROBE_A1MODE
            { pg8::EpiSink E9{(float*)LW}; pg8::gemm_phase<pg8::EpiSink, pg8::StaticOrder, true, false, D, D, D, false, PROBE_A1MODE>(F.lds + RING_OFF, g, S, E9); }
#endif
        }
        GRID_BAR();
        {
            PH_BEGIN;
            LAS unsigned* nrm = (LAS unsigned*)(F.lds + NRM_OFF);
            if (F.tid < 96) nrm[F.tid] = 0u;
            __syncthreads();
            if (F.vcu < 32) {
                const int bh = F.vcu, b = bh >> 3, h = bh & 7; const float bf_ = GIN(16)[l * 8 + h];
                LAS float* tot = (LAS float*)(F.lds + RING_OFF);
                float loc[16]; float run = 0.f; const int t0 = F.tid * 16;
#pragma unroll
                for (int i = 0; i < 16; ++i) { const float f = FL[((size_t)b * T + t0 + i) * 8 + h] + bf_; const float ls = fminf(f, 0.f) - log1pf(__expf(-fabsf(f))); run += ls; loc[i] = run; }
                tot[F.tid] = run; __syncthreads();
                float pre = 0.f; for (int i = 0; i < F.tid; ++i) pre += tot[i];
#pragma unroll
                for (int i = 0; i < 16; ++i) CB[(size_t)bh * T + t0 + i] = -(pre + loc[i]) * LOG2E;
                __syncthreads();
            }
            const float* mu = GIN(4) + (size_t)l * R_COLS + 1536; const float* cw = GIN(15) + (size_t)l * 3 * RW;
            const f32x4 mu4 = *(const f32x4*)(mu + 4 * lane);
            f32x4 w0a = *(const f32x4*)(cw + 8 * lane), w0b = *(const f32x4*)(cw + 8 * lane + 4), w1a = *(const f32x4*)(cw + RW + 8 * lane), w1b = *(const f32x4*)(cw + RW + 8 * lane + 4),
                  w2a = *(const f32x4*)(cw + 2 * RW + 8 * lane), w2b = *(const f32x4*)(cw + 2 * RW + 8 * lane + 4);
            struct A2Raw { pg8::u32x2 cu, pv; pg8::u32x4 b, u0, u1, u2, fq, fk; };
            auto a2_fetch = [&](A2Raw& r, int m) { const int t = m & (T - 1);
                const bf16* rp = Rr + (size_t)m * R_COLS + 1536 + 4 * lane; r.cu = *(const pg8::u32x2*)rp; r.pv = (pg8::u32x2){0u, 0u}; if (t > 0) r.pv = *(const pg8::u32x2*)(rp - R_COLS);
                const bf16* cp = Cb + (size_t)m * C_COLS + 8 * lane; const pg8::u32x4 z4 = (pg8::u32x4){0u, 0u, 0u, 0u};
                r.b = *(const pg8::u32x4*)cp; r.u0 = *(const pg8::u32x4*)(cp + 512);
                r.fq = *(const pg8::u32x4*)(FQ + (size_t)m * RW + 8 * lane); r.fk = *(const pg8::u32x4*)(FK + (size_t)m * RW + 8 * lane);
                r.u1 = z4; r.u2 = z4;
                if (t >= 1) r.u1 = *(const pg8::u32x4*)(cp - C_COLS + 512);
                if (t >= 2) r.u2 = *(const pg8::u32x4*)(cp - 2 * C_COLS + 512); };
            A2Raw nx; a2_fetch(nx, gw); float mq = 0.f, mk = 0.f, md = 0.f;
            DUP(3) for (int m = gw; m < M; m += NGW) {
                const A2Raw r = nx; if (m + NGW < M) a2_fetch(nx, m + NGW);
                {
                    f32x4 a0, a1; pg8::unpack8(r.fq, a0, a1); float sq = (a0[0] * a0[0] + a0[1] * a0[1]) + (a0[2] * a0[2] + a0[3] * a0[3]) + (a1[0] * a1[0] + a1[1] * a1[1]) + (a1[2] * a1[2] + a1[3] * a1[3]);
                    f32x4 k0, k1; pg8::unpack8(r.fk, k0, k1); float dq = (a0[0] * k0[0] + a0[1] * k0[1]) + (a0[2] * k0[2] + a0[3] * k0[3]) + (a1[0] * k1[0] + a1[1] * k1[1]) + (a1[2] * k1[2] + a1[3] * k1[3]);
                    a0 = k0; a1 = k1; float sk = (a0[0] * a0[0] + a0[1] * a0[1]) + (a0[2] * a0[2] + a0[3] * a0[3]) + (a1[0] * a1[0] + a1[1] * a1[1]) + (a1[2] * a1[2] + a1[3] * a1[3]);
                    sq += __shfl_xor(sq, 1); sk += __shfl_xor(sk, 1); dq += __shfl_xor(dq, 1); sq += __shfl_xor(sq, 2); sk += __shfl_xor(sk, 2); dq += __shfl_xor(dq, 2); sq += __shfl_xor(sq, 4); sk += __shfl_xor(sk, 4); dq += __shfl_xor(dq, 4);
                    mq = fmaxf(mq, sq); mk = fmaxf(mk, sk); md = fmaxf(md, -dq);
                    if (((m >> 11) & 3) == 3) {
                        if ((lane & 7) == 0) { LAS unsigned* e = nrm + ((m >> 13) * 8 + (lane >> 3)) * 3;
                            __hip_atomic_fetch_max(e, __float_as_uint(mq), __ATOMIC_RELAXED, __HIP_MEMORY_SCOPE_WORKGROUP); __hip_atomic_fetch_max(e + 1, __float_as_uint(mk), __ATOMIC_RELAXED, __HIP_MEMORY_SCOPE_WORKGROUP);
                            __hip_atomic_fetch_max(e + 2, __float_as_uint(md), __ATOMIC_RELAXED, __HIP_MEMORY_SCOPE_WORKGROUP); }
                        mq = 0.f; mk = 0.f; md = 0.f; }
                }
                {
                    const pg8::u32x2 cu = r.cu, pv = r.pv;
                    f32x4 c4 = (f32x4){bflo(cu.x), bfhi(cu.x), bflo(cu.y), bfhi(cu.y)}, p4 = (f32x4){bflo(pv.x), bfhi(pv.x), bflo(pv.y), bfhi(pv.y)};
                    f32x4 o = c4 + mu4 * (p4 - c4);
                    if (lane < 16) {
#pragma unroll
                        for (int j = 0; j < 4; ++j) o[j] = 2.f * sigm(2.f * o[j]) - 1.f;
                    } else if (lane >= 32) {
#pragma unroll
                        for (int j = 0; j < 4; ++j) o[j] = sigm(o[j]);
                    }
                    pg8::u32x2 ou; ou.x = pk2(o[0], o[1]); ou.y = pk2(o[2], o[3]); *(pg8::u32x2*)(LA + (size_t)m * 256 + 4 * lane) = ou;
                }
                {
                    f32x4 ba, bb, u0a, u0b, u1a, u1b, u2a, u2b; pg8::unpack8(r.b, ba, bb); pg8::unpack8(r.u0, u0a, u0b); pg8::unpack8(r.u1, u1a, u1b); pg8::unpack8(r.u2, u2a, u2b);
                    const f32x4 ya = ba * (w0a * u2a + w1a * u1a + w2a * u0a), yb = bb * (w0b * u2b + w1b * u1b + w2b * u0b);
                    *(pg8::u32x4*)(OB + (size_t)m * RW + 8 * lane) = pg8::pack8(ya, yb);
                }
            }
            __syncthreads();
            if (F.tid < 96) { const unsigned v = nrm[F.tid]; if (v) __hip_atomic_fetch_max(ctl + CW_NRM + 128 * l + F.tid, v, RLX_AGENT); }
        }
        GRID_BAR();
        {
            PH_BEGIN;
            pg8::Gemm g{LA, WL + (size_t)l * 1536 * 256, 0, nullptr}; pg8::StaticOrder S; S.init(M, 1536, NG, bx);
            pg8::EpiLora E{LW, LAO, LG, GIN(5) + (size_t)l * RW, GIN(7) + (size_t)l * RW};
            DUP(1) pg8::gemm_phase<pg8::EpiLora, pg8::StaticOrder, true, false, 256, 256, 256>(F.lds + RING_OFF, g, S, E);
        }
        GRID_BAR();
        {
            PH_BEGIN;
#define CK_TASK(it_) (((4 * (bx & 7) + ((((it_) * 32 + (bx >> 3))) >> 7)) << 7) + ((((it_) * 32 + (bx >> 3))) & 127))
            CkRaw raw; ck_load(raw, CK_TASK(0), F.wave, lane, Rr, LAO, LW, GIN(4) + (size_t)l * R_COLS, GIN(10) + (size_t)l * RW, GIN(11) + (size_t)l * RW, GIN(12) + (size_t)l * RW);
            for (int it = 0; it < 16; ++it)
                rwkv_chunk_local(F, CK_TASK(it), (it + 1 < 16) ? CK_TASK(it + 1) : -1, raw, Rr, LAO, LW, OA, BV, PMB, QMB, RHB, GIN(4) + (size_t)l * R_COLS, GIN(10) + (size_t)l * RW, GIN(11) + (size_t)l * RW, GIN(12) + (size_t)l * RW);
        }
        GRID_BAR();
        {
            PH_BEGIN;
            const int grp = bx & 7, jj = bx >> 3;
#if (PROBE_DUP >> 5) & 1
            if (jj < 4) rwkv_carry(F, grp * 4 + jj, PMB, QMB, (bf16*)outp);
#endif
            if (jj < 4) rwkv_carry(F, grp * 4 + jj, PMB, QMB, QMB);
#if (PROBE_DUP >> 15) & 1
            { const attn_orig::AttnTensors AT3{(const attn_orig::bf16*)FQ, (const attn_orig::bf16*)FK, (const attn_orig::bf16*)FV, (attn_orig::bf16*)outp};
              struct DynO { gu32* ctr; volatile LAS unsigned* slot; int grp;
                __device__ __forceinline__ bool next(int, attn_orig::AttnUnit& u) const { if (threadIdx.x == 0) slot[0] = __hip_atomic_fetch_add(ctr, 1u, RLX_AGENT); __syncthreads(); const unsigned v = slot[0]; __syncthreads(); if (v >= 128u) return false; u.qb = 31 - (int)(v >> 2); u.bh = grp * 4 + (int)(v & 3u); return true; }
                __device__ __forceinline__ void a_ready(const attn_orig::AttnUnit&) const {} __device__ __forceinline__ void done(const attn_orig::AttnUnit&) const {} };
              const DynO S3{ctl + CW_QATT + 512 + 1024 * l + 64 * grp, F.MISC + 0, grp};
              attn_orig::attn_phase<DynO, 8>((char*)lds + RING_OFF, AT3, S3); }
#endif
#if (PROBE_DUP >> 4) & 1
            { const attn_body::AttnTensors AT2{(const attn_body::bf16*)FQ, (const attn_body::bf16*)FK, (const attn_body::bf16*)FV, (attn_body::bf16*)outp, CB};
              const DynAttnOrder S2{ctl + CW_QATT + 512 + 1024 * l + 64 * grp, F.MISC + 0, grp};
              attn_body::attn_phase<DynAttnOrder, 24>((char*)lds + RING_OFF, AT2, S2); }
#endif
            const attn_body::AttnTensors AT{(const attn_body::bf16*)FQ, (const attn_body::bf16*)FK, (const attn_body::bf16*)FV, (attn_body::bf16*)FQ, CB};
            {
                volatile LAS unsigned* slot = F.MISC + 0; gu32* ctr0 = ctl + CW_QATT + 1024 * l;
                int cg = grp, tried = 0; unsigned pre = 0u; if (F.tid == 0) pre = __hip_atomic_fetch_add(ctr0 + 64 * cg, 1u, RLX_AGENT);
                for (;;) {
                    if (F.tid == 0) { slot[0] = pre; slot[3] = (unsigned)cg; }
                    __syncthreads(); const unsigned v = slot[0]; const int g = (int)slot[3];
                    if (v < 128u && F.tid < 128) { const int qb_ = 31 - (int)(v >> 2), bh_ = g * 4 + (int)(v & 3u); const float* cbh = CB + (size_t)bh_ * T;
                        const float q2 = __uint_as_float(__hip_atomic_load(ctl + CW_NRM + 128 * l + 3 * bh_, RLX_AGENT)), k2 = __uint_as_float(__hip_atomic_load(ctl + CW_NRM + 128 * l + 3 * bh_ + 1, RLX_AGENT)),
                                    dn = __uint_as_float(__hip_atomic_load(ctl + CW_NRM + 128 * l + 3 * bh_ + 2, RLX_AGENT));
                        const float thr = cbh[qb_ * 256] - (40.5f + 1.01f * (sqrtf(q2 * k2) + dn));
                        const bool sk = (F.tid < 4 * qb_) && (cbh[64 * F.tid + 63] < thr);
                        const unsigned long long bal = __ballot(sk);
                        if (F.lane == 0) slot[1 + F.wave] = (unsigned)__popcll(bal); }
                    __syncthreads();
                    if (v >= 128u) {
                        if (++tried == 8) break;
                        cg = (g + 1) & 7; if (F.tid == 0) pre = __hip_atomic_fetch_add(ctr0 + 64 * cg, 1u, RLX_AGENT);
                        continue; }
                    if (F.tid == 0) pre = __hip_atomic_fetch_add(ctr0 + 64 * g, 1u, RLX_AGENT);
                    const int qb = 31 - (int)(v >> 2), bh = g * 4 + (int)(v & 3u);
                    const int ts = (int)(slot[1] + slot[2]) & ~1;
                    attn_body::attn_unit<24>(bh / attn_body::NHEAD, bh % attn_body::NHEAD, qb, (const attn_body::bf16*)FQ, (const attn_body::bf16*)FK, (const attn_body::bf16*)FV, (attn_body::bf16*)FQ, CB + (size_t)bh * attn_body::SEQ, (char*)lds + RING_OFF, ts);
                }
            }
        }
        GRID_BAR();
        {
            PH_BEGIN;
            {
#define FX_PAIR(it_) (256 * (bx & 7) + (it_) * 32 + (bx >> 3))
                FxRaw fa, fb; fx_load(fa, FX_PAIR(0), F.wave, lane, RHB, QMB, OA, BV, LG);
#pragma unroll 1
                for (int it = 0; it < 8; it += 2) {
                    fx_load(fb, FX_PAIR(it + 1), F.wave, lane, RHB, QMB, OA, BV, LG);
                    rwkv_fixup(F, FX_PAIR(it), fa, OA, GIN(13) + (size_t)l * RW, GIN(14) + (size_t)l * RW);
                    if (it + 2 < 8) fx_load(fa, FX_PAIR(it + 2), F.wave, lane, RHB, QMB, OA, BV, LG);
                    rwkv_fixup(F, FX_PAIR(it + 1), fb, OA, GIN(13) + (size_t)l * RW, GIN(14) + (size_t)l * RW);
                }
            }
            pg8::Gemm g{X, WIN + ((size_t)l * INP_N + INA_N) * D, 0, nullptr}; pg8::StaticOrder S; S.init(M, 3 * D, NG, bx);
            pg8::EpiGate E{(unsigned char*)outp, (unsigned char*)(ws + WS_G2), GIN(17) + (size_t)l * 3 * D, (size_t)M * D};
            DUP(1) pg8::gemm_phase<pg8::EpiGate, pg8::StaticOrder, true, false, D, D, D>(F.lds + RING_OFF, g, S, E);
        }
        GRID_BAR();
        {
            PH_BEGIN;
            pg8::Gemm g{OA, WUP + (size_t)l * D * 3 * RW, 0, nullptr, (long)WS_OB - (long)WS_OA, (long)WS_FQ - (long)WS_OA}; pg8::StaticOrder S; S.init(M, D, NG, bx);
            pg8::EpiUp3 E{(const unsigned char*)outp, (const unsigned char*)(ws + WS_G2), (size_t)M * D, MG};
            DUP(9) pg8::gemm_phase<pg8::EpiUp3, pg8::StaticOrder, true, false, RW, 3 * RW, 3 * RW, true>(F.lds + RING_OFF, g, S, E);
        }
        GRID_BAR();
        {
            PH_BEGIN;
            pg8::Gemm g{MG, WOUT + (size_t)l * D * D, 0, nullptr}; pg8::StaticOrder S; S.init(M, D, NG, bx);
            pg8::EpiResid E{X, Y, DN_ALPHA};
            DUP(1) pg8::gemm_phase<pg8::EpiResid, pg8::StaticOrder, true, false, D, D, D>(F.lds + RING_OFF, g, S, E);
        }
        GRID_BAR();
        {
            PH_BEGIN;
            const float* g1 = GIN(22) + (size_t)l * D; const float* b1 = GIN(23) + (size_t)l * D;
            const bool moe = (l & 1) != 0;
            LAS float* rwl = (LAS float*)(F.lds + RING_OFF);
            if (moe) { for (int i = F.tid; i < D * NEXP / 4; i += NWAVES * 64) ((LAS f32x4*)rwl)[i] = ((const f32x4*)(GIN(29) + (size_t)(l >> 1) * D * NEXP))[i]; __syncthreads(); }
            LnGB q; ln_load_gb(q, g1, b1, lane); RowRaw nx; row_fetch(nx, Y + (size_t)gw * D, lane);
            float rbias[8];
#pragma unroll
            for (int e = 0; e < 8; ++e) rbias[e] = moe ? GIN(30)[(l >> 1) * NEXP + e] : 0.f;
            for (int dup_ = 0; dup_ < ((((PROBE_DUP) >> 7) & 1) && !moe ? 2 : 1); ++dup_) for (int m = gw; m < M; m += NGW) { f32x4 v[4]; row_unpack(nx, v);
                if (m + NGW < M) row_fetch(nx, Y + (size_t)(m + NGW) * D, lane);
                ln_norm_r(v, q); row_store_bf16(X + (size_t)m * D, v, lane);
                if (moe) {
                    float lgt[8];
#pragma unroll
                    for (int e = 0; e < 8; ++e) lgt[e] = 0.f;
#pragma unroll
                    for (int j = 0; j < 4; ++j)
#pragma unroll
                        for (int i = 0; i < 4; ++i) { const LAS f32x4* wp = (const LAS f32x4*)(rwl + (size_t)(4 * lane + 256 * j + i) * 8); const f32x4 wa = wp[0], wb = wp[1]; const float xv = v[j][i];
                            lgt[0] += xv * wa[0]; lgt[1] += xv * wa[1]; lgt[2] += xv * wa[2]; lgt[3] += xv * wa[3]; lgt[4] += xv * wb[0]; lgt[5] += xv * wb[1]; lgt[6] += xv * wb[2]; lgt[7] += xv * wb[3]; }
#pragma unroll
                    for (int e = 0; e < 8; ++e) lgt[e] = wave_sum(lgt[e]) + rbias[e];
                    if (lane == 0) {
                        int e1 = 0; float v1 = lgt[0];
#pragma unroll
                        for (int e = 1; e < 8; ++e) if (lgt[e] > v1) { v1 = lgt[e]; e1 = e; }
                        int e2 = -1; float v2 = -INFINITY;
#pragma unroll
                        for (int e = 0; e < 8; ++e) if (e != e1 && lgt[e] > v2) { v2 = lgt[e]; e2 = e; }
                        const float gA = 1.f / (1.f + __expf(v2 - v1));
                        TOKE[m] = (unsigned)e1 | ((unsigned)e2 << 8); TOKG[2 * m] = gA; TOKG[2 * m + 1] = 1.f - gA;
                        const int hf = m / MOE_HALF;
                        LAS unsigned* lc = (LAS unsigned*)(F.lds + LCNT_OFF); __hip_atomic_fetch_add(lc + hf * 8 + e1, 1u, __ATOMIC_RELAXED, __HIP_MEMORY_SCOPE_WORKGROUP); __hip_atomic_fetch_add(lc + hf * 8 + e2, 1u, __ATOMIC_RELAXED, __HIP_MEMORY_SCOPE_WORKGROUP);
                    }
                }
            }
            if (moe) {
                __syncthreads();
                if (F.tid < 16) { const unsigned cv = ((LAS unsigned*)(F.lds + LCNT_OFF))[F.tid]; if (cv) __hip_atomic_fetch_add(ctl + CW_CNT + 64 * F.tid, cv, RLX_AGENT); }
                LAS float* scr = (LAS float*)(F.lds + RING_OFF + 32768 + F.wave * 8448);
                const int li = l >> 1; constexpr int I_13 = (2 * DFFE / 32) * 16, I_2 = 32 * (DFFE / 64);
                DUP(2) for (int it = gw; it < NEXP * (I_13 + I_2); it += NGW) {
                    const int e = it / (I_13 + I_2); int r = it - e * (I_13 + I_2);
                    if (r < I_13) { const int rg = r >> 4, kb = r & 15, d0 = 32 * rg, tile = d0 >> 8, within = d0 & 255;
                        const float* W = ((within < 128) ? GIN(31) : GIN(32)) + ((size_t)li * NEXP + e) * D * DFFE;
                        tr_item(W, DFFE, 64 * kb, tile * 128 + (within & 127), 32, WM13 + ((size_t)e * 2 * DFFE + d0) * D, D, 64 * kb, 1.f, scr, lane); }
                    else { r -= I_13; const int rg = r / (DFFE / 64), kb = r % (DFFE / 64);
                        tr_item(GIN(33) + ((size_t)li * NEXP + e) * DFFE * D, D, 64 * kb, 32 * rg, 32, WM2 + ((size_t)e * D + 32 * rg) * DFFE, DFFE, 64 * kb, 1.f, scr, lane); }
                }
            }
        }
        GRID_BAR();
        if constexpr ((l & 1) == 0) {
            {
                PH_BEGIN;
                pg8::Gemm g{X, W13, 0, nullptr}; pg8::StaticOrder S; S.init(M, 2 * DFF, NG, bx);
                pg8::EpiSwiglu E{H, DFF};
                DUP(1) pg8::gemm_phase<pg8::EpiSwiglu, pg8::StaticOrder, true, false, D, D, D>(F.lds + RING_OFF, g, S, E);
            }
            GRID_BAR();
            {
                PH_BEGIN;
                pg8::Gemm g{H, W2, 0, nullptr}; pg8::StaticOrder S; S.init(M, D, NG, bx);
                pg8::EpiResid E{X, Y, DN_ALPHA};
#if defined(PROBE_ZERO_FFN) && (PROBE_ZERO_FFN & 1)
                E.zero = 1;
#endif
                DUP(1) pg8::gemm_phase<pg8::EpiResid, pg8::StaticOrder, true, false, DFF, DFF, DFF>(F.lds + RING_OFF, g, S, E);
            }
            GRID_BAR();
            {
                PH_BEGIN;
                const float* g2 = GIN(24) + (size_t)l * D; const float* b2 = GIN(25) + (size_t)l * D;
                LnGB q; ln_load_gb(q, g2, b2, lane); RowRaw nx; row_fetch(nx, Y + (size_t)gw * D, lane);
                DUP(7) for (int m = gw; m < M; m += NGW) { f32x4 v[4]; row_unpack(nx, v);
                    if (m + NGW < M) row_fetch(nx, Y + (size_t)(m + NGW) * D, lane);
                    ln_norm_r(v, q);
                    if (l == NLAYER - 1) { GAS f32x4* o = (GAS f32x4*)(outp + (size_t)m * D) + lane;
#pragma unroll
                        for (int j = 0; j < 4; ++j) o[64 * j] = v[j]; }
                    else row_store_bf16(X + (size_t)m * D, v, lane); }
            }
            GRID_BAR();
        } else {
            LAS int* moff = (LAS int*)((LAS unsigned char*)lds + MOFF_OFF);
            LAS int* pexp = (LAS int*)((LAS unsigned char*)lds + PEXP_OFF);
            { PH_BEGIN;
            if (F.tid < 2) { int o = 0; for (int e = 0; e < NEXP; ++e) { moff[F.tid * 9 + e] = o; const int c = (int)__hip_atomic_load(ctl + CW_CNT + 64 * (F.tid * 8 + e), RLX_AGENT); o += (c + 255) & ~255; } moff[F.tid * 9 + 8] = o; }
            __syncthreads();
            {
                const int m = F.vcu * (NWAVES * 64) + F.tid;
                LAS unsigned* lf = (LAS unsigned*)(F.lds + LFIL_OFF); LAS unsigned* lb = (LAS unsigned*)(F.lds + LBAS_OFF);
                unsigned te = 0u, rk0 = 0u, rk1 = 0u; int hf = 0;
                if (m < M) { hf = m / MOE_HALF; te = TOKE[m];
                    rk0 = __hip_atomic_fetch_add(lf + hf * 8 + (int)(te & 255u), 1u, __ATOMIC_RELAXED, __HIP_MEMORY_SCOPE_WORKGROUP);
                    rk1 = __hip_atomic_fetch_add(lf + hf * 8 + (int)((te >> 8) & 255u), 1u, __ATOMIC_RELAXED, __HIP_MEMORY_SCOPE_WORKGROUP); }
                __syncthreads();
                if (F.tid < 16) { const unsigned cv = lf[F.tid]; lb[F.tid] = cv ? __hip_atomic_fetch_add(ctl + CW_FILL + 64 * F.tid, cv, RLX_AGENT) : 0u; }
                __syncthreads();
                if (m < M) { const int e0 = (int)(te & 255u), e1 = (int)((te >> 8) & 255u);
                    const int p0 = moff[hf * 9 + e0] + (int)(lb[hf * 8 + e0] + rk0), p1 = moff[hf * 9 + e1] + (int)(lb[hf * 8 + e1] + rk1);
                    PPOS[2 * m] = (unsigned)p0; PPOS[2 * m + 1] = (unsigned)p1; RTOK[hf * MOE_ROWS + p0] = m; RTOK[hf * MOE_ROWS + p1] = m; }
                if (F.vcu >= 64 && F.vcu < 66) { const int hf = F.vcu - 64;
                    for (int e = 0; e < NEXP; ++e) { const int c = (int)__hip_atomic_load(ctl + CW_CNT + 64 * (hf * 8 + e), RLX_AGENT); const int p0 = moff[hf * 9 + e] + c, p1 = moff[hf * 9 + e + 1];
                        for (int p = p0 + F.tid; p < p1; p += NWAVES * 64) RTOK[hf * MOE_ROWS + p] = hf * MOE_HALF; } }
            } }
            GRID_BAR();
{ constexpr int hf = 0;

                const int npan = moff[hf * 9 + 8] >> 8;
                __syncthreads();
                int tp_ = threadIdx.x; asm volatile("" : "+v"(tp_));
                for (int p = tp_; p < npan; p += NWAVES * 64) { int e = 0;
#pragma unroll
                    for (int q = 1; q < NEXP; ++q) if (p * 256 >= moff[hf * 9 + q]) e = q;
                    pexp[p] = e; }
                __syncthreads();
                {
                    PH_BEGIN;
                    pg8::Gemm g{X, WM13, (size_t)2 * DFFE * D * 2, RTOK + hf * MOE_ROWS}; pg8::GroupedOrder S; S.so.init_tiles(npan, 2 * DFFE / 256, NG, bx); S.pexp = pexp;
                    pg8::EpiSwiglu E{HM, DFFE};
                    DUP(1) pg8::gemm_phase<pg8::EpiSwiglu, pg8::GroupedOrder, true, true, D, D, D>(F.lds + RING_OFF, g, S, E);
                }
                GRID_BAR();
                {
                    PH_BEGIN;
                    const int npm = npan < MOE_MAINP ? npan : MOE_MAINP;
                    pg8::Gemm g{HM, WM2, (size_t)D * DFFE * 2, nullptr}; pg8::GroupedOrder S; S.so.init_tiles(npm, D / 256, NG, bx); S.pexp = pexp;
                    pg8::EpiStore E{YP, D};
                    pg8::gemm_phase<pg8::EpiStore, pg8::GroupedOrder, true, false, DFFE, DFFE, DFFE>(F.lds + RING_OFF, g, S, E);
                    if (npan > MOE_MAINP) {
                        pg8::SliceOrder T{MOE_MAINP, npan - MOE_MAINP, D / 256, bx, (DFFE / 4) * 2, pexp};
                        pg8::EpiStore E2{YPS, D, MOE_MAINP, (DFFE / 4) * 2, (size_t)8 * 256 * D};
                        pg8::gemm_phase<pg8::EpiStore, pg8::SliceOrder, true, false, DFFE, DFFE, DFFE / 4>(F.lds + RING_OFF, g, T, E2);
                    }
                }
                GRID_BAR();
                {
                    PH_BEGIN;
                    const float* g2 = GIN(24) + (size_t)l * D; const float* b2 = GIN(25) + (size_t)l * D;
                    LnGB q; ln_load_gb(q, g2, b2, lane);
                    constexpr unsigned MAINR = (unsigned)(MOE_MAINP * 256);
                    unsigned np1 = PPOS[2 * (hf * MOE_HALF + gw)], np2 = PPOS[2 * (hf * MOE_HALF + gw) + 1]; float nga = TOKG[2 * (hf * MOE_HALF + gw)], ngb = TOKG[2 * (hf * MOE_HALF + gw) + 1];
                    RowRaw rx, ra, rc; unsigned p1 = np1, p2 = np2; float ga = nga, gb = ngb;
                    row_fetch(rx, X + (size_t)(hf * MOE_HALF + gw) * D, lane);
                    row_fetch(ra, (p1 < MAINR) ? YP + (size_t)p1 * D : YPS + (size_t)(p1 - MAINR) * D, lane); row_fetch(rc, (p2 < MAINR) ? YP + (size_t)p2 * D : YPS + (size_t)(p2 - MAINR) * D, lane);
                    if (gw + NGW < MOE_HALF) { const int m2 = hf * MOE_HALF + gw + NGW; np1 = PPOS[2 * m2]; np2 = PPOS[2 * m2 + 1]; nga = TOKG[2 * m2]; ngb = TOKG[2 * m2 + 1]; }
                    DUP(7) for (int mm = gw; mm < MOE_HALF; mm += NGW) { const int m = hf * MOE_HALF + mm;
                        f32x4 v[4], a[4], c[4]; row_unpack(rx, v); row_unpack(ra, a); row_unpack(rc, c);
                        const unsigned q1 = p1, q2 = p2; const float ha = ga, hb = gb;
                        if (q1 >= MAINR) { f32x4 t4[4];
#pragma unroll
                            for (int sl = 1; sl < 4; ++sl) { row_load_bf16(YPS + (size_t)sl * 8 * 256 * D + (size_t)(q1 - MAINR) * D, t4, lane);
#pragma unroll
                                for (int j = 0; j < 4; ++j) a[j] = a[j] + t4[j]; } }
                        if (q2 >= MAINR) { f32x4 t4[4];
#pragma unroll
                            for (int sl = 1; sl < 4; ++sl) { row_load_bf16(YPS + (size_t)sl * 8 * 256 * D + (size_t)(q2 - MAINR) * D, t4, lane);
#pragma unroll
                                for (int j = 0; j < 4; ++j) c[j] = c[j] + t4[j]; } }
                        if (mm + NGW < MOE_HALF) { const int m1 = m + NGW; p1 = np1; p2 = np2; ga = nga; gb = ngb;
                            row_fetch(rx, X + (size_t)m1 * D, lane);
                            row_fetch(ra, (p1 < MAINR) ? YP + (size_t)p1 * D : YPS + (size_t)(p1 - MAINR) * D, lane); row_fetch(rc, (p2 < MAINR) ? YP + (size_t)p2 * D : YPS + (size_t)(p2 - MAINR) * D, lane);
                            if (mm + 2 * NGW < MOE_HALF) { const int m2 = m + 2 * NGW; np1 = PPOS[2 * m2]; np2 = PPOS[2 * m2 + 1]; nga = TOKG[2 * m2]; ngb = TOKG[2 * m2 + 1]; } }
#pragma unroll
                        for (int j = 0; j < 4; ++j) v[j] = DN_ALPHA * v[j] + PROBE_MOE_SCALE * (ha * a[j] + hb * c[j]);
                        ln_norm_r(v, q);
                        if (l == NLAYER - 1) { GAS f32x4* o = (GAS f32x4*)(outp + (size_t)m * D) + lane;
#pragma unroll
                            for (int j = 0; j < 4; ++j) o[64 * j] = v[j]; }
                        else row_store_bf16(X + (size_t)m * D, v, lane); }
                }

}
{ constexpr int hf = 1;

                const int npan = moff[hf * 9 + 8] >> 8;
                __syncthreads();
                int tp_ = threadIdx.x; asm volatile("" : "+v"(tp_));
                for (int p = tp_; p < npan; p += NWAVES * 64) { int e = 0;
#pragma unroll
                    for (int q = 1; q < NEXP; ++q) if (p * 256 >= moff[hf * 9 + q]) e = q;
                    pexp[p] = e; }
                __syncthreads();
                {
                    PH_BEGIN;
                    pg8::Gemm g{X, WM13, (size_t)2 * DFFE * D * 2, RTOK + hf * MOE_ROWS}; pg8::GroupedOrder S; S.so.init_tiles(npan, 2 * DFFE / 256, NG, bx); S.pexp = pexp;
                    pg8::EpiSwiglu E{HM, DFFE};
                    DUP(1) pg8::gemm_phase<pg8::EpiSwiglu, pg8::GroupedOrder, true, true, D, D, D>(F.lds + RING_OFF, g, S, E);
                }
                GRID_BAR();
                {
                    PH_BEGIN;
                    const int npm = npan < MOE_MAINP ? npan : MOE_MAINP;
                    pg8::Gemm g{HM, WM2, (size_t)D * DFFE * 2, nullptr}; pg8::GroupedOrder S; S.so.init_tiles(npm, D / 256, NG, bx); S.pexp = pexp;
                    pg8::EpiStore E{YP, D};
                    pg8::gemm_phase<pg8::EpiStore, pg8::GroupedOrder, true, false, DFFE, DFFE, DFFE>(F.lds + RING_OFF, g, S, E);
                    if (npan > MOE_MAINP) {
                        pg8::SliceOrder T{MOE_MAINP, npan - MOE_MAINP, D / 256, bx, (DFFE / 4) * 2, pexp};
                        pg8::EpiStore E2{YPS, D, MOE_MAINP, (DFFE / 4) * 2, (size_t)8 * 256 * D};
                        pg8::gemm_phase<pg8::EpiStore, pg8::SliceOrder, true, false, DFFE, DFFE, DFFE / 4>(F.lds + RING_OFF, g, T, E2);
                    }
                }
                GRID_BAR();
                {
                    PH_BEGIN;
                    const float* g2 = GIN(24) + (size_t)l * D; const float* b2 = GIN(25) + (size_t)l * D;
                    LnGB q; ln_load_gb(q, g2, b2, lane);
                    constexpr unsigned MAINR = (unsigned)(MOE_MAINP * 256);
                    unsigned np1 = PPOS[2 * (hf * MOE_HALF + gw)], np2 = PPOS[2 * (hf * MOE_HALF + gw) + 1]; float nga = TOKG[2 * (hf * MOE_HALF + gw)], ngb = TOKG[2 * (hf * MOE_HALF + gw) + 1];
                    RowRaw rx, ra, rc; unsigned p1 = np1, p2 = np2; float ga = nga, gb = ngb;
                    row_fetch(rx, X + (size_t)(hf * MOE_HALF + gw) * D, lane);
                    row_fetch(ra, (p1 < MAINR) ? YP + (size_t)p1 * D : YPS + (size_t)(p1 - MAINR) * D, lane); row_fetch(rc, (p2 < MAINR) ? YP + (size_t)p2 * D : YPS + (size_t)(p2 - MAINR) * D, lane);
                    if (gw + NGW < MOE_HALF) { const int m2 = hf * MOE_HALF + gw + NGW; np1 = PPOS[2 * m2]; np2 = PPOS[2 * m2 + 1]; nga = TOKG[2 * m2]; ngb = TOKG[2 * m2 + 1]; }
                    DUP(7) for (int mm = gw; mm < MOE_HALF; mm += NGW) { const int m = hf * MOE_HALF + mm;
                        f32x4 v[4], a[4], c[4]; row_unpack(rx, v); row_unpack(ra, a); row_unpack(rc, c);
                        const unsigned q1 = p1, q2 = p2; const float ha = ga, hb = gb;
                        if (q1 >= MAINR) { f32x4 t4[4];
#pragma unroll
                            for (int sl = 1; sl < 4; ++sl) { row_load_bf16(YPS + (size_t)sl * 8 * 256 * D + (size_t)(q1 - MAINR) * D, t4, lane);
#pragma unroll
                                for (int j = 0; j < 4; ++j) a[j] = a[j] + t4[j]; } }
                        if (q2 >= MAINR) { f32x4 t4[4];
#pragma unroll
                            for (int sl = 1; sl < 4; ++sl) { row_load_bf16(YPS + (size_t)sl * 8 * 256 * D + (size_t)(q2 - MAINR) * D, t4, lane);
#pragma unroll
                                for (int j = 0; j < 4; ++j) c[j] = c[j] + t4[j]; } }
                        if (mm + NGW < MOE_HALF) { const int m1 = m + NGW; p1 = np1; p2 = np2; ga = nga; gb = ngb;
                            row_fetch(rx, X + (size_t)m1 * D, lane);
                            row_fetch(ra, (p1 < MAINR) ? YP + (size_t)p1 * D : YPS + (size_t)(p1 - MAINR) * D, lane); row_fetch(rc, (p2 < MAINR) ? YP + (size_t)p2 * D : YPS + (size_t)(p2 - MAINR) * D, lane);
                            if (mm + 2 * NGW < MOE_HALF) { const int m2 = m + 2 * NGW; np1 = PPOS[2 * m2]; np2 = PPOS[2 * m2 + 1]; nga = TOKG[2 * m2]; ngb = TOKG[2 * m2 + 1]; } }
#pragma unroll
                        for (int j = 0; j < 4; ++j) v[j] = DN_ALPHA * v[j] + PROBE_MOE_SCALE * (ha * a[j] + hb * c[j]);
                        ln_norm_r(v, q);
                        if (l == NLAYER - 1) { GAS f32x4* o = (GAS f32x4*)(outp + (size_t)m * D) + lane;
#pragma unroll
                            for (int j = 0; j < 4; ++j) o[64 * j] = v[j]; }
                        else row_store_bf16(X + (size_t)m * D, v, lane); }
                }

}

            if (l != NLAYER - 1) GRID_BAR();
        }

}
{ constexpr int l = 1;

        {
            PH_BEGIN;
            pg8::Gemm g{X, WIN + (size_t)l * INP_N * D, 0, nullptr}; pg8::StaticOrder S; S.init(M, INA_N, NG, bx);
            pg8::EpiInA E{Rr, Cb, FQ, FL, (size_t)(WS_FK - WS_FQ) / 2};
            DUP(1) pg8::gemm_phase<pg8::EpiInA, pg8::StaticOrder, true, false, D, D, D>(F.lds + RING_OFF, g, S, E);
#ifdef PROBE_A1MODE
            { pg8::EpiSink E9{(float*)LW}; pg8::gemm_phase<pg8::EpiSink, pg8::StaticOrder, true, false, D, D, D, false, PROBE_A1MODE>(F.lds + RING_OFF, g, S, E9); }
#endif
        }
        GRID_BAR();
        {
            PH_BEGIN;
            LAS unsigned* nrm = (LAS unsigned*)(F.lds + NRM_OFF);
            if (F.tid < 96) nrm[F.tid] = 0u;
            __syncthreads();
            if (F.vcu < 32) {
                const int bh = F.vcu, b = bh >> 3, h = bh & 7; const float bf_ = GIN(16)[l * 8 + h];
                LAS float* tot = (LAS float*)(F.lds + RING_OFF);
                float loc[16]; float run = 0.f; const int t0 = F.tid * 16;
#pragma unroll
                for (int i = 0; i < 16; ++i) { const float f = FL[((size_t)b * T + t0 + i) * 8 + h] + bf_; const float ls = fminf(f, 0.f) - log1pf(__expf(-fabsf(f))); run += ls; loc[i] = run; }
                tot[F.tid] = run; __syncthreads();
                float pre = 0.f; for (int i = 0; i < F.tid; ++i) pre += tot[i];
#pragma unroll
                for (int i = 0; i < 16; ++i) CB[(size_t)bh * T + t0 + i] = -(pre + loc[i]) * LOG2E;
                __syncthreads();
            }
            const float* mu = GIN(4) + (size_t)l * R_COLS + 1536; const float* cw = GIN(15) + (size_t)l * 3 * RW;
            const f32x4 mu4 = *(const f32x4*)(mu + 4 * lane);
            f32x4 w0a = *(const f32x4*)(cw + 8 * lane), w0b = *(const f32x4*)(cw + 8 * lane + 4), w1a = *(const f32x4*)(cw + RW + 8 * lane), w1b = *(const f32x4*)(cw + RW + 8 * lane + 4),
                  w2a = *(const f32x4*)(cw + 2 * RW + 8 * lane), w2b = *(const f32x4*)(cw + 2 * RW + 8 * lane + 4);
            struct A2Raw { pg8::u32x2 cu, pv; pg8::u32x4 b, u0, u1, u2, fq, fk; };
            auto a2_fetch = [&](A2Raw& r, int m) { const int t = m & (T - 1);
                const bf16* rp = Rr + (size_t)m * R_COLS + 1536 + 4 * lane; r.cu = *(const pg8::u32x2*)rp; r.pv = (pg8::u32x2){0u, 0u}; if (t > 0) r.pv = *(const pg8::u32x2*)(rp - R_COLS);
                const bf16* cp = Cb + (size_t)m * C_COLS + 8 * lane; const pg8::u32x4 z4 = (pg8::u32x4){0u, 0u, 0u, 0u};
                r.b = *(const pg8::u32x4*)cp; r.u0 = *(const pg8::u32x4*)(cp + 512);
                r.fq = *(const pg8::u32x4*)(FQ + (size_t)m * RW + 8 * lane); r.fk = *(const pg8::u32x4*)(FK + (size_t)m * RW + 8 * lane);
                r.u1 = z4; r.u2 = z4;
                if (t >= 1) r.u1 = *(const pg8::u32x4*)(cp - C_COLS + 512);
                if (t >= 2) r.u2 = *(const pg8::u32x4*)(cp - 2 * C_COLS + 512); };
            A2Raw nx; a2_fetch(nx, gw); float mq = 0.f, mk = 0.f, md = 0.f;
            DUP(3) for (int m = gw; m < M; m += NGW) {
                const A2Raw r = nx; if (m + NGW < M) a2_fetch(nx, m + NGW);
                {
                    f32x4 a0, a1; pg8::unpack8(r.fq, a0, a1); float sq = (a0[0] * a0[0] + a0[1] * a0[1]) + (a0[2] * a0[2] + a0[3] * a0[3]) + (a1[0] * a1[0] + a1[1] * a1[1]) + (a1[2] * a1[2] + a1[3] * a1[3]);
                    f32x4 k0, k1; pg8::unpack8(r.fk, k0, k1); float dq = (a0[0] * k0[0] + a0[1] * k0[1]) + (a0[2] * k0[2] + a0[3] * k0[3]) + (a1[0] * k1[0] + a1[1] * k1[1]) + (a1[2] * k1[2] + a1[3] * k1[3]);
                    a0 = k0; a1 = k1; float sk = (a0[0] * a0[0] + a0[1] * a0[1]) + (a0[2] * a0[2] + a0[3] * a0[3]) + (a1[0] * a1[0] + a1[1] * a1[1]) + (a1[2] * a1[2] + a1[3] * a1[3]);
                    sq += __shfl_xor(sq, 1); sk += __shfl_xor(sk, 1); dq += __shfl_xor(dq, 1); sq += __shfl_xor(sq, 2); sk += __shfl_xor(sk, 2); dq += __shfl_xor(dq, 2); sq += __shfl_xor(sq, 4); sk += __shfl_xor(sk, 4); dq += __shfl_xor(dq, 4);
                    mq = fmaxf(mq, sq); mk = fmaxf(mk, sk); md = fmaxf(md, -dq);
                    if (((m >> 11) & 3) == 3) {
                        if ((lane & 7) == 0) { LAS unsigned* e = nrm + ((m >> 13) * 8 + (lane >> 3)) * 3;
                            __hip_atomic_fetch_max(e, __float_as_uint(mq), __ATOMIC_RELAXED, __HIP_MEMORY_SCOPE_WORKGROUP); __hip_atomic_fetch_max(e + 1, __float_as_uint(mk), __ATOMIC_RELAXED, __HIP_MEMORY_SCOPE_WORKGROUP);
                            __hip_atomic_fetch_max(e + 2, __float_as_uint(md), __ATOMIC_RELAXED, __HIP_MEMORY_SCOPE_WORKGROUP); }
                        mq = 0.f; mk = 0.f; md = 0.f; }
                }
                {
                    const pg8::u32x2 cu = r.cu, pv = r.pv;
                    f32x4 c4 = (f32x4){bflo(cu.x), bfhi(cu.x), bflo(cu.y), bfhi(cu.y)}, p4 = (f32x4){bflo(pv.x), bfhi(pv.x), bflo(pv.y), bfhi(pv.y)};
                    f32x4 o = c4 + mu4 * (p4 - c4);
                    if (lane < 16) {
#pragma unroll
                        for (int j = 0; j < 4; ++j) o[j] = 2.f * sigm(2.f * o[j]) - 1.f;
                    } else if (lane >= 32) {
#pragma unroll
                        for (int j = 0; j < 4; ++j) o[j] = sigm(o[j]);
                    }
                    pg8::u32x2 ou; ou.x = pk2(o[0], o[1]); ou.y = pk2(o[2], o[3]); *(pg8::u32x2*)(LA + (size_t)m * 256 + 4 * lane) = ou;
                }
                {
                    f32x4 ba, bb, u0a, u0b, u1a, u1b, u2a, u2b; pg8::unpack8(r.b, ba, bb); pg8::unpack8(r.u0, u0a, u0b); pg8::unpack8(r.u1, u1a, u1b); pg8::unpack8(r.u2, u2a, u2b);
                    const f32x4 ya = ba * (w0a * u2a + w1a * u1a + w2a * u0a), yb = bb * (w0b * u2b + w1b * u1b + w2b * u0b);
                    *(pg8::u32x4*)(OB + (size_t)m * RW + 8 * lane) = pg8::pack8(ya, yb);
                }
            }
            __syncthreads();
            if (F.tid < 96) { const unsigned v = nrm[F.tid]; if (v) __hip_atomic_fetch_max(ctl + CW_NRM + 128 * l + F.tid, v, RLX_AGENT); }
        }
        GRID_BAR();
        {
            PH_BEGIN;
            pg8::Gemm g{LA, WL + (size_t)l * 1536 * 256, 0, nullptr}; pg8::StaticOrder S; S.init(M, 1536, NG, bx);
            pg8::EpiLora E{LW, LAO, LG, GIN(5) + (size_t)l * RW, GIN(7) + (size_t)l * RW};
            DUP(1) pg8::gemm_phase<pg8::EpiLora, pg8::StaticOrder, true, false, 256, 256, 256>(F.lds + RING_OFF, g, S, E);
        }
        GRID_BAR();
        {
            PH_BEGIN;
#define CK_TASK(it_) (((4 * (bx & 7) + ((((it_) * 32 + (bx >> 3))) >> 7)) << 7) + ((((it_) * 32 + (bx >> 3))) & 127))
            CkRaw raw; ck_load(raw, CK_TASK(0), F.wave, lane, Rr, LAO, LW, GIN(4) + (size_t)l * R_COLS, GIN(10) + (size_t)l * RW, GIN(11) + (size_t)l * RW, GIN(12) + (size_t)l * RW);
            for (int it = 0; it < 16; ++it)
                rwkv_chunk_local(F, CK_TASK(it), (it + 1 < 16) ? CK_TASK(it + 1) : -1, raw, Rr, LAO, LW, OA, BV, PMB, QMB, RHB, GIN(4) + (size_t)l * R_COLS, GIN(10) + (size_t)l * RW, GIN(11) + (size_t)l * RW, GIN(12) + (size_t)l * RW);
        }
        GRID_BAR();
        {
            PH_BEGIN;
            const int grp = bx & 7, jj = bx >> 3;
#if (PROBE_DUP >> 5) & 1
            if (jj < 4) rwkv_carry(F, grp * 4 + jj, PMB, QMB, (bf16*)outp);
#endif
            if (jj < 4) rwkv_carry(F, grp * 4 + jj, PMB, QMB, QMB);
#if (PROBE_DUP >> 15) & 1
            { const attn_orig::AttnTensors AT3{(const attn_orig::bf16*)FQ, (const attn_orig::bf16*)FK, (const attn_orig::bf16*)FV, (attn_orig::bf16*)outp};
              struct DynO { gu32* ctr; volatile LAS unsigned* slot; int grp;
                __device__ __forceinline__ bool next(int, attn_orig::AttnUnit& u) const { if (threadIdx.x == 0) slot[0] = __hip_atomic_fetch_add(ctr, 1u, RLX_AGENT); __syncthreads(); const unsigned v = slot[0]; __syncthreads(); if (v >= 128u) return false; u.qb = 31 - (int)(v >> 2); u.bh = grp * 4 + (int)(v & 3u); return true; }
                __device__ __forceinline__ void a_ready(const attn_orig::AttnUnit&) const {} __device__ __forceinline__ void done(const attn_orig::AttnUnit&) const {} };
              const DynO S3{ctl + CW_QATT + 512 + 1024 * l + 64 * grp, F.MISC + 0, grp};
              attn_orig::attn_phase<DynO, 8>((char*)lds + RING_OFF, AT3, S3); }
#endif
#if (PROBE_DUP >> 4) & 1
            { const attn_body::AttnTensors AT2{(const attn_body::bf16*)FQ, (const attn_body::bf16*)FK, (const attn_body::bf16*)FV, (attn_body::bf16*)outp, CB};
              const DynAttnOrder S2{ctl + CW_QATT + 512 + 1024 * l + 64 * grp, F.MISC + 0, grp};
              attn_body::attn_phase<DynAttnOrder, 24>((char*)lds + RING_OFF, AT2, S2); }
#endif
            const attn_body::AttnTensors AT{(const attn_body::bf16*)FQ, (const attn_body::bf16*)FK, (const attn_body::bf16*)FV, (attn_body::bf16*)FQ, CB};
            {
                volatile LAS unsigned* slot = F.MISC + 0; gu32* ctr0 = ctl + CW_QATT + 1024 * l;
                int cg = grp, tried = 0; unsigned pre = 0u; if (F.tid == 0) pre = __hip_atomic_fetch_add(ctr0 + 64 * cg, 1u, RLX_AGENT);
                for (;;) {
                    if (F.tid == 0) { slot[0] = pre; slot[3] = (unsigned)cg; }
                    __syncthreads(); const unsigned v = slot[0]; const int g = (int)slot[3];
                    if (v < 128u && F.tid < 128) { const int qb_ = 31 - (int)(v >> 2), bh_ = g * 4 + (int)(v & 3u); const float* cbh = CB + (size_t)bh_ * T;
                        const float q2 = __uint_as_float(__hip_atomic_load(ctl + CW_NRM + 128 * l + 3 * bh_, RLX_AGENT)), k2 = __uint_as_float(__hip_atomic_load(ctl + CW_NRM + 128 * l + 3 * bh_ + 1, RLX_AGENT)),
                                    dn = __uint_as_float(__hip_atomic_load(ctl + CW_NRM + 128 * l + 3 * bh_ + 2, RLX_AGENT));
                        const float thr = cbh[qb_ * 256] - (40.5f + 1.01f * (sqrtf(q2 * k2) + dn));
                        const bool sk = (F.tid < 4 * qb_) && (cbh[64 * F.tid + 63] < thr);
                        const unsigned long long bal = __ballot(sk);
                        if (F.lane == 0) slot[1 + F.wave] = (unsigned)__popcll(bal); }
                    __syncthreads();
                    if (v >= 128u) {
                        if (++tried == 8) break;
                        cg = (g + 1) & 7; if (F.tid == 0) pre = __hip_atomic_fetch_add(ctr0 + 64 * cg, 1u, RLX_AGENT);
                        continue; }
                    if (F.tid == 0) pre = __hip_atomic_fetch_add(ctr0 + 64 * g, 1u, RLX_AGENT);
                    const int qb = 31 - (int)(v >> 2), bh = g * 4 + (int)(v & 3u);
                    const int ts = (int)(slot[1] + slot[2]) & ~1;
                    attn_body::attn_unit<24>(bh / attn_body::NHEAD, bh % attn_body::NHEAD, qb, (const attn_body::bf16*)FQ, (const attn_body::bf16*)FK, (const attn_body::bf16*)FV, (attn_body::bf16*)FQ, CB + (size_t)bh * attn_body::SEQ, (char*)lds + RING_OFF, ts);
                }
            }
        }
        GRID_BAR();
        {
            PH_BEGIN;
            {
#define FX_PAIR(it_) (256 * (bx & 7) + (it_) * 32 + (bx >> 3))
                FxRaw fa, fb; fx_load(fa, FX_PAIR(0), F.wave, lane, RHB, QMB, OA, BV, LG);
#pragma unroll 1
                for (int it = 0; it < 8; it += 2) {
                    fx_load(fb, FX_PAIR(it + 1), F.wave, lane, RHB, QMB, OA, BV, LG);
                    rwkv_fixup(F, FX_PAIR(it), fa, OA, GIN(13) + (size_t)l * RW, GIN(14) + (size_t)l * RW);
                    if (it + 2 < 8) fx_load(fa, FX_PAIR(it + 2), F.wave, lane, RHB, QMB, OA, BV, LG);
                    rwkv_fixup(F, FX_PAIR(it + 1), fb, OA, GIN(13) + (size_t)l * RW, GIN(14) + (size_t)l * RW);
                }
            }
            pg8::Gemm g{X, WIN + ((size_t)l * INP_N + INA_N) * D, 0, nullptr}; pg8::StaticOrder S; S.init(M, 3 * D, NG, bx);
            pg8::EpiGate E{(unsigned char*)outp, (unsigned char*)(ws + WS_G2), GIN(17) + (size_t)l * 3 * D, (size_t)M * D};
            DUP(1) pg8::gemm_phase<pg8::EpiGate, pg8::StaticOrder, true, false, D, D, D>(F.lds + RING_OFF, g, S, E);
        }
        GRID_BAR();
        {
            PH_BEGIN;
            pg8::Gemm g{OA, WUP + (size_t)l * D * 3 * RW, 0, nullptr, (long)WS_OB - (long)WS_OA, (long)WS_FQ - (long)WS_OA}; pg8::StaticOrder S; S.init(M, D, NG, bx);
            pg8::EpiUp3 E{(const unsigned char*)outp, (const unsigned char*)(ws + WS_G2), (size_t)M * D, MG};
            DUP(9) pg8::gemm_phase<pg8::EpiUp3, pg8::StaticOrder, true, false, RW, 3 * RW, 3 * RW, true>(F.lds + RING_OFF, g, S, E);
        }
        GRID_BAR();
        {
            PH_BEGIN;
            pg8::Gemm g{MG, WOUT + (size_t)l * D * D, 0, nullptr}; pg8::StaticOrder S; S.init(M, D, NG, bx);
            pg8::EpiResid E{X, Y, DN_ALPHA};
            DUP(1) pg8::gemm_phase<pg8::EpiResid, pg8::StaticOrder, true, false, D, D, D>(F.lds + RING_OFF, g, S, E);
        }
        GRID_BAR();
        {
            PH_BEGIN;
            const float* g1 = GIN(22) + (size_t)l * D; const float* b1 = GIN(23) + (size_t)l * D;
            const bool moe = (l & 1) != 0;
            LAS float* rwl = (LAS float*)(F.lds + RING_OFF);
            if (moe) { for (int i = F.tid; i < D * NEXP / 4; i += NWAVES * 64) ((LAS f32x4*)rwl)[i] = ((const f32x4*)(GIN(29) + (size_t)(l >> 1) * D * NEXP))[i]; __syncthreads(); }
            LnGB q; ln_load_gb(q, g1, b1, lane); RowRaw nx; row_fetch(nx, Y + (size_t)gw * D, lane);
            float rbias[8];
#pragma unroll
            for (int e = 0; e < 8; ++e) rbias[e] = moe ? GIN(30)[(l >> 1) * NEXP + e] : 0.f;
            for (int dup_ = 0; dup_ < ((((PROBE_DUP) >> 7) & 1) && !moe ? 2 : 1); ++dup_) for (int m = gw; m < M; m += NGW) { f32x4 v[4]; row_unpack(nx, v);
                if (m + NGW < M) row_fetch(nx, Y + (size_t)(m + NGW) * D, lane);
                ln_norm_r(v, q); row_store_bf16(X + (size_t)m * D, v, lane);
                if (moe) {
                    float lgt[8];
#pragma unroll
                    for (int e = 0; e < 8; ++e) lgt[e] = 0.f;
#pragma unroll
                    for (int j = 0; j < 4; ++j)
#pragma unroll
                        for (int i = 0; i < 4; ++i) { const LAS f32x4* wp = (const LAS f32x4*)(rwl + (size_t)(4 * lane + 256 * j + i) * 8); const f32x4 wa = wp[0], wb = wp[1]; const float xv = v[j][i];
                            lgt[0] += xv * wa[0]; lgt[1] += xv * wa[1]; lgt[2] += xv * wa[2]; lgt[3] += xv * wa[3]; lgt[4] += xv * wb[0]; lgt[5] += xv * wb[1]; lgt[6] += xv * wb[2]; lgt[7] += xv * wb[3]; }
#pragma unroll
                    for (int e = 0; e < 8; ++e) lgt[e] = wave_sum(lgt[e]) + rbias[e];
                    if (lane == 0) {
                        int e1 = 0; float v1 = lgt[0];
#pragma unroll
                        for (int e = 1; e < 8; ++e) if (lgt[e] > v1) { v1 = lgt[e]; e1 = e; }
                        int e2 = -1; float v2 = -INFINITY;
#pragma unroll
                        for (int e = 0; e < 8; ++e) if (e != e1 && lgt[e] > v2) { v2 = lgt[e]; e2 = e; }
                        const float gA = 1.f / (1.f + __expf(v2 - v1));
                        TOKE[m] = (unsigned)e1 | ((unsigned)e2 << 8); TOKG[2 * m] = gA; TOKG[2 * m + 1] = 1.f - gA;
                        const int hf = m / MOE_HALF;
                        LAS unsigned* lc = (LAS unsigned*)(F.lds + LCNT_OFF); __hip_atomic_fetch_add(lc + hf * 8 + e1, 1u, __ATOMIC_RELAXED, __HIP_MEMORY_SCOPE_WORKGROUP); __hip_atomic_fetch_add(lc + hf * 8 + e2, 1u, __ATOMIC_RELAXED, __HIP_MEMORY_SCOPE_WORKGROUP);
                    }
                }
            }
            if (moe) {
                __syncthreads();
                if (F.tid < 16) { const unsigned cv = ((LAS unsigned*)(F.lds + LCNT_OFF))[F.tid]; if (cv) __hip_atomic_fetch_add(ctl + CW_CNT + 64 * F.tid, cv, RLX_AGENT); }
                LAS float* scr = (LAS float*)(F.lds + RING_OFF + 32768 + F.wave * 8448);
                const int li = l >> 1; constexpr int I_13 = (2 * DFFE / 32) * 16, I_2 = 32 * (DFFE / 64);
                DUP(2) for (int it = gw; it < NEXP * (I_13 + I_2); it += NGW) {
                    const int e = it / (I_13 + I_2); int r = it - e * (I_13 + I_2);
                    if (r < I_13) { const int rg = r >> 4, kb = r & 15, d0 = 32 * rg, tile = d0 >> 8, within = d0 & 255;
                        const float* W = ((within < 128) ? GIN(31) : GIN(32)) + ((size_t)li * NEXP + e) * D * DFFE;
                        tr_item(W, DFFE, 64 * kb, tile * 128 + (within & 127), 32, WM13 + ((size_t)e * 2 * DFFE + d0) * D, D, 64 * kb, 1.f, scr, lane); }
                    else { r -= I_13; const int rg = r / (DFFE / 64), kb = r % (DFFE / 64);
                        tr_item(GIN(33) + ((size_t)li * NEXP + e) * DFFE * D, D, 64 * kb, 32 * rg, 32, WM2 + ((size_t)e * D + 32 * rg) * DFFE, DFFE, 64 * kb, 1.f, scr, lane); }
                }
            }
        }
        GRID_BAR();
        if constexpr ((l & 1) == 0) {
            {
                PH_BEGIN;
                pg8::Gemm g{X, W13, 0, nullptr}; pg8::StaticOrder S; S.init(M, 2 * DFF, NG, bx);
                pg8::EpiSwiglu E{H, DFF};
                DUP(1) pg8::gemm_phase<pg8::EpiSwiglu, pg8::StaticOrder, true, false, D, D, D>(F.lds + RING_OFF, g, S, E);
            }
            GRID_BAR();
            {
                PH_BEGIN;
                pg8::Gemm g{H, W2, 0, nullptr}; pg8::StaticOrder S; S.init(M, D, NG, bx);
                pg8::EpiResid E{X, Y, DN_ALPHA};
#if defined(PROBE_ZERO_FFN) && (PROBE_ZERO_FFN & 1)
                E.zero = 1;
#endif
                DUP(1) pg8::gemm_phase<pg8::EpiResid, pg8::StaticOrder, true, false, DFF, DFF, DFF>(F.lds + RING_OFF, g, S, E);
            }
            GRID_BAR();
            {
                PH_BEGIN;
                const float* g2 = GIN(24) + (size_t)l * D; const float* b2 = GIN(25) + (size_t)l * D;
                LnGB q; ln_load_gb(q, g2, b2, lane); RowRaw nx; row_fetch(nx, Y + (size_t)gw * D, lane);
                DUP(7) for (int m = gw; m < M; m += NGW) { f32x4 v[4]; row_unpack(nx, v);
                    if (m + NGW < M) row_fetch(nx, Y + (size_t)(m + NGW) * D, lane);
                    ln_norm_r(v, q);
                    if (l == NLAYER - 1) { GAS f32x4* o = (GAS f32x4*)(outp + (size_t)m * D) + lane;
#pragma unroll
                        for (int j = 0; j < 4; ++j) o[64 * j] = v[j]; }
                    else row_store_bf16(X + (size_t)m * D, v, lane); }
            }
            GRID_BAR();
        } else {
            LAS int* moff = (LAS int*)((LAS unsigned char*)lds + MOFF_OFF);
            LAS int* pexp = (LAS int*)((LAS unsigned char*)lds + PEXP_OFF);
            { PH_BEGIN;
            if (F.tid < 2) { int o = 0; for (int e = 0; e < NEXP; ++e) { moff[F.tid * 9 + e] = o; const int c = (int)__hip_atomic_load(ctl + CW_CNT + 64 * (F.tid * 8 + e), RLX_AGENT); o += (c + 255) & ~255; } moff[F.tid * 9 + 8] = o; }
            __syncthreads();
            {
                const int m = F.vcu * (NWAVES * 64) + F.tid;
                LAS unsigned* lf = (LAS unsigned*)(F.lds + LFIL_OFF); LAS unsigned* lb = (LAS unsigned*)(F.lds + LBAS_OFF);
                unsigned te = 0u, rk0 = 0u, rk1 = 0u; int hf = 0;
                if (m < M) { hf = m / MOE_HALF; te = TOKE[m];
                    rk0 = __hip_atomic_fetch_add(lf + hf * 8 + (int)(te & 255u), 1u, __ATOMIC_RELAXED, __HIP_MEMORY_SCOPE_WORKGROUP);
                    rk1 = __hip_atomic_fetch_add(lf + hf * 8 + (int)((te >> 8) & 255u), 1u, __ATOMIC_RELAXED, __HIP_MEMORY_SCOPE_WORKGROUP); }
                __syncthreads();
                if (F.tid < 16) { const unsigned cv = lf[F.tid]; lb[F.tid] = cv ? __hip_atomic_fetch_add(ctl + CW_FILL + 64 * F.tid, cv, RLX_AGENT) : 0u; }
                __syncthreads();
                if (m < M) { const int e0 = (int)(te & 255u), e1 = (int)((te >> 8) & 255u);
                    const int p0 = moff[hf * 9 + e0] + (int)(lb[hf * 8 + e0] + rk0), p1 = moff[hf * 9 + e1] + (int)(lb[hf * 8 + e1] + rk1);
                    PPOS[2 * m] = (unsigned)p0; PPOS[2 * m + 1] = (unsigned)p1; RTOK[hf * MOE_ROWS + p0] = m; RTOK[hf * MOE_ROWS + p1] = m; }
                if (F.vcu >= 64 && F.vcu < 66) { const int hf = F.vcu - 64;
                    for (int e = 0; e < NEXP; ++e) { const int c = (int)__hip_atomic_load(ctl + CW_CNT + 64 * (hf * 8 + e), RLX_AGENT); const int p0 = moff[hf * 9 + e] + c, p1 = moff[hf * 9 + e + 1];
                        for (int p = p0 + F.tid; p < p1; p += NWAVES * 64) RTOK[hf * MOE_ROWS + p] = hf * MOE_HALF; } }
            } }
            GRID_BAR();
{ constexpr int hf = 0;

                const int npan = moff[hf * 9 + 8] >> 8;
                __syncthreads();
                int tp_ = threadIdx.x; asm volatile("" : "+v"(tp_));
                for (int p = tp_; p < npan; p += NWAVES * 64) { int e = 0;
#pragma unroll
                    for (int q = 1; q < NEXP; ++q) if (p * 256 >= moff[hf * 9 + q]) e = q;
                    pexp[p] = e; }
                __syncthreads();
                {
                    PH_BEGIN;
                    pg8::Gemm g{X, WM13, (size_t)2 * DFFE * D * 2, RTOK + hf * MOE_ROWS}; pg8::GroupedOrder S; S.so.init_tiles(npan, 2 * DFFE / 256, NG, bx); S.pexp = pexp;
                    pg8::EpiSwiglu E{HM, DFFE};
                    DUP(1) pg8::gemm_phase<pg8::EpiSwiglu, pg8::GroupedOrder, true, true, D, D, D>(F.lds + RING_OFF, g, S, E);
                }
                GRID_BAR();
                {
                    PH_BEGIN;
                    const int npm = npan < MOE_MAINP ? npan : MOE_MAINP;
                    pg8::Gemm g{HM, WM2, (size_t)D * DFFE * 2, nullptr}; pg8::GroupedOrder S; S.so.init_tiles(npm, D / 256, NG, bx); S.pexp = pexp;
                    pg8::EpiStore E{YP, D};
                    pg8::gemm_phase<pg8::EpiStore, pg8::GroupedOrder, true, false, DFFE, DFFE, DFFE>(F.lds + RING_OFF, g, S, E);
                    if (npan > MOE_MAINP) {
                        pg8::SliceOrder T{MOE_MAINP, npan - MOE_MAINP, D / 256, bx, (DFFE / 4) * 2, pexp};
                        pg8::EpiStore E2{YPS, D, MOE_MAINP, (DFFE / 4) * 2, (size_t)8 * 256 * D};
                        pg8::gemm_phase<pg8::EpiStore, pg8::SliceOrder, true, false, DFFE, DFFE, DFFE / 4>(F.lds + RING_OFF, g, T, E2);
                    }
                }
                GRID_BAR();
                {
                    PH_BEGIN;
                    const float* g2 = GIN(24) + (size_t)l * D; const float* b2 = GIN(25) + (size_t)l * D;
                    LnGB q; ln_load_gb(q, g2, b2, lane);
                    constexpr unsigned MAINR = (unsigned)(MOE_MAINP * 256);
                    unsigned np1 = PPOS[2 * (hf * MOE_HALF + gw)], np2 = PPOS[2 * (hf * MOE_HALF + gw) + 1]; float nga = TOKG[2 * (hf * MOE_HALF + gw)], ngb = TOKG[2 * (hf * MOE_HALF + gw) + 1];
                    RowRaw rx, ra, rc; unsigned p1 = np1, p2 = np2; float ga = nga, gb = ngb;
                    row_fetch(rx, X + (size_t)(hf * MOE_HALF + gw) * D, lane);
                    row_fetch(ra, (p1 < MAINR) ? YP + (size_t)p1 * D : YPS + (size_t)(p1 - MAINR) * D, lane); row_fetch(rc, (p2 < MAINR) ? YP + (size_t)p2 * D : YPS + (size_t)(p2 - MAINR) * D, lane);
                    if (gw + NGW < MOE_HALF) { const int m2 = hf * MOE_HALF + gw + NGW; np1 = PPOS[2 * m2]; np2 = PPOS[2 * m2 + 1]; nga = TOKG[2 * m2]; ngb = TOKG[2 * m2 + 1]; }
                    DUP(7) for (int mm = gw; mm < MOE_HALF; mm += NGW) { const int m = hf * MOE_HALF + mm;
                        f32x4 v[4], a[4], c[4]; row_unpack(rx, v); row_unpack(ra, a); row_unpack(rc, c);
                        const unsigned q1 = p1, q2 = p2; const float ha = ga, hb = gb;
                        if (q1 >= MAINR) { f32x4 t4[4];
#pragma unroll
                            for (int sl = 1; sl < 4; ++sl) { row_load_bf16(YPS + (size_t)sl * 8 * 256 * D + (size_t)(q1 - MAINR) * D, t4, lane);
#pragma unroll
                                for (int j = 0; j < 4; ++j) a[j] = a[j] + t4[j]; } }
                        if (q2 >= MAINR) { f32x4 t4[4];
#pragma unroll
                            for (int sl = 1; sl < 4; ++sl) { row_load_bf16(YPS + (size_t)sl * 8 * 256 * D + (size_t)(q2 - MAINR) * D, t4, lane);
#pragma unroll
                                for (int j = 0; j < 4; ++j) c[j] = c[j] + t4[j]; } }
                        if (mm + NGW < MOE_HALF) { const int m1 = m + NGW; p1 = np1; p2 = np2; ga = nga; gb = ngb;
                            row_fetch(rx, X + (size_t)m1 * D, lane);
                            row_fetch(ra, (p1 < MAINR) ? YP + (size_t)p1 * D : YPS + (size_t)(p1 - MAINR) * D, lane); row_fetch(rc, (p2 < MAINR) ? YP + (size_t)p2 * D : YPS + (size_t)(p2 - MAINR) * D, lane);
                            if (mm + 2 * NGW < MOE_HALF) { const int m2 = m + 2 * NGW; np1 = PPOS[2 * m2]; np2 = PPOS[2 * m2 + 1]; nga = TOKG[2 * m2]; ngb = TOKG[2 * m2 + 1]; } }
#pragma unroll
                        for (int j = 0; j < 4; ++j) v[j] = DN_ALPHA * v[j] + PROBE_MOE_SCALE * (ha * a[j] + hb * c[j]);
                        ln_norm_r(v, q);
                        if (l == NLAYER - 1) { GAS f32x4* o = (GAS f32x4*)(outp + (size_t)m * D) + lane;
#pragma unroll
                            for (int j = 0; j < 4; ++j) o[64 * j] = v[j]; }
                        else row_store_bf16(X + (size_t)m * D, v, lane); }
                }

}
{ constexpr int hf = 1;

                const int npan = moff[hf * 9 + 8] >> 8;
                __syncthreads();
                int tp_ = threadIdx.x; asm volatile("" : "+v"(tp_));
                for (int p = tp_; p < npan; p += NWAVES * 64) { int e = 0;
#pragma unroll
                    for (int q = 1; q < NEXP; ++q) if (p * 256 >= moff[hf * 9 + q]) e = q;
                    pexp[p] = e; }
                __syncthreads();
                {
                    PH_BEGIN;
                    pg8::Gemm g{X, WM13, (size_t)2 * DFFE * D * 2, RTOK + hf * MOE_ROWS}; pg8::GroupedOrder S; S.so.init_tiles(npan, 2 * DFFE / 256, NG, bx); S.pexp = pexp;
                    pg8::EpiSwiglu E{HM, DFFE};
                    DUP(1) pg8::gemm_phase<pg8::EpiSwiglu, pg8::GroupedOrder, true, true, D, D, D>(F.lds + RING_OFF, g, S, E);
                }
                GRID_BAR();
                {
                    PH_BEGIN;
                    const int npm = npan < MOE_MAINP ? npan : MOE_MAINP;
                    pg8::Gemm g{HM, WM2, (size_t)D * DFFE * 2, nullptr}; pg8::GroupedOrder S; S.so.init_tiles(npm, D / 256, NG, bx); S.pexp = pexp;
                    pg8::EpiStore E{YP, D};
                    pg8::gemm_phase<pg8::EpiStore, pg8::GroupedOrder, true, false, DFFE, DFFE, DFFE>(F.lds + RING_OFF, g, S, E);
                    if (npan > MOE_MAINP) {
                        pg8::SliceOrder T{MOE_MAINP, npan - MOE_MAINP, D / 256, bx, (DFFE / 4) * 2, pexp};
                        pg8::EpiStore E2{YPS, D, MOE_MAINP, (DFFE / 4) * 2, (size_t)8 * 256 * D};
                        pg8::gemm_phase<pg8::EpiStore, pg8::SliceOrder, true, false, DFFE, DFFE, DFFE / 4>(F.lds + RING_OFF, g, T, E2);
                    }
                }
                GRID_BAR();
                {
                    PH_BEGIN;
                    const float* g2 = GIN(24) + (size_t)l * D; const float* b2 = GIN(25) + (size_t)l * D;
                    LnGB q; ln_load_gb(q, g2, b2, lane);
                    constexpr unsigned MAINR = (unsigned)(MOE_MAINP * 256);
                    unsigned np1 = PPOS[2 * (hf * MOE_HALF + gw)], np2 = PPOS[2 * (hf * MOE_HALF + gw) + 1]; float nga = TOKG[2 * (hf * MOE_HALF + gw)], ngb = TOKG[2 * (hf * MOE_HALF + gw) + 1];
                    RowRaw rx, ra, rc; unsigned p1 = np1, p2 = np2; float ga = nga, gb = ngb;
                    row_fetch(rx, X + (size_t)(hf * MOE_HALF + gw) * D, lane);
                    row_fetch(ra, (p1 < MAINR) ? YP + (size_t)p1 * D : YPS + (size_t)(p1 - MAINR) * D, lane); row_fetch(rc, (p2 < MAINR) ? YP + (size_t)p2 * D : YPS + (size_t)(p2 - MAINR) * D, lane);
                    if (gw + NGW < MOE_HALF) { const int m2 = hf * MOE_HALF + gw + NGW; np1 = PPOS[2 * m2]; np2 = PPOS[2 * m2 + 1]; nga = TOKG[2 * m2]; ngb = TOKG[2 * m2 + 1]; }
                    DUP(7) for (int mm = gw; mm < MOE_HALF; mm += NGW) { const int m = hf * MOE_HALF + mm;
                        f32x4 v[4], a[4], c[4]; row_unpack(rx, v); row_unpack(ra, a); row_unpack(rc, c);
                        const unsigned q1 = p1, q2 = p2; const float ha = ga, hb = gb;
                        if (q1 >= MAINR) { f32x4 t4[4];
#pragma unroll
                            for (int sl = 1; sl < 4; ++sl) { row_load_bf16(YPS + (size_t)sl * 8 * 256 * D + (size_t)(q1 - MAINR) * D, t4, lane);
#pragma unroll
                                for (int j = 0; j < 4; ++j) a[j] = a[j] + t4[j]; } }
                        if (q2 >= MAINR) { f32x4 t4[4];
#pragma unroll
                            for (int sl = 1; sl < 4; ++sl) { row_load_bf16(YPS + (size_t)sl * 8 * 256 * D + (size_t)(q2 - MAINR) * D, t4, lane);
#pragma unroll
                                for (int j = 0; j < 4; ++j) c[j] = c[j] + t4[j]; } }
                        if (mm + NGW < MOE_HALF) { const int m1 = m + NGW; p1 = np1; p2 = np2; ga = nga; gb = ngb;
                            row_fetch(rx, X + (size_t)m1 * D, lane);
                            row_fetch(ra, (p1 < MAINR) ? YP + (size_t)p1 * D : YPS + (size_t)(p1 - MAINR) * D, lane); row_fetch(rc, (p2 < MAINR) ? YP + (size_t)p2 * D : YPS + (size_t)(p2 - MAINR) * D, lane);
                            if (mm + 2 * NGW < MOE_HALF) { const int m2 = m + 2 * NGW; np1 = PPOS[2 * m2]; np2 = PPOS[2 * m2 + 1]; nga = TOKG[2 * m2]; ngb = TOKG[2 * m2 + 1]; } }
#pragma unroll
                        for (int j = 0; j < 4; ++j) v[j] = DN_ALPHA * v[j] + PROBE_MOE_SCALE * (ha * a[j] + hb * c[j]);
                        ln_norm_r(v, q);
                        if (l == NLAYER - 1) { GAS f32x4* o = (GAS f32x4*)(outp + (size_t)m * D) + lane;
#pragma unroll
                            for (int j = 0; j < 4; ++j) o[64 * j] = v[j]; }
                        else row_store_bf16(X + (size_t)m * D, v, lane); }
                }

}

            if (l != NLAYER - 1) GRID_BAR();
        }

}

}

extern "C" void kernel_launch(void* const* d_in, const int* in_sizes, int n_in, void* d_out, int out_size, void* d_ws, size_t ws_size, hipStream_t stream) {
    static int grid = 0;
    if (grid == 0) {
        if (n_in != 34 || in_sizes[0] != M * D || out_size != M * D || ws_size < WS_END) { fprintf(stderr, "kernel_launch: unexpected shapes / workspace (n_in %d, in0 %d, out %d, ws %zu); nothing launched\n", n_in, n_in > 0 ? in_sizes[0] : -1, out_size, ws_size); grid = -1; return; }
        int dev = 0, cus = 0;
        if (hipGetDevice(&dev) != hipSuccess || hipDeviceGetAttribute(&cus, hipDeviceAttributeMultiprocessorCount, dev) != hipSuccess) { grid = -1; return; }
        if (hipFuncSetAttribute((const void*)mk_fwd, hipFuncAttributeMaxDynamicSharedMemorySize, LDS_BYTES) != hipSuccess) { fprintf(stderr, "kernel_launch: hipFuncSetAttribute failed\n"); grid = -1; return; }
        int per_cu = 0;
        if (hipOccupancyMaxActiveBlocksPerMultiprocessor(&per_cu, (const void*)mk_fwd, NWAVES * 64, LDS_BYTES) != hipSuccess || per_cu < 1) fprintf(stderr, "kernel_launch: occupancy query reports %d workgroups per CU\n", per_cu);
        (void)hipGetLastError();
        if (cus != 256) { fprintf(stderr, "kernel_launch: built for a 256-CU device, found %d; nothing launched\n", cus); grid = -1; return; }
        grid = 256;
    }
    if (grid < 0) return;
    if (hipMemsetAsync((char*)d_ws + WS_CTL, 0, CTL_ZERO_BYTES, stream) != hipSuccess) return;
    Args a{};
    for (int i = 0; i < 34; ++i) a.in[i] = (const float*)d_in[i];
    a.out = (float*)d_out; a.ws = (unsigned char*)d_ws;
    hipLaunchKernelGGL(mk_fwd, dim3(grid), dim3(NWAVES * 64), LDS_BYTES, stream, a);
}
```
